# Optimizing an MI355X kernel written in HIP

```python
import jax
import jax.numpy as jnp
from jax import lax
import numpy as np

D_MODEL = 1024
BATCH = 8
SEQ = 2048
DEPTH = 4

GRID_W = 64
CTX_LEN = 256
D_MIX = D_MODEL
N_GROUPS = 4
GROUP_W = D_MIX // N_GROUPS
HEAD_DIM = 64
NORM_EPS = 1e-6
ROPE_BASE = 10000.0
NEG_INF = -1e30

CONV_W = 4
LRU_BLOCKS = GROUP_W // HEAD_DIM
LRU_BLOCK = GROUP_W // LRU_BLOCKS
LRU_C = 8.0
GDN_HEADS = GROUP_W // HEAD_DIM
GDN_CHUNK = 64
GDN_INV_STEPS = GDN_CHUNK.bit_length() - 2
RET_HEADS = GROUP_W // HEAD_DIM
RET_CHUNK = 64
SWA_HEADS = GROUP_W // HEAD_DIM
SWA_KV_HEADS = 2
SWA_GROUP = SWA_HEADS // SWA_KV_HEADS
SWA_KV_W = SWA_KV_HEADS * HEAD_DIM
WINDOW = 128
SWA_BLOCK = WINDOW

IN_SPLITS = (
    ('lru_x', GROUP_W), ('lru_z', GROUP_W),
    ('gdn_qkv', 3 * GROUP_W), ('gdn_z', GROUP_W), ('gdn_alpha', 2 * GDN_HEADS), ('gdn_beta', 2 * GDN_HEADS),
    ('ret_q', GROUP_W), ('ret_k', GROUP_W), ('ret_v', GROUP_W), ('ret_z', GROUP_W),
    ('swa_q', GROUP_W), ('swa_k', SWA_KV_W), ('swa_v', SWA_KV_W), ('swa_z', GROUP_W),
)
IN_W = sum(w for _, w in IN_SPLITS)

kernel_name = 'hybrid_parallel_group_diffusion_block'


def rmsnorm(x, g):
    xf = x.astype(jnp.float32)
    y = xf * lax.rsqrt(jnp.mean(xf * xf, axis=-1, keepdims=True) + NORM_EPS)
    return (y * g.astype(jnp.float32)).astype(x.dtype)


def l2norm(x):
    return x * lax.rsqrt(jnp.sum(x * x, axis=-1, keepdims=True) + NORM_EPS)


def head_groupnorm(o):
    mu = jnp.mean(o, axis=-1, keepdims=True)
    d = o - mu
    return d * lax.rsqrt(jnp.mean(d * d, axis=-1, keepdims=True) + NORM_EPS)


def split_in(u):
    parts, off = {}, 0
    for name, w in IN_SPLITS:
        parts[name] = u[..., off:off + w]
        off += w
    return parts


def dwconv(x, w):
    k = w.shape[0]
    return lax.conv_general_dilated(
        x, w[:, None, :].astype(x.dtype), window_strides=(1,),
        padding=[(k // 2, k - 1 - k // 2)],
        dimension_numbers=('NWC', 'WIO', 'NWC'), feature_group_count=x.shape[-1])


def rope_freqs(pos, n):
    inv = ROPE_BASE ** (-jnp.arange(0, n, 2, dtype=jnp.float32) / n)
    return pos[:, None] * inv[None, :]


def apply_rope(x, ang):
    half = x.shape[-1] // 2
    cos = jnp.cos(ang)[None, :, None, :]
    sin = jnp.sin(ang)[None, :, None, :]
    x1, x2 = x[..., :half], x[..., half:]
    return jnp.concatenate([x1 * cos - x2 * sin, x1 * sin + x2 * cos], axis=-1).astype(x.dtype)


def _chunks4(t, c):
    bsz, tl, h, d = t.shape
    return t.reshape(bsz, tl // c, c, h, d).transpose(1, 0, 3, 2, 4)


def _chunks3(t, c):
    bsz, tl, h = t.shape
    return t.reshape(bsz, tl // c, c, h).transpose(1, 0, 3, 2)


def _unchunk(o):
    n, bsz, h, c, d = o.shape
    return o.transpose(1, 0, 3, 2, 4).reshape(bsz, n * c, h, d)


def linear_scan(a, b, h0):
    b = b.at[:, 0].add(a[:, 0] * h0)

    def combine(left, right):
        a_l, b_l = left
        a_r, b_r = right
        return a_l * a_r, a_r * b_l + b_r

    _, h = lax.associative_scan(combine, (a, b), axis=1)
    return h


def rglru_dir(u, w_r, b_r, w_i, b_i, lam, h0):
    bsz, t, w = u.shape
    ub = u.reshape(bsz, t, LRU_BLOCKS, LRU_BLOCK)
    r = jax.nn.sigmoid(jnp.einsum('btnc,ncd->btnd', ub, w_r.astype(jnp.float32)).reshape(bsz, t, w) + b_r)
    i = jax.nn.sigmoid(jnp.einsum('btnc,ncd->btnd', ub, w_i.astype(jnp.float32)).reshape(bsz, t, w) + b_i)
    log_a = -LRU_C * r * jax.nn.softplus(-lam.astype(jnp.float32))
    a = jnp.exp(log_a)
    b = jnp.sqrt(-jnp.expm1(2.0 * log_a)) * (i * u)
    return linear_scan(a, b, h0)


def mixer_rglru(u, uc, conv_w, conv_b, w_r, b_r, w_i, b_i, lam, with_ctx):
    f32 = jnp.float32
    x_l, x_c = u['lru_x'], uc['lru_x']
    u_l = (dwconv(x_l, conv_w) + conv_b).astype(f32)
    u_c = (dwconv(x_c, conv_w) + conv_b).astype(f32)
    h0 = jnp.zeros((x_l.shape[0], GROUP_W), f32)
    hc_f = rglru_dir(u_c, w_r[0], b_r[0], w_i[0], b_i[0], lam[0], h0)
    hl_f = rglru_dir(u_l, w_r[0], b_r[0], w_i[0], b_i[0], lam[0], hc_f[:, -1])
    hc_b = rglru_dir(u_c[:, ::-1], w_r[1], b_r[1], w_i[1], b_i[1], lam[1], h0)
    hl_b = rglru_dir(u_l[:, ::-1], w_r[1], b_r[1], w_i[1], b_i[1], lam[1], hc_b[:, -1])[:, ::-1]
    y_l = ((hl_f + hl_b) * jax.nn.silu(u['lru_z'].astype(f32))).astype(x_l.dtype)
    y_c = None
    if with_ctx:
        y_c = ((hc_f + hc_b[:, ::-1]) * jax.nn.silu(uc['lru_z'].astype(f32))).astype(x_c.dtype)
    return y_l, y_c


def unit_lower_inverse(l_mat):
    eye = jnp.eye(l_mat.shape[-1], dtype=l_mat.dtype)
    n = -l_mat
    p = eye + n
    for _ in range(GDN_INV_STEPS):
        n = n @ n
        p = p @ (eye + n)
    return p


def gdn_chunked(q, k, v, g, beta, s0, with_out):
    c = GDN_CHUNK
    ks, vs = _chunks4(k, c), _chunks4(v, c)
    gs, bs = _chunks3(g, c), _chunks3(beta, c)
    gcum = jnp.cumsum(gs, axis=-1)
    idx = jnp.arange(c)
    lower = idx[:, None] >= idx[None, :]
    strict = idx[:, None] > idx[None, :]
    diff = gcum[..., :, None] - gcum[..., None, :]
    decay = jnp.where(lower, jnp.exp(jnp.where(lower, diff, 0.0)), 0.0)
    kb = ks * bs[..., None]
    l_mat = jnp.where(strict, jnp.einsum('nbhid,nbhjd->nbhij', kb, ks) * decay, 0.0)
    t_mat = unit_lower_inverse(l_mat)
    u_val = t_mat @ (vs * bs[..., None])
    w_dec = t_mat @ (kb * jnp.exp(gcum)[..., None])
    k_tail = ks * jnp.exp(gcum[..., -1:] - gcum)[..., None]
    g_tail = jnp.exp(gcum[..., -1])
    if with_out:
        qs = _chunks4(q, c)
        att = jnp.where(lower, jnp.einsum('nbhid,nbhjd->nbhij', qs, ks) * decay, 0.0)
        q_dec = qs * jnp.exp(gcum)[..., None]
        xs = (u_val, w_dec, k_tail, g_tail, att, q_dec)
    else:
        xs = (u_val, w_dec, k_tail, g_tail)

    def step(s, inp):
        u_i, w_i, kt_i, gt_i = inp[0], inp[1], inp[2], inp[3]
        v_new = u_i - jnp.einsum('bhcd,bhde->bhce', w_i, s)
        s_new = s * gt_i[..., None, None] + jnp.einsum('bhcd,bhce->bhde', kt_i, v_new)
        if not with_out:
            return s_new, None
        att_i, qd_i = inp[4], inp[5]
        o = jnp.einsum('bhcd,bhde->bhce', qd_i, s) + jnp.einsum('bhij,bhje->bhie', att_i, v_new)
        return s_new, o

    s_fin, o = lax.scan(step, s0, xs)
    return (_unchunk(o) if with_out else None), s_fin


def gdn_prep(qkv, alpha, beta, conv_w, a_log, dt_bias):
    f32 = jnp.float32
    bsz, t, _ = qkv.shape
    h = jax.nn.silu(dwconv(qkv, conv_w).astype(f32)).reshape(bsz, t, 3, GDN_HEADS, HEAD_DIM)
    q = l2norm(h[:, :, 0]) * HEAD_DIM ** -0.5
    k = l2norm(h[:, :, 1])
    v = h[:, :, 2]
    g = -jnp.exp(a_log.astype(f32)) * jax.nn.softplus(
        alpha.astype(f32).reshape(bsz, t, 2, GDN_HEADS) + dt_bias.astype(f32))
    b = jax.nn.sigmoid(beta.astype(f32).reshape(bsz, t, 2, GDN_HEADS))
    return q, k, v, g, b


def mixer_gdn(u, uc, conv_w, a_log, dt_bias, norm_g, with_ctx):
    ql, kl, vl, gl, bl = gdn_prep(u['gdn_qkv'], u['gdn_alpha'], u['gdn_beta'], conv_w, a_log, dt_bias)
    qc, kc, vc, gc, bc = gdn_prep(uc['gdn_qkv'], uc['gdn_alpha'], uc['gdn_beta'], conv_w, a_log, dt_bias)
    s0 = jnp.zeros((ql.shape[0], GDN_HEADS, HEAD_DIM, HEAD_DIM), jnp.float32)
    rev = lambda t: t[:, ::-1]
    oc_f, sc_f = gdn_chunked(qc, kc, vc, gc[:, :, 0], bc[:, :, 0], s0, with_ctx)
    ol_f, _ = gdn_chunked(ql, kl, vl, gl[:, :, 0], bl[:, :, 0], sc_f, True)
    oc_b, sc_b = gdn_chunked(rev(qc), rev(kc), rev(vc), rev(gc[:, :, 1]), rev(bc[:, :, 1]), s0, with_ctx)
    ol_b, _ = gdn_chunked(rev(ql), rev(kl), rev(vl), rev(gl[:, :, 1]), rev(bl[:, :, 1]), sc_b, True)

    def finish(o, z):
        bsz, t = z.shape[0], z.shape[1]
        return (rmsnorm(o, norm_g).reshape(bsz, t, GROUP_W) * jax.nn.silu(z.astype(jnp.float32))).astype(z.dtype)

    y_l = finish(ol_f + rev(ol_b), u['gdn_z'])
    y_c = finish(oc_f + rev(oc_b), uc['gdn_z']) if with_ctx else None
    return y_l, y_c


def retention_chunked(q, k, v, log_gamma, s0, with_out):
    c = RET_CHUNK
    idx = jnp.arange(c, dtype=jnp.float32)
    diff = idx[:, None] - idx[None, :]
    lower = diff >= 0
    dmat = jnp.where(lower, jnp.exp(jnp.where(lower, diff, 0.0)[None] * log_gamma[:, None, None]), 0.0)
    q_dec = jnp.exp((idx + 1.0)[None, :] * log_gamma[:, None])
    k_dec = jnp.exp((c - 1.0 - idx)[None, :] * log_gamma[:, None])
    c_dec = jnp.exp(c * log_gamma)
    ks, vs = _chunks4(k, c), _chunks4(v, c)
    xs = (ks, vs, _chunks4(q, c)) if with_out else (ks, vs)

    def step(s, inp):
        k_i, v_i = inp[0], inp[1]
        s_new = s * c_dec[None, :, None, None] + jnp.einsum('bhcd,bhce->bhde', k_i * k_dec[None, :, :, None], v_i)
        if not with_out:
            return s_new, None
        q_i = inp[2]
        att = jnp.einsum('bhid,bhjd->bhij', q_i, k_i) * dmat[None]
        o = jnp.einsum('bhcd,bhde->bhce', q_i * q_dec[None, :, :, None], s) + jnp.einsum('bhij,bhje->bhie', att, v_i)
        return s_new, o

    s_fin, o = lax.scan(step, s0, xs)
    return (_unchunk(o) if with_out else None), s_fin


def mixer_retention(u, uc, decay_logit, ang1d, with_ctx):
    f32 = jnp.float32
    heads = lambda t: t.astype(f32).reshape(t.shape[0], t.shape[1], RET_HEADS, HEAD_DIM)
    kscale = HEAD_DIM ** -0.5
    ql = apply_rope(heads(u['ret_q']), ang1d)
    kl = apply_rope(heads(u['ret_k']), ang1d) * kscale
    vl = heads(u['ret_v'])
    qc = heads(uc['ret_q']) if with_ctx else None
    kc = heads(uc['ret_k']) * kscale
    vc = heads(uc['ret_v'])
    lg = jax.nn.log_sigmoid(decay_logit.astype(f32))
    s0 = jnp.zeros((ql.shape[0], RET_HEADS, HEAD_DIM, HEAD_DIM), f32)
    rev = lambda t: None if t is None else t[:, ::-1]
    oc_f, s_f = retention_chunked(qc, kc, vc, lg[0], s0, with_ctx)
    ol_f, _ = retention_chunked(ql, kl, vl, lg[0], s_f, True)
    oc_b, s_b = retention_chunked(rev(qc), rev(kc), rev(vc), lg[1], s0, with_ctx)
    ol_b, _ = retention_chunked(rev(ql), rev(kl), rev(vl), lg[1], s_b, True)

    def finish(o, z):
        bsz, t = z.shape[0], z.shape[1]
        return (head_groupnorm(o).reshape(bsz, t, GROUP_W) * jax.nn.silu(z.astype(f32))).astype(z.dtype)

    y_l = finish(ol_f + ol_b[:, ::-1], u['ret_z'])
    y_c = finish(oc_f + oc_b[:, ::-1], uc['ret_z']) if with_ctx else None
    return y_l, y_c


def mixer_swa(u, uc, sink, ang2d, with_ctx):
    f32 = jnp.float32
    bsz, t, _ = u['swa_q'].shape
    lc = uc['swa_k'].shape[1]
    blk = SWA_BLOCK
    nb = t // blk
    scale = HEAD_DIM ** -0.5
    q = apply_rope(u['swa_q'].reshape(bsz, t, SWA_HEADS, HEAD_DIM), ang2d) * scale
    k = apply_rope(u['swa_k'].reshape(bsz, t, SWA_KV_HEADS, HEAD_DIM), ang2d)
    v = u['swa_v'].reshape(bsz, t, SWA_KV_HEADS, HEAD_DIM)
    kc = uc['swa_k'].reshape(bsz, lc, SWA_KV_HEADS, HEAD_DIM)
    vc = uc['swa_v'].reshape(bsz, lc, SWA_KV_HEADS, HEAD_DIM)
    sink_g = sink.astype(f32).reshape(SWA_KV_HEADS, SWA_GROUP)

    qb = q.reshape(bsz, nb, blk, SWA_KV_HEADS, SWA_GROUP, HEAD_DIM)
    pad = ((0, 0), (blk, blk), (0, 0), (0, 0))
    kp = jnp.pad(k, pad).reshape(bsz, nb + 2, blk, SWA_KV_HEADS, HEAD_DIM)
    vp = jnp.pad(v, pad).reshape(bsz, nb + 2, blk, SWA_KV_HEADS, HEAD_DIM)
    kw = jnp.concatenate([kp[:, :-2], kp[:, 1:-1], kp[:, 2:]], axis=2)
    vw = jnp.concatenate([vp[:, :-2], vp[:, 1:-1], vp[:, 2:]], axis=2)
    qi = jnp.arange(blk)[:, None]
    kj = jnp.arange(3 * blk)[None, :]
    in_win = jnp.abs(kj - blk - qi) <= WINDOW
    kpos = jnp.arange(nb)[:, None] * blk - blk + jnp.arange(3 * blk)[None, :]
    valid = (kpos >= 0) & (kpos < t)
    mask = in_win[None, :, :] & valid[:, None, :]
    s_loc = jnp.einsum('bnqhgd,bnkhd->bnhgqk', qb, kw).astype(f32)
    s_loc = jnp.where(mask[None, :, None, None], s_loc, NEG_INF)
    s_ctx = jnp.einsum('bnqhgd,bchd->bnhgqc', qb, kc).astype(f32)
    s_snk = jnp.broadcast_to(sink_g[None, None, :, :, None, None], s_loc.shape[:-1] + (1,))
    p = jax.nn.softmax(jnp.concatenate([s_loc, s_ctx, s_snk], axis=-1), axis=-1).astype(v.dtype)
    o = (jnp.einsum('bnhgqk,bnkhd->bnqhgd', p[..., :3 * blk], vw)
         + jnp.einsum('bnhgqc,bchd->bnqhgd', p[..., 3 * blk:3 * blk + lc], vc))
    z_l = u['swa_z']
    y_l = (o.reshape(bsz, t, GROUP_W).astype(f32) * jax.nn.silu(z_l.astype(f32))).astype(z_l.dtype)
    y_c = None
    if with_ctx:
        qcx = uc['swa_q'].reshape(bsz, lc, SWA_KV_HEADS, SWA_GROUP, HEAD_DIM) * scale
        s_c = jnp.einsum('bqhgd,bkhd->bhgqk', qcx, kc).astype(f32)
        s_cs = jnp.broadcast_to(sink_g[None, :, :, None, None], s_c.shape[:-1] + (1,))
        p_c = jax.nn.softmax(jnp.concatenate([s_c, s_cs], axis=-1), axis=-1).astype(vc.dtype)
        o_c = jnp.einsum('bhgqk,bkhd->bqhgd', p_c[..., :lc], vc)
        z_c = uc['swa_z']
        y_c = (o_c.reshape(bsz, lc, GROUP_W).astype(f32) * jax.nn.silu(z_c.astype(f32))).astype(z_c.dtype)
    return y_l, y_c


def setup_inputs(seed: int = 0) -> dict:
    key = jax.random.key(seed)
    ks = jax.random.split(key, 24)
    f32 = jnp.float32
    nrm = lambda k, shape, s: jax.random.normal(k, shape, f32) * s
    x = nrm(ks[0], (BATCH, SEQ, D_MODEL), 1.0)
    c = nrm(ks[1], (BATCH, D_MODEL), 1.0)
    ctx = nrm(ks[2], (BATCH, CTX_LEN, D_MODEL), 1.0)
    c_ctx = nrm(ks[3], (D_MODEL,), 1.0)
    w_mod = nrm(ks[4], (DEPTH, D_MODEL, 3 * D_MODEL), 0.5 * D_MODEL ** -0.5)
    b_mod = nrm(ks[5], (DEPTH, 3 * D_MODEL), 0.02)
    pre_norm_g = 1.0 + nrm(ks[6], (DEPTH, D_MODEL), 0.02)
    post_norm_g = 1.0 + nrm(ks[7], (DEPTH, D_MODEL), 0.02)
    w_in = nrm(ks[8], (DEPTH, D_MODEL, IN_W), D_MODEL ** -0.5)
    w_out = nrm(ks[9], (DEPTH, D_MIX, D_MODEL), D_MIX ** -0.5)
    lru_conv_w = nrm(ks[10], (DEPTH, CONV_W, GROUP_W), CONV_W ** -0.5)
    lru_conv_b = nrm(ks[11], (DEPTH, GROUP_W), 0.02)
    lru_w_r = nrm(ks[12], (DEPTH, 2, LRU_BLOCKS, LRU_BLOCK, LRU_BLOCK), LRU_BLOCK ** -0.5)
    lru_b_r = nrm(ks[13], (DEPTH, 2, GROUP_W), 0.02)
    lru_w_i = nrm(ks[14], (DEPTH, 2, LRU_BLOCKS, LRU_BLOCK, LRU_BLOCK), LRU_BLOCK ** -0.5)
    lru_b_i = nrm(ks[15], (DEPTH, 2, GROUP_W), 0.02)
    a0 = jax.random.uniform(ks[16], (DEPTH, 2, GROUP_W), f32, 0.9, 0.999)
    lru_lambda = jnp.log(a0) - jnp.log1p(-a0)
    gdn_conv_w = nrm(ks[17], (DEPTH, CONV_W, 3 * GROUP_W), CONV_W ** -0.5)
    gdn_a_log = jnp.log(jax.random.uniform(ks[18], (DEPTH, 2, GDN_HEADS), f32, 1.0, 16.0))
    dt = jnp.exp(jax.random.uniform(ks[19], (DEPTH, 2, GDN_HEADS), f32, np.log(1e-3), np.log(1e-1)))
    gdn_dt_bias = dt + jnp.log(-jnp.expm1(-dt))
    gdn_norm_g = 1.0 + nrm(ks[20], (DEPTH, HEAD_DIM), 0.02)
    ret_base = jnp.log(2.0 ** (5.0 + jnp.arange(RET_HEADS, dtype=f32)) - 1.0)
    ret_decay_logit = ret_base + nrm(ks[21], (DEPTH, 2, RET_HEADS), 0.1)
    swa_sink = nrm(ks[22], (DEPTH, SWA_HEADS), 0.5)
    return {'x': x, 'c': c, 'ctx': ctx, 'c_ctx': c_ctx, 'w_mod': w_mod, 'b_mod': b_mod,
            'pre_norm_g': pre_norm_g, 'post_norm_g': post_norm_g, 'w_in': w_in, 'w_out': w_out,
            'lru_conv_w': lru_conv_w, 'lru_conv_b': lru_conv_b, 'lru_w_r': lru_w_r, 'lru_b_r': lru_b_r,
            'lru_w_i': lru_w_i, 'lru_b_i': lru_b_i, 'lru_lambda': lru_lambda,
            'gdn_conv_w': gdn_conv_w, 'gdn_a_log': gdn_a_log, 'gdn_dt_bias': gdn_dt_bias,
            'gdn_norm_g': gdn_norm_g, 'ret_decay_logit': ret_decay_logit, 'swa_sink': swa_sink}


def reference(x, c, ctx, c_ctx, w_mod, b_mod, pre_norm_g, post_norm_g, w_in, w_out,
              lru_conv_w, lru_conv_b, lru_w_r, lru_b_r, lru_w_i, lru_b_i, lru_lambda,
              gdn_conv_w, gdn_a_log, gdn_dt_bias, gdn_norm_g, ret_decay_logit, swa_sink):
    bsz, t, _ = x.shape
    rows = t // GRID_W
    row = jnp.repeat(jnp.arange(rows, dtype=jnp.float32), GRID_W)
    col = jnp.tile(jnp.arange(GRID_W, dtype=jnp.float32), rows)
    ang2d = jnp.concatenate([rope_freqs(row, HEAD_DIM // 2), rope_freqs(col, HEAD_DIM // 2)], axis=-1)
    ang1d = rope_freqs(jnp.arange(t, dtype=jnp.float32), HEAD_DIM)
    s_lat = jax.nn.silu(c)
    s_ctx = jax.nn.silu(c_ctx)
    xc = ctx
    for l in range(DEPTH):
        with_ctx = l < DEPTH - 1
        shift, scale, gate = jnp.split((s_lat @ w_mod[l] + b_mod[l])[:, None, :], 3, axis=-1)
        shift_c, scale_c, gate_c = jnp.split(s_ctx @ w_mod[l] + b_mod[l], 3, axis=-1)
        h = rmsnorm(x, pre_norm_g[l]) * (1 + scale) + shift
        hc = rmsnorm(xc, pre_norm_g[l]) * (1 + scale_c) + shift_c
        u = split_in(h @ w_in[l])
        uc = split_in(hc @ w_in[l])
        ya_l, ya_c = mixer_rglru(u, uc, lru_conv_w[l], lru_conv_b[l], lru_w_r[l], lru_b_r[l],
                                 lru_w_i[l], lru_b_i[l], lru_lambda[l], with_ctx)
        yb_l, yb_c = mixer_gdn(u, uc, gdn_conv_w[l], gdn_a_log[l], gdn_dt_bias[l], gdn_norm_g[l], with_ctx)
        yr_l, yr_c = mixer_retention(u, uc, ret_decay_logit[l], ang1d, with_ctx)
        yd_l, yd_c = mixer_swa(u, uc, swa_sink[l], ang2d, with_ctx)
        y = jnp.concatenate([ya_l, yb_l, yr_l, yd_l], axis=-1) @ w_out[l]
        if with_ctx:
            yc = jnp.concatenate([ya_c, yb_c, yr_c, yd_c], axis=-1) @ w_out[l]
            xc = xc + gate_c * rmsnorm(yc, post_norm_g[l])
        x = x + gate * rmsnorm(y, post_norm_g[l])
    return x
```

```cpp
#include <hip/hip_runtime.h>
#include <hip/hip_bf16.h>
#include <cstdio>
#include <cstdint>

typedef unsigned short bf16_t;
typedef __attribute__((ext_vector_type(8))) short bf16x8;
typedef __attribute__((ext_vector_type(4))) float f32x4;

#define NT 256
constexpr int Bsz = 8, T = 2048, LC = 256, DM = 1024, INW = 3344;
constexpr int LAT = Bsz * T, NROW = LAT + Bsz * LC;
constexpr int C_LRUX = 0, C_LRUZ = 256, C_GQ = 512, C_GZ = 1280, C_GA = 1536, C_GB = 1544;
constexpr int C_RQ = 1552, C_RK = 1808, C_RV = 2064, C_RZ = 2320, C_SQ = 2576, C_SK = 2832, C_SV = 2960, C_SZ = 3088;
constexpr float EPS = 1e-6f;

enum { I_X = 0, I_C, I_CTX, I_CCTX, I_WMOD, I_BMOD, I_PREG, I_POSTG, I_WIN, I_WOUT, I_LCW, I_LCB, I_LWR, I_LBR, I_LWI, I_LBI,
       I_LLAM, I_GCW, I_GALOG, I_GDT, I_GNG, I_RDEC, I_SINK };

constexpr size_t OFF_MOD = 0;
constexpr size_t OFF_WINT = 1u << 19;
constexpr size_t SZ_WINT = 4ull * INW * DM * 2;
constexpr size_t OFF_WOUTT = OFF_WINT + SZ_WINT;
constexpr size_t SZ_WOUTT = 4ull * DM * DM * 2;
constexpr size_t OFF_U = OFF_WOUTT + SZ_WOUTT;
constexpr size_t SZ_U = (size_t)NROW * INW * 2;
constexpr size_t OFF_P = OFF_U + SZ_U;
constexpr size_t SZ_P = (size_t)NROW * DM * 2;
constexpr size_t OFF_XC = OFF_P + SZ_P;
constexpr size_t SZ_XC = (size_t)Bsz * LC * DM * 4;
constexpr size_t OFF_T0 = OFF_XC + SZ_XC;
constexpr size_t SZ_T = (size_t)NROW * 256 * 2;
constexpr size_t WS_END = OFF_T0 + 3 * SZ_T;

struct Params {
    const float* in[23];
    float* out;
    unsigned char* ws;
};

__device__ __forceinline__ float bf2f(bf16_t v) { return __uint_as_float(((unsigned)v) << 16); }
__device__ __forceinline__ bf16_t f2bf(float f) {
    unsigned u = __float_as_uint(f);
    u += 0x7fffu + ((u >> 16) & 1u);
    return (bf16_t)(u >> 16);
}
__device__ __forceinline__ float sigmoidf_(float x) { return 1.f / (1.f + __expf(-x)); }
__device__ __forceinline__ float siluf_(float x) { return x / (1.f + __expf(-x)); }
__device__ __forceinline__ float softplusf_(float x) { return x > 20.f ? x : log1pf(__expf(x)); }

__device__ __forceinline__ float wave_sum(float v) {
#pragma unroll
    for (int o = 32; o >= 1; o >>= 1) v += __shfl_xor(v, o);
    return v;
}
__device__ __forceinline__ float block_sum(float v, float* red) {
    v = wave_sum(v);
    __syncthreads();
    if ((threadIdx.x & 63) == 0) red[threadIdx.x >> 6] = v;
    __syncthreads();
    return red[0] + red[1] + red[2] + red[3];
}

__device__ void phase_prep(const Params& p, char* smem) {
    const int tid = threadIdx.x;
    float* mod = (float*)(p.ws + OFF_MOD);
    bf16_t* wint = (bf16_t*)(p.ws + OFF_WINT);
    bf16_t* woutt = (bf16_t*)(p.ws + OFF_WOUTT);
    const int nA = 48, nB = 4 * 16 * 53, nC = 4 * 16 * 16;
    for (int it = blockIdx.x; it < nA + nB + nC; it += gridDim.x) {
        __syncthreads();
        if (it < nA) {
            float* s = (float*)smem;
            const int l = it / 12, col = (it % 12) * 256 + tid;
            for (int i = tid; i < 9 * 1024; i += NT) {
                const int r = i >> 10, k = i & 1023;
                const float cv = (r < 8) ? p.in[I_C][r * 1024 + k] : p.in[I_CCTX][k];
                s[i] = siluf_(cv);
            }
            __syncthreads();
            float acc[9];
#pragma unroll
            for (int r = 0; r < 9; ++r) acc[r] = 0.f;
            const float* w = p.in[I_WMOD] + (size_t)l * 1024 * 3072 + col;
            for (int k = 0; k < 1024; ++k) {
                const float wv = w[(size_t)k * 3072];
#pragma unroll
                for (int r = 0; r < 9; ++r) acc[r] += s[r * 1024 + k] * wv;
            }
            const float bm = p.in[I_BMOD][l * 3072 + col];
#pragma unroll
            for (int r = 0; r < 9; ++r) mod[(l * 9 + r) * 3072 + col] = acc[r] + bm;
        } else {
            float* tile = (float*)smem;
            const bool isin = it < nA + nB;
            const int id = isin ? it - nA : it - nA - nB;
            const int NN = isin ? INW : DM;
            const int ntn = isin ? 53 : 16;
            const int l = id / (16 * ntn), rem = id % (16 * ntn);
            const int k0 = (rem / ntn) * 64, n0 = (rem % ntn) * 64;
            const float* W = (isin ? p.in[I_WIN] : p.in[I_WOUT]) + (size_t)l * 1024 * NN;
            bf16_t* Wt = (isin ? wint : woutt) + (size_t)l * NN * 1024;
#pragma unroll
            for (int i = 0; i < 16; ++i) {
                const int r = i * 4 + (tid >> 6), cc = tid & 63;
                const int n = n0 + cc;
                tile[r * 65 + cc] = (n < NN) ? W[(size_t)(k0 + r) * NN + n] : 0.f;
            }
            __syncthreads();
#pragma unroll
            for (int i = 0; i < 16; ++i) {
                const int r2 = i * 4 + (tid >> 6), c2 = tid & 63;
                const int n = n0 + r2;
                if (n < NN) Wt[(size_t)n * 1024 + k0 + c2] = f2bf(tile[c2 * 65 + r2]);
            }
        }
    }
}

__device__ void phase_E(const Params& p, int l, char* smem) {
    const int tid = threadIdx.x;
    float* red = (float*)smem;
    const float* mod = (const float*)(p.ws + OFF_MOD);
    bf16_t* P = (bf16_t*)(p.ws + OFF_P);
    float* XC = (float*)(p.ws + OFF_XC);
    const int nrows = (l == 4) ? LAT : NROW;
    const int col = tid * 4;
    for (int row = blockIdx.x; row < nrows; row += gridDim.x) {
        const bool isctx = row >= LAT;
        const int mr = isctx ? 8 : row / T;
        float* xcur = isctx ? XC + (size_t)(row - LAT) * DM + col : p.out + (size_t)row * DM + col;
        float4 xv;
        if (l == 0) {
            const float* src = isctx ? p.in[I_CTX] + (size_t)(row - LAT) * DM + col : p.in[I_X] + (size_t)row * DM + col;
            xv = *(const float4*)src;
        } else {
            xv = *(const float4*)xcur;
            const uint2 yr = *(const uint2*)(P + (size_t)row * DM + col);
            const float y0 = bf2f((bf16_t)(yr.x & 0xffff)), y1 = bf2f((bf16_t)(yr.x >> 16));
            const float y2 = bf2f((bf16_t)(yr.y & 0xffff)), y3 = bf2f((bf16_t)(yr.y >> 16));
            const float ss = block_sum(y0 * y0 + y1 * y1 + y2 * y2 + y3 * y3, red);
            const float rs = rsqrtf(ss * (1.f / DM) + EPS);
            const float4 g = *(const float4*)(mod + ((l - 1) * 9 + mr) * 3072 + 2048 + col);
            const float4 pg = *(const float4*)(p.in[I_POSTG] + (l - 1) * DM + col);
            xv.x += g.x * (y0 * rs * pg.x);
            xv.y += g.y * (y1 * rs * pg.y);
            xv.z += g.z * (y2 * rs * pg.z);
            xv.w += g.w * (y3 * rs * pg.w);
        }
        *(float4*)xcur = xv;
        if (l < 4) {
            const float ss2 = block_sum(xv.x * xv.x + xv.y * xv.y + xv.z * xv.z + xv.w * xv.w, red);
            const float rs2 = rsqrtf(ss2 * (1.f / DM) + EPS);
            const float4 pg = *(const float4*)(p.in[I_PREG] + l * DM + col);
            const float4 sh = *(const float4*)(mod + (l * 9 + mr) * 3072 + col);
            const float4 sc = *(const float4*)(mod + (l * 9 + mr) * 3072 + 1024 + col);
            const float h0 = xv.x * rs2 * pg.x * (1.f + sc.x) + sh.x;
            const float h1 = xv.y * rs2 * pg.y * (1.f + sc.y) + sh.y;
            const float h2 = xv.z * rs2 * pg.z * (1.f + sc.z) + sh.z;
            const float h3 = xv.w * rs2 * pg.w * (1.f + sc.w) + sh.w;
            uint2 hv;
            hv.x = (unsigned)f2bf(h0) | ((unsigned)f2bf(h1) << 16);
            hv.y = (unsigned)f2bf(h2) | ((unsigned)f2bf(h3) << 16);
            *(uint2*)(P + (size_t)row * DM + col) = hv;
        }
    }
}

template <bool OUTP>
__device__ void phase_gemm(const Params& p, int l, char* smem) {
    constexpr int BK = 32, LDS_S = 40;
    bf16_t* sA = (bf16_t*)smem;
    bf16_t* sB = sA + 128 * LDS_S;
    const int tid = threadIdx.x, lane = tid & 63, wave = tid >> 6, wm = wave >> 1, wn = wave & 1;
    const int N = OUTP ? DM : INW;
    const int mtiles = OUTP ? ((l == 3) ? LAT / 128 : NROW / 128) : NROW / 128;
    const int ntiles = (N + 127) / 128;
    const bf16_t* A = OUTP ? (const bf16_t*)(p.ws + OFF_U) : (const bf16_t*)(p.ws + OFF_P);
    const int lda = OUTP ? INW : DM;
    const bf16_t* Wt = OUTP ? (const bf16_t*)(p.ws + OFF_WOUTT) + (size_t)l * DM * DM
                            : (const bf16_t*)(p.ws + OFF_WINT) + (size_t)l * INW * DM;
    bf16_t* C = OUTP ? (bf16_t*)(p.ws + OFF_P) : (bf16_t*)(p.ws + OFF_U);
    const int ldc = OUTP ? DM : INW;

    for (int tile = blockIdx.x; tile < mtiles * ntiles; tile += gridDim.x) {
        const int tm = tile / ntiles, tn = tile % ntiles;
        f32x4 acc[4][4];
#pragma unroll
        for (int m = 0; m < 4; ++m)
#pragma unroll
            for (int n = 0; n < 4; ++n) acc[m][n] = (f32x4){0.f, 0.f, 0.f, 0.f};

        const int r0_ = tid >> 2, kc_ = (tid & 3) * 8;
        const bf16_t* aptr0 = A + (size_t)(tm * 128 + r0_) * lda + kc_;
        const bf16_t* aptr1 = A + (size_t)(tm * 128 + r0_ + 64) * lda + kc_;
        int n0_ = tn * 128 + r0_, n1_ = tn * 128 + r0_ + 64;
        if (n0_ > N - 1) n0_ = N - 1;
        if (n1_ > N - 1) n1_ = N - 1;
        const bf16_t* bptr0 = Wt + (size_t)n0_ * DM + kc_;
        const bf16_t* bptr1 = Wt + (size_t)n1_ * DM + kc_;
        const int lofs0 = r0_ * LDS_S + kc_, lofs1 = (r0_ + 64) * LDS_S + kc_;
        uint4 ra0, ra1, rb0, rb1;
#define GLOAD(k0_)                                                                                   \
    {                                                                                                \
        const int k0__ = (k0_);                                                                      \
        int acol;                                                                                    \
        if (OUTP) {                                                                                  \
            const int g = k0__ >> 8;                                                                 \
            const int zoff = (g == 0) ? C_LRUZ : (g == 1) ? C_GZ : (g == 2) ? C_RZ : C_SZ;           \
            acol = zoff + (k0__ & 255);                                                              \
        } else {                                                                                     \
            acol = k0__;                                                                             \
        }                                                                                            \
        ra0 = *(const uint4*)(aptr0 + acol);                                                         \
        ra1 = *(const uint4*)(aptr1 + acol);                                                         \
        rb0 = *(const uint4*)(bptr0 + k0__);                                                         \
        rb1 = *(const uint4*)(bptr1 + k0__);                                                         \
    }
        GLOAD(0);
        for (int k0 = 0; k0 < DM; k0 += BK) {
            __syncthreads();
            *(uint4*)(sA + lofs0) = ra0;
            *(uint4*)(sA + lofs1) = ra1;
            *(uint4*)(sB + lofs0) = rb0;
            *(uint4*)(sB + lofs1) = rb1;
            __syncthreads();
            if (k0 + BK < DM) GLOAD(k0 + BK);
            bf16x8 af[4], bfr[4];
#pragma unroll
            for (int m = 0; m < 4; ++m)
                af[m] = *(const bf16x8*)(sA + (wm * 64 + m * 16 + (lane & 15)) * LDS_S + (lane >> 4) * 8);
#pragma unroll
            for (int n = 0; n < 4; ++n)
                bfr[n] = *(const bf16x8*)(sB + (wn * 64 + n * 16 + (lane & 15)) * LDS_S + (lane >> 4) * 8);
#pragma unroll
            for (int m = 0; m < 4; ++m)
#pragma unroll
                for (int n = 0; n < 4; ++n)
                    acc[m][n] = __builtin_amdgcn_mfma_f32_16x16x32_bf16(af[m], bfr[n], acc[m][n], 0, 0, 0);
        }
#pragma unroll
        for (int m = 0; m < 4; ++m)
#pragma unroll
            for (int n = 0; n < 4; ++n) {
                const int gcol = tn * 128 + wn * 64 + n * 16 + (lane & 15);
                if (gcol < N) {
#pragma unroll
                    for (int r = 0; r < 4; ++r) {
                        const int grow = tm * 128 + wm * 64 + m * 16 + (lane >> 4) * 4 + r;
                        C[(size_t)grow * ldc + gcol] = f2bf(acc[m][n][r]);
                    }
                }
            }
    }
}

struct ChunkInfo {
    bool isctx;
    int t0, Tseg;
    size_t rowbase;
};
template <int CH>
__device__ __forceinline__ ChunkInfo chunk_info(int ci, int dir, int b) {
    constexpr int NC = LC / CH, NL = T / CH;
    ChunkInfo c;
    c.isctx = ci < NC;
    const int cidx = c.isctx ? ci : ci - NC;
    const int nch = c.isctx ? NC : NL;
    const int chunk = dir ? (nch - 1 - cidx) : cidx;
    c.Tseg = c.isctx ? LC : T;
    c.rowbase = c.isctx ? (size_t)LAT + (size_t)b * LC : (size_t)b * T;
    c.t0 = chunk * CH;
    return c;
}

__device__ void phase_lru(const Params& p, int l, char* smem) {
    constexpr int CH = 64;
    float* xb = (float*)smem;
    float* uc = xb + (CH + 3) * 64;
    float* hb = uc + CH * 64;
    bf16_t* U = (bf16_t*)(p.ws + OFF_U);
    bf16_t* TMP = (bf16_t*)(p.ws + OFF_T0);
    const int tid = threadIdx.x;
    const bool with_ctx = l < 3;
    for (int it = blockIdx.x; it < 32; it += gridDim.x) {
        const int b = it >> 2, n = it & 3;
        const int d = tid >> 2, kg = tid & 3, ch = n * 64 + d;
        for (int pass = 0; pass < 2; ++pass) {
            const int dir = 1 - pass;
            float wr[16], wi[16];
#pragma unroll
            for (int i = 0; i < 16; ++i) {
                const size_t wo = ((size_t)((l * 2 + dir) * 4 + n) * 64 + (kg * 16 + i)) * 64 + d;
                wr[i] = p.in[I_LWR][wo];
                wi[i] = p.in[I_LWI][wo];
            }
            const float br = p.in[I_LBR][(l * 2 + dir) * 256 + ch];
            const float bi = p.in[I_LBI][(l * 2 + dir) * 256 + ch];
            const float sp = softplusf_(-p.in[I_LLAM][(l * 2 + dir) * 256 + ch]);
            float h = 0.f;
            for (int ci = 0; ci < (LC + T) / CH; ++ci) {
                const ChunkInfo c = chunk_info<CH>(ci, dir, b);
                __syncthreads();
                for (int idx = tid; idx < (CH + 3) * 64; idx += NT) {
                    const int r = idx >> 6, cc = idx & 63, t = c.t0 - 2 + r;
                    xb[idx] = (t >= 0 && t < c.Tseg) ? bf2f(U[(c.rowbase + t) * INW + C_LRUX + n * 64 + cc]) : 0.f;
                }
                __syncthreads();
                for (int idx = tid; idx < CH * 64; idx += NT) {
                    const int t = idx >> 6, cc = idx & 63;
                    float a = p.in[I_LCB][l * 256 + n * 64 + cc];
#pragma unroll
                    for (int j = 0; j < 4; ++j) a += p.in[I_LCW][(l * 4 + j) * 256 + n * 64 + cc] * xb[(t + j) * 64 + cc];
                    uc[idx] = a;
                }
                __syncthreads();
                for (int tt = 0; tt < CH; ++tt) {
                    const int t = dir ? (CH - 1 - tt) : tt;
                    float pr = 0.f, pi = 0.f;
#pragma unroll
                    for (int i = 0; i < 16; ++i) {
                        const float u = uc[t * 64 + kg * 16 + i];
                        pr += u * wr[i];
                        pi += u * wi[i];
                    }
                    pr += __shfl_xor(pr, 1); pr += __shfl_xor(pr, 2);
                    pi += __shfl_xor(pi, 1); pi += __shfl_xor(pi, 2);
                    const float r = sigmoidf_(pr + br), ig = sigmoidf_(pi + bi);
                    const float la = -8.f * r * sp;
                    const float a = __expf(la);
                    const float mult = sqrtf(fmaxf(0.f, -expm1f(2.f * la)));
                    h = a * h + mult * ig * uc[t * 64 + d];
                    if (kg == 0) hb[t * 65 + d] = h;
                }
                __syncthreads();
                if (!c.isctx || with_ctx) {
                    const int t = tid >> 2, pr = tid & 3;
                    const size_t row = c.rowbase + c.t0 + t;
                    if (dir == 1) {
#pragma unroll
                        for (int i = 0; i < 16; ++i) TMP[row * 256 + n * 64 + pr * 16 + i] = f2bf(hb[t * 65 + pr * 16 + i]);
                    } else {
#pragma unroll
                        for (int i = 0; i < 16; ++i) {
                            const int cc = n * 64 + pr * 16 + i;
                            const float hs = hb[t * 65 + pr * 16 + i] + bf2f(TMP[row * 256 + cc]);
                            const float z = bf2f(U[row * INW + C_LRUZ + cc]);
                            U[row * INW + C_LRUZ + cc] = f2bf(hs * siluf_(z));
                        }
                    }
                }
            }
        }
    }
}

__device__ void phase_gdn(const Params& p, int l, char* smem) {
    constexpr int CH = 32;
    bf16_t* raw = (bf16_t*)smem;
    float* cv = (float*)(smem + ((CH + 3) * 192 * 2 + 15) / 16 * 16);
    float* ob = cv + CH * 193;
    float* egs = ob + CH * 65;
    float* bts = egs + CH;
    bf16_t* U = (bf16_t*)(p.ws + OFF_U);
    bf16_t* TMP = (bf16_t*)(p.ws + OFF_T0 + SZ_T);
    const int tid = threadIdx.x;
    const bool with_ctx = l < 3;
    for (int it = blockIdx.x; it < 32; it += gridDim.x) {
        const int b = it >> 2, h = it & 3;
        const int e = tid >> 2, dg = tid & 3;
        for (int pass = 0; pass < 2; ++pass) {
            const int dir = 1 - pass;
            float S[16];
#pragma unroll
            for (int i = 0; i < 16; ++i) S[i] = 0.f;
            const float neg_ea = -__expf(p.in[I_GALOG][(l * 2 + dir) * 4 + h]);
            const float dtb = p.in[I_GDT][(l * 2 + dir) * 4 + h];
            for (int ci = 0; ci < (LC + T) / CH; ++ci) {
                const ChunkInfo c = chunk_info<CH>(ci, dir, b);
                __syncthreads();
                for (int idx = tid; idx < (CH + 3) * 24; idx += NT) {
                    const int r = idx / 24, c8 = idx % 24, t = c.t0 - 2 + r;
                    uint4 v = make_uint4(0, 0, 0, 0);
                    if (t >= 0 && t < c.Tseg)
                        v = *(const uint4*)(U + (c.rowbase + t) * INW + C_GQ + (c8 >> 3) * 256 + h * 64 + (c8 & 7) * 8);
                    *(uint4*)(raw + r * 192 + c8 * 8) = v;
                }
                if (tid < CH) {
                    const size_t row = c.rowbase + c.t0 + tid;
                    const float alpha = bf2f(U[row * INW + C_GA + dir * 4 + h]);
                    const float beta = bf2f(U[row * INW + C_GB + dir * 4 + h]);
                    egs[tid] = __expf(neg_ea * softplusf_(alpha + dtb));
                    bts[tid] = sigmoidf_(beta);
                }
                __syncthreads();
                for (int idx = tid; idx < CH * 192; idx += NT) {
                    const int t = idx / 192, cc = idx % 192;
                    const int gc = (cc >> 6) * 256 + h * 64 + (cc & 63);
                    float a = 0.f;
#pragma unroll
                    for (int j = 0; j < 4; ++j) a += p.in[I_GCW][(l * 4 + j) * 768 + gc] * bf2f(raw[(t + j) * 192 + cc]);
                    cv[t * 193 + cc] = siluf_(a);
                }
                __syncthreads();
                if (tid < CH * 4) {
                    const int t = tid >> 2, pr = tid & 3;
                    float sq = 0.f, sk = 0.f;
#pragma unroll
                    for (int i = 0; i < 16; ++i) {
                        const float q = cv[t * 193 + pr * 16 + i], k = cv[t * 193 + 64 + pr * 16 + i];
                        sq += q * q;
                        sk += k * k;
                    }
                    sq += __shfl_xor(sq, 1); sq += __shfl_xor(sq, 2);
                    sk += __shfl_xor(sk, 1); sk += __shfl_xor(sk, 2);
                    const float rq = rsqrtf(sq + EPS) * 0.125f, rk = rsqrtf(sk + EPS);
#pragma unroll
                    for (int i = 0; i < 16; ++i) {
                        cv[t * 193 + pr * 16 + i] *= rq;
                        cv[t * 193 + 64 + pr * 16 + i] *= rk;
                    }
                }
                __syncthreads();
                for (int tt = 0; tt < CH; ++tt) {
                    const int t = dir ? (CH - 1 - tt) : tt;
                    const float eg = egs[t], bt = bts[t];
                    const float* qr = cv + t * 193 + dg * 16;
                    const float* kr = qr + 64;
                    const float vv = cv[t * 193 + 128 + e];
                    float dot = 0.f;
#pragma unroll
                    for (int i = 0; i < 16; ++i) {
                        S[i] *= eg;
                        dot += S[i] * kr[i];
                    }
                    dot += __shfl_xor(dot, 1); dot += __shfl_xor(dot, 2);
                    const float vn = bt * (vv - dot);
                    float o = 0.f;
#pragma unroll
                    for (int i = 0; i < 16; ++i) {
                        S[i] += kr[i] * vn;
                        o += S[i] * qr[i];
                    }
                    o += __shfl_xor(o, 1); o += __shfl_xor(o, 2);
                    if (dg == 0) ob[t * 65 + e] = o;
                }
                __syncthreads();
                if ((!c.isctx || with_ctx) && tid < CH * 4) {
                    const int t = tid >> 2, pr = tid & 3;
                    const size_t row = c.rowbase + c.t0 + t;
                    if (dir == 1) {
#pragma unroll
                        for (int i = 0; i < 16; ++i) TMP[row * 256 + h * 64 + pr * 16 + i] = f2bf(ob[t * 65 + pr * 16 + i]);
                    } else {
                        float o16[16];
                        float ss = 0.f;
#pragma unroll
                        for (int i = 0; i < 16; ++i) {
                            o16[i] = ob[t * 65 + pr * 16 + i] + bf2f(TMP[row * 256 + h * 64 + pr * 16 + i]);
                            ss += o16[i] * o16[i];
                        }
                        ss += __shfl_xor(ss, 1); ss += __shfl_xor(ss, 2);
                        const float rs = rsqrtf(ss * (1.f / 64.f) + EPS);
#pragma unroll
                        for (int i = 0; i < 16; ++i) {
                            const int e2 = pr * 16 + i;
                            const float z = bf2f(U[row * INW + C_GZ + h * 64 + e2]);
                            U[row * INW + C_GZ + h * 64 + e2] = f2bf(o16[i] * rs * p.in[I_GNG][l * 64 + e2] * siluf_(z));
                        }
                    }
                }
            }
        }
    }
}

__device__ void phase_ret(const Params& p, int l, char* smem) {
    constexpr int CH = 32;
    float* sq = (float*)smem;
    float* sk = sq + CH * 64;
    float* sv = sk + CH * 64;
    float* ob = sv + CH * 64;
    bf16_t* U = (bf16_t*)(p.ws + OFF_U);
    bf16_t* TMP = (bf16_t*)(p.ws + OFF_T0 + 2 * SZ_T);
    const int tid = threadIdx.x;
    const bool with_ctx = l < 3;
    for (int it = blockIdx.x; it < 32; it += gridDim.x) {
        const int b = it >> 2, h = it & 3;
        const int e = tid >> 2, dg = tid & 3;
        for (int pass = 0; pass < 2; ++pass) {
            const int dir = 1 - pass;
            float S[16];
#pragma unroll
            for (int i = 0; i < 16; ++i) S[i] = 0.f;
            const float gamma = sigmoidf_(p.in[I_RDEC][(l * 2 + dir) * 4 + h]);
            for (int ci = 0; ci < (LC + T) / CH; ++ci) {
                const ChunkInfo c = chunk_info<CH>(ci, dir, b);
                __syncthreads();
                if (tid < CH * 4) {
                    const int t = tid >> 2, pr = tid & 3;
                    const size_t row = c.rowbase + c.t0 + t;
#pragma unroll
                    for (int i = 0; i < 16; ++i) {
                        const int dd = pr * 16 + i;
                        sq[t * 64 + dd] = bf2f(U[row * INW + C_RQ + h * 64 + dd]);
                        sk[t * 64 + dd] = bf2f(U[row * INW + C_RK + h * 64 + dd]) * 0.125f;
                        sv[t * 64 + dd] = bf2f(U[row * INW + C_RV + h * 64 + dd]);
                    }
                }
                __syncthreads();
                if (!c.isctx && tid < CH * 4) {
                    const int t = tid >> 2, pr = tid & 3;
                    const float pos = (float)(c.t0 + t);
#pragma unroll
                    for (int ii = 0; ii < 8; ++ii) {
                        const int i = pr * 8 + ii;
                        const float inv = expf(-(float)i * (9.210340371976184f / 32.f));
                        const float ang = pos * inv;
                        const float cs = cosf(ang), sn = sinf(ang);
                        const float q1 = sq[t * 64 + i], q2 = sq[t * 64 + i + 32];
                        sq[t * 64 + i] = q1 * cs - q2 * sn;
                        sq[t * 64 + i + 32] = q1 * sn + q2 * cs;
                        const float k1 = sk[t * 64 + i], k2 = sk[t * 64 + i + 32];
                        sk[t * 64 + i] = k1 * cs - k2 * sn;
                        sk[t * 64 + i + 32] = k1 * sn + k2 * cs;
                    }
                }
                __syncthreads();
                for (int tt = 0; tt < CH; ++tt) {
                    const int t = dir ? (CH - 1 - tt) : tt;
                    const float vv = sv[t * 64 + e];
                    float o = 0.f;
#pragma unroll
                    for (int i = 0; i < 16; ++i) {
                        S[i] = gamma * S[i] + sk[t * 64 + dg * 16 + i] * vv;
                        o += sq[t * 64 + dg * 16 + i] * S[i];
                    }
                    o += __shfl_xor(o, 1); o += __shfl_xor(o, 2);
                    if (dg == 0) ob[t * 65 + e] = o;
                }
                __syncthreads();
                if ((!c.isctx || with_ctx) && tid < CH * 4) {
                    const int t = tid >> 2, pr = tid & 3;
                    const size_t row = c.rowbase + c.t0 + t;
                    if (dir == 1) {
#pragma unroll
                        for (int i = 0; i < 16; ++i) TMP[row * 256 + h * 64 + pr * 16 + i] = f2bf(ob[t * 65 + pr * 16 + i]);
                    } else {
                        float o16[16];
                        float s1 = 0.f;
#pragma unroll
                        for (int i = 0; i < 16; ++i) {
                            o16[i] = ob[t * 65 + pr * 16 + i] + bf2f(TMP[row * 256 + h * 64 + pr * 16 + i]);
                            s1 += o16[i];
                        }
                        s1 += __shfl_xor(s1, 1); s1 += __shfl_xor(s1, 2);
                        const float mu = s1 * (1.f / 64.f);
                        float s2 = 0.f;
#pragma unroll
                        for (int i = 0; i < 16; ++i) {
                            const float dd = o16[i] - mu;
                            s2 += dd * dd;
                        }
                        s2 += __shfl_xor(s2, 1); s2 += __shfl_xor(s2, 2);
                        const float rs = rsqrtf(s2 * (1.f / 64.f) + EPS);
#pragma unroll
                        for (int i = 0; i < 16; ++i) {
                            const int e2 = pr * 16 + i;
                            const float z = bf2f(U[row * INW + C_RZ + h * 64 + e2]);
                            U[row * INW + C_RZ + h * 64 + e2] = f2bf((o16[i] - mu) * rs * siluf_(z));
                        }
                    }
                }
            }
        }
    }
}

__device__ void phase_swa(const Params& p, int l, char* smem) {
    float* sK = (float*)smem;
    float* sV = sK + 64 * 68;
    bf16_t* U = (bf16_t*)(p.ws + OFF_U);
    const int tid = threadIdx.x;
    const bool with_ctx = l < 3;
    const int nlat = 8 * 4 * 32, nctx = with_ctx ? 8 * 4 * 4 : 0;
    for (int it = blockIdx.x; it < nlat + nctx; it += gridDim.x) {
        const bool cq = it >= nlat;
        const int id = cq ? it - nlat : it;
        int qt, hq, b;
        if (!cq) { qt = id & 31; hq = (id >> 5) & 3; b = id >> 7; }
        else     { qt = id & 3;  hq = (id >> 2) & 3; b = id >> 4; }
        const int kvh = hq >> 1;
        const int qi = tid >> 2, part = tid & 3;
        const int tq = qt * 64 + qi;
        const size_t qrow = cq ? (size_t)LAT + b * LC + tq : (size_t)b * T + tq;
        float q[64];
        {
            const bf16_t* qp = U + qrow * INW + C_SQ + hq * 64;
#pragma unroll
            for (int j = 0; j < 64; ++j) q[j] = bf2f(qp[j]);
        }
        if (!cq) {
            const float prow = (float)(tq >> 6), pcol = (float)(tq & 63);
#pragma unroll
            for (int i = 0; i < 32; ++i) {
                const float inv = expf(-(float)(i & 15) * (9.210340371976184f / 16.f));
                const float ang = ((i < 16) ? prow : pcol) * inv;
                const float cs = __cosf(ang), sn = __sinf(ang);
                const float x1 = q[i], x2 = q[i + 32];
                q[i] = x1 * cs - x2 * sn;
                q[i + 32] = x1 * sn + x2 * cs;
            }
        }
#pragma unroll
        for (int j = 0; j < 64; ++j) q[j] *= 0.125f;
        float m = -1e30f, lsum = 0.f, acc[64];
#pragma unroll
        for (int j = 0; j < 64; ++j) acc[j] = 0.f;
        const int nloc = cq ? 0 : 5;
        for (int ti = 0; ti < nloc + 4; ++ti) {
            const bool kctx = ti >= nloc;
            const int ktile = kctx ? ti - nloc : qt - 2 + ti;
            if (!kctx && (ktile < 0 || ktile >= 32)) continue;
            __syncthreads();
            {
                const int kk = tid >> 2, d0 = (tid & 3) * 16;
                const int tk = ktile * 64 + kk;
                const size_t krow = kctx ? (size_t)LAT + b * LC + tk : (size_t)b * T + tk;
#pragma unroll
                for (int i = 0; i < 16; ++i) {
                    sK[kk * 68 + d0 + i] = bf2f(U[krow * INW + C_SK + kvh * 64 + d0 + i]);
                    sV[kk * 68 + d0 + i] = bf2f(U[krow * INW + C_SV + kvh * 64 + d0 + i]);
                }
            }
            __syncthreads();
            if (!kctx) {
                const int kk = tid >> 2, pr = tid & 3;
                const int tk = ktile * 64 + kk;
                const float prow = (float)(tk >> 6), pcol = (float)(tk & 63);
#pragma unroll
                for (int ii = 0; ii < 8; ++ii) {
                    const int i = pr * 8 + ii;
                    const float inv = expf(-(float)(i & 15) * (9.210340371976184f / 16.f));
                    const float ang = ((i < 16) ? prow : pcol) * inv;
                    const float cs = __cosf(ang), sn = __sinf(ang);
                    const float x1 = sK[kk * 68 + i], x2 = sK[kk * 68 + i + 32];
                    sK[kk * 68 + i] = x1 * cs - x2 * sn;
                    sK[kk * 68 + i + 32] = x1 * sn + x2 * cs;
                }
                __syncthreads();
            }
            for (int jj = 0; jj < 16; ++jj) {
                const int j = jj * 4 + part;
                const int tk = ktile * 64 + j;
                int dlt = tk - tq;
                dlt = dlt < 0 ? -dlt : dlt;
                const bool valid = kctx || (dlt <= 128);
                if (valid) {
                    float s = 0.f;
#pragma unroll
                    for (int d = 0; d < 64; ++d) s += q[d] * sK[j * 68 + d];
                    if (s > m) {
                        const float sc = __expf(m - s);
                        lsum *= sc;
#pragma unroll
                        for (int d = 0; d < 64; ++d) acc[d] *= sc;
                        m = s;
                    }
                    const float pw = __expf(s - m);
                    lsum += pw;
#pragma unroll
                    for (int d = 0; d < 64; ++d) acc[d] += pw * sV[j * 68 + d];
                }
            }
        }
#pragma unroll
        for (int off = 1; off <= 2; off <<= 1) {
            const float m2 = __shfl_xor(m, off), l2 = __shfl_xor(lsum, off);
            const float mn = fmaxf(m, m2);
            const float s1 = __expf(m - mn), s2 = __expf(m2 - mn);
            lsum = lsum * s1 + l2 * s2;
#pragma unroll
            for (int d = 0; d < 64; ++d) acc[d] = acc[d] * s1 + __shfl_xor(acc[d], off) * s2;
            m = mn;
        }
        const float snk = p.in[I_SINK][l * 4 + hq];
        const float mn = fmaxf(m, snk);
        const float s1 = __expf(m - mn);
        lsum = lsum * s1 + __expf(snk - mn);
        const float sc = s1 / lsum;
#pragma unroll
        for (int i = 0; i < 16; ++i) {
            const float a = (part == 0) ? acc[i] : (part == 1) ? acc[16 + i] : (part == 2) ? acc[32 + i] : acc[48 + i];
            const int e2 = part * 16 + i;
            const float z = bf2f(U[qrow * INW + C_SZ + hq * 64 + e2]);
            U[qrow * INW + C_SZ + hq * 64 + e2] = f2bf(a * sc * siluf_(z));
        }
    }
}

enum { PH_PREP = 0, PH_E, PH_GIN, PH_LRU, PH_GDN, PH_RET, PH_SWA, PH_GOUT };

template <int PH>
__global__ void __launch_bounds__(NT) k_phase(Params p, int l) {
    extern __shared__ __attribute__((aligned(16))) char smem[];
    if constexpr (PH == PH_PREP) phase_prep(p, smem);
    if constexpr (PH == PH_E) phase_E(p, l, smem);
    if constexpr (PH == PH_GIN) phase_gemm<false>(p, l, smem);
    if constexpr (PH == PH_LRU) phase_lru(p, l, smem);
    if constexpr (PH == PH_GDN) phase_gdn(p, l, smem);
    if constexpr (PH == PH_RET) phase_ret(p, l, smem);
    if constexpr (PH == PH_SWA) phase_swa(p, l, smem);
    if constexpr (PH == PH_GOUT) phase_gemm<true>(p, l, smem);
}

extern "C" void kernel_launch(void* const* d_in, const int* in_sizes, int n_in, void* d_out, int out_size, void* d_ws,
                              size_t ws_size, hipStream_t stream) {
    if (n_in != 23 || ws_size < WS_END) {
        fprintf(stderr, "kernel_launch: unexpected n_in %d or ws_size %zu (< %zu)\n", n_in, ws_size, (size_t)WS_END);
        return;
    }
    Params p{};
    for (int i = 0; i < 23; ++i) p.in[i] = (const float*)d_in[i];
    p.out = (float*)d_out;
    p.ws = (unsigned char*)d_ws;
    const size_t SM = 60 * 1024;
    hipLaunchKernelGGL(k_phase<PH_PREP>, dim3(2048), dim3(NT), SM, stream, p, 0);
    for (int l = 0; l < 4; ++l) {
        hipLaunchKernelGGL(k_phase<PH_E>, dim3(4096), dim3(NT), SM, stream, p, l);
        hipLaunchKernelGGL(k_phase<PH_GIN>, dim3(2048), dim3(NT), SM, stream, p, l);
        hipLaunchKernelGGL(k_phase<PH_LRU>, dim3(32), dim3(NT), SM, stream, p, l);
        hipLaunchKernelGGL(k_phase<PH_GDN>, dim3(32), dim3(NT), SM, stream, p, l);
        hipLaunchKernelGGL(k_phase<PH_RET>, dim3(32), dim3(NT), SM, stream, p, l);
        hipLaunchKernelGGL(k_phase<PH_SWA>, dim3(1152), dim3(NT), SM, stream, p, l);
        hipLaunchKernelGGL(k_phase<PH_GOUT>, dim3(1152), dim3(NT), SM, stream, p, l);
    }
    hipLaunchKernelGGL(k_phase<PH_E>, dim3(4096), dim3(NT), SM, stream, p, 4);
}
```

```cpp
#include <hip/hip_runtime.h>
#include <hip/hip_bf16.h>
#include <cstdio>
#include <cstdint>

typedef unsigned short bf16_t;
typedef __attribute__((ext_vector_type(8))) short bf16x8;
typedef __attribute__((ext_vector_type(4))) float f32x4;

#define NT 256
constexpr int Bsz = 8, T = 2048, LC = 256, DM = 1024, INW = 3344;
constexpr int LAT = Bsz * T, NROW = LAT + Bsz * LC;
constexpr int C_LRUX = 0, C_LRUZ = 256, C_GQ = 512, C_GZ = 1280, C_GA = 1536, C_GB = 1544;
constexpr int C_RQ = 1552, C_RK = 1808, C_RV = 2064, C_RZ = 2320, C_SQ = 2576, C_SK = 2832, C_SV = 2960, C_SZ = 3088;
constexpr float EPS = 1e-6f;

enum { I_X = 0, I_C, I_CTX, I_CCTX, I_WMOD, I_BMOD, I_PREG, I_POSTG, I_WIN, I_WOUT, I_LCW, I_LCB, I_LWR, I_LBR, I_LWI, I_LBI,
       I_LLAM, I_GCW, I_GALOG, I_GDT, I_GNG, I_RDEC, I_SINK };

constexpr size_t OFF_MOD = 0;
constexpr size_t OFF_WINT = 1u << 19;
constexpr size_t SZ_WINT = 4ull * INW * DM * 2;
constexpr size_t OFF_WOUTT = OFF_WINT + SZ_WINT;
constexpr size_t SZ_WOUTT = 4ull * DM * DM * 2;
constexpr size_t OFF_U = OFF_WOUTT + SZ_WOUTT;
constexpr size_t SZ_U = (size_t)NROW * INW * 2;
constexpr size_t OFF_P = OFF_U + SZ_U;
constexpr size_t SZ_P = (size_t)NROW * DM * 2;
constexpr size_t OFF_XC = OFF_P + SZ_P;
constexpr size_t SZ_XC = (size_t)Bsz * LC * DM * 4;
constexpr size_t OFF_T0 = OFF_XC + SZ_XC;
constexpr size_t SZ_T = (size_t)NROW * 256 * 2;
constexpr size_t WS_END = OFF_T0 + 3 * SZ_T;

struct Params {
    const float* in[23];
    float* out;
    unsigned char* ws;
};

__device__ __forceinline__ float bf2f(bf16_t v) { return __uint_as_float(((unsigned)v) << 16); }
__device__ __forceinline__ bf16_t f2bf(float f) {
    unsigned u = __float_as_uint(f);
    u += 0x7fffu + ((u >> 16) & 1u);
    return (bf16_t)(u >> 16);
}
__device__ __forceinline__ float sigmoidf_(float x) { return 1.f / (1.f + __expf(-x)); }
__device__ __forceinline__ float siluf_(float x) { return x / (1.f + __expf(-x)); }
__device__ __forceinline__ float softplusf_(float x) { return x > 20.f ? x : log1pf(__expf(x)); }

__device__ __forceinline__ float wave_sum(float v) {
#pragma unroll
    for (int o = 32; o >= 1; o >>= 1) v += __shfl_xor(v, o);
    return v;
}
__device__ __forceinline__ float block_sum(float v, float* red) {
    v = wave_sum(v);
    __syncthreads();
    if ((threadIdx.x & 63) == 0) red[threadIdx.x >> 6] = v;
    __syncthreads();
    return red[0] + red[1] + red[2] + red[3];
}

__device__ void phase_prep(const Params& p, char* smem, int vb, int nvb) {
    const int tid = threadIdx.x;
    float* mod = (float*)(p.ws + OFF_MOD);
    bf16_t* wint = (bf16_t*)(p.ws + OFF_WINT);
    bf16_t* woutt = (bf16_t*)(p.ws + OFF_WOUTT);
    const int nA = 48, nB = 4 * 16 * 53, nC = 4 * 16 * 16;
    for (int it = vb; it < nA + nB + nC; it += nvb) {
        __syncthreads();
        if (it < nA) {
            float* s = (float*)smem;
            const int l = it / 12, col = (it % 12) * 256 + tid;
            for (int i = tid; i < 9 * 1024; i += NT) {
                const int r = i >> 10, k = i & 1023;
                const float cv = (r < 8) ? p.in[I_C][r * 1024 + k] : p.in[I_CCTX][k];
                s[i] = siluf_(cv);
            }
            __syncthreads();
            float acc[9];
#pragma unroll
            for (int r = 0; r < 9; ++r) acc[r] = 0.f;
            const float* w = p.in[I_WMOD] + (size_t)l * 1024 * 3072 + col;
            for (int k = 0; k < 1024; ++k) {
                const float wv = w[(size_t)k * 3072];
#pragma unroll
                for (int r = 0; r < 9; ++r) acc[r] += s[r * 1024 + k] * wv;
            }
            const float bm = p.in[I_BMOD][l * 3072 + col];
#pragma unroll
            for (int r = 0; r < 9; ++r) mod[(l * 9 + r) * 3072 + col] = acc[r] + bm;
        } else {
            float* tile = (float*)smem;
            const bool isin = it < nA + nB;
            const int id = isin ? it - nA : it - nA - nB;
            const int NN = isin ? INW : DM;
            const int ntn = isin ? 53 : 16;
            const int l = id / (16 * ntn), rem = id % (16 * ntn);
            const int k0 = (rem / ntn) * 64, n0 = (rem % ntn) * 64;
            const float* W = (isin ? p.in[I_WIN] : p.in[I_WOUT]) + (size_t)l * 1024 * NN;
            bf16_t* Wt = (isin ? wint : woutt) + (size_t)l * NN * 1024;
#pragma unroll
            for (int i = 0; i < 16; ++i) {
                const int r = i * 4 + (tid >> 6), cc = tid & 63;
                const int n = n0 + cc;
                tile[r * 65 + cc] = (n < NN) ? W[(size_t)(k0 + r) * NN + n] : 0.f;
            }
            __syncthreads();
#pragma unroll
            for (int i = 0; i < 16; ++i) {
                const int r2 = i * 4 + (tid >> 6), c2 = tid & 63;
                const int n = n0 + r2;
                if (n < NN) Wt[(size_t)n * 1024 + k0 + c2] = f2bf(tile[c2 * 65 + r2]);
            }
        }
    }
}

__device__ void phase_E(const Params& p, int l, char* smem, int vb, int nvb) {
    const int tid = threadIdx.x;
    float* red = (float*)smem;
    const float* mod = (const float*)(p.ws + OFF_MOD);
    bf16_t* P = (bf16_t*)(p.ws + OFF_P);
    float* XC = (float*)(p.ws + OFF_XC);
    const int nrows = (l == 4) ? LAT : NROW;
    const int col = tid * 4;
    for (int row = vb; row < nrows; row += nvb) {
        const bool isctx = row >= LAT;
        const int mr = isctx ? 8 : row / T;
        float* xcur = isctx ? XC + (size_t)(row - LAT) * DM + col : p.out + (size_t)row * DM + col;
        float4 xv;
        if (l == 0) {
            const float* src = isctx ? p.in[I_CTX] + (size_t)(row - LAT) * DM + col : p.in[I_X] + (size_t)row * DM + col;
            xv = *(const float4*)src;
        } else {
            xv = *(const float4*)xcur;
            const uint2 yr = *(const uint2*)(P + (size_t)row * DM + col);
            const float y0 = bf2f((bf16_t)(yr.x & 0xffff)), y1 = bf2f((bf16_t)(yr.x >> 16));
            const float y2 = bf2f((bf16_t)(yr.y & 0xffff)), y3 = bf2f((bf16_t)(yr.y >> 16));
            const float ss = block_sum(y0 * y0 + y1 * y1 + y2 * y2 + y3 * y3, red);
            const float rs = rsqrtf(ss * (1.f / DM) + EPS);
            const float4 g = *(const float4*)(mod + ((l - 1) * 9 + mr) * 3072 + 2048 + col);
            const float4 pg = *(const float4*)(p.in[I_POSTG] + (l - 1) * DM + col);
            xv.x += g.x * (y0 * rs * pg.x);
            xv.y += g.y * (y1 * rs * pg.y);
            xv.z += g.z * (y2 * rs * pg.z);
            xv.w += g.w * (y3 * rs * pg.w);
        }
        *(float4*)xcur = xv;
        if (l < 4) {
            const float ss2 = block_sum(xv.x * xv.x + xv.y * xv.y + xv.z * xv.z + xv.w * xv.w, red);
            const float rs2 = rsqrtf(ss2 * (1.f / DM) + EPS);
            const float4 pg = *(const float4*)(p.in[I_PREG] + l * DM + col);
            const float4 sh = *(const float4*)(mod + (l * 9 + mr) * 3072 + col);
            const float4 sc = *(const float4*)(mod + (l * 9 + mr) * 3072 + 1024 + col);
            const float h0 = xv.x * rs2 * pg.x * (1.f + sc.x) + sh.x;
            const float h1 = xv.y * rs2 * pg.y * (1.f + sc.y) + sh.y;
            const float h2 = xv.z * rs2 * pg.z * (1.f + sc.z) + sh.z;
            const float h3 = xv.w * rs2 * pg.w * (1.f + sc.w) + sh.w;
            uint2 hv;
            hv.x = (unsigned)f2bf(h0) | ((unsigned)f2bf(h1) << 16);
            hv.y = (unsigned)f2bf(h2) | ((unsigned)f2bf(h3) << 16);
            *(uint2*)(P + (size_t)row * DM + col) = hv;
        }
    }
}

template <bool OUTP>
__device__ void phase_gemm(const Params& p, int l, char* smem, int vb, int nvb) {
    constexpr int BK = 32, LDS_S = 40;
    bf16_t* sA = (bf16_t*)smem;
    bf16_t* sB = sA + 128 * LDS_S;
    const int tid = threadIdx.x, lane = tid & 63, wave = tid >> 6, wm = wave >> 1, wn = wave & 1;
    const int N = OUTP ? DM : INW;
    const int mtiles = OUTP ? ((l == 3) ? LAT / 128 : NROW / 128) : NROW / 128;
    const int ntiles = (N + 127) / 128;
    const bf16_t* A = OUTP ? (const bf16_t*)(p.ws + OFF_U) : (const bf16_t*)(p.ws + OFF_P);
    const int lda = OUTP ? INW : DM;
    const bf16_t* Wt = OUTP ? (const bf16_t*)(p.ws + OFF_WOUTT) + (size_t)l * DM * DM
                            : (const bf16_t*)(p.ws + OFF_WINT) + (size_t)l * INW * DM;
    bf16_t* C = OUTP ? (bf16_t*)(p.ws + OFF_P) : (bf16_t*)(p.ws + OFF_U);
    const int ldc = OUTP ? DM : INW;

    for (int tile = vb; tile < mtiles * ntiles; tile += nvb) {
        const int tm = tile / ntiles, tn = tile % ntiles;
        f32x4 acc[4][4];
#pragma unroll
        for (int m = 0; m < 4; ++m)
#pragma unroll
            for (int n = 0; n < 4; ++n) acc[m][n] = (f32x4){0.f, 0.f, 0.f, 0.f};

        const int r0_ = tid >> 2, kc_ = (tid & 3) * 8;
        const bf16_t* aptr0 = A + (size_t)(tm * 128 + r0_) * lda + kc_;
        const bf16_t* aptr1 = A + (size_t)(tm * 128 + r0_ + 64) * lda + kc_;
        int n0_ = tn * 128 + r0_, n1_ = tn * 128 + r0_ + 64;
        if (n0_ > N - 1) n0_ = N - 1;
        if (n1_ > N - 1) n1_ = N - 1;
        const bf16_t* bptr0 = Wt + (size_t)n0_ * DM + kc_;
        const bf16_t* bptr1 = Wt + (size_t)n1_ * DM + kc_;
        const int lofs0 = r0_ * LDS_S + kc_, lofs1 = (r0_ + 64) * LDS_S + kc_;
        uint4 ra0, ra1, rb0, rb1;
#define GLOAD(k0_)                                                                                   \
    {                                                                                                \
        const int k0__ = (k0_);                                                                      \
        int acol;                                                                                    \
        if (OUTP) {                                                                                  \
            const int g = k0__ >> 8;                                                                 \
            const int zoff = (g == 0) ? C_LRUZ : (g == 1) ? C_GZ : (g == 2) ? C_RZ : C_SZ;           \
            acol = zoff + (k0__ & 255);                                                              \
        } else {                                                                                     \
            acol = k0__;                                                                             \
        }                                                                                            \
        ra0 = *(const uint4*)(aptr0 + acol);                                                         \
        ra1 = *(const uint4*)(aptr1 + acol);                                                         \
        rb0 = *(const uint4*)(bptr0 + k0__);                                                         \
        rb1 = *(const uint4*)(bptr1 + k0__);                                                         \
    }
        GLOAD(0);
        for (int k0 = 0; k0 < DM; k0 += BK) {
            __syncthreads();
            *(uint4*)(sA + lofs0) = ra0;
            *(uint4*)(sA + lofs1) = ra1;
            *(uint4*)(sB + lofs0) = rb0;
            *(uint4*)(sB + lofs1) = rb1;
            __syncthreads();
            if (k0 + BK < DM) GLOAD(k0 + BK);
            bf16x8 af[4], bfr[4];
#pragma unroll
            for (int m = 0; m < 4; ++m)
                af[m] = *(const bf16x8*)(sA + (wm * 64 + m * 16 + (lane & 15)) * LDS_S + (lane >> 4) * 8);
#pragma unroll
            for (int n = 0; n < 4; ++n)
                bfr[n] = *(const bf16x8*)(sB + (wn * 64 + n * 16 + (lane & 15)) * LDS_S + (lane >> 4) * 8);
#pragma unroll
            for (int m = 0; m < 4; ++m)
#pragma unroll
                for (int n = 0; n < 4; ++n)
                    acc[m][n] = __builtin_amdgcn_mfma_f32_16x16x32_bf16(af[m], bfr[n], acc[m][n], 0, 0, 0);
        }
#pragma unroll
        for (int m = 0; m < 4; ++m)
#pragma unroll
            for (int n = 0; n < 4; ++n) {
                const int gcol = tn * 128 + wn * 64 + n * 16 + (lane & 15);
                if (gcol < N) {
#pragma unroll
                    for (int r = 0; r < 4; ++r) {
                        const int grow = tm * 128 + wm * 64 + m * 16 + (lane >> 4) * 4 + r;
                        C[(size_t)grow * ldc + gcol] = f2bf(acc[m][n][r]);
                    }
                }
            }
    }
}

struct ChunkInfo {
    bool isctx;
    int t0, Tseg;
    size_t rowbase;
};
template <int CH>
__device__ __forceinline__ ChunkInfo chunk_info(int ci, int dir, int b) {
    constexpr int NC = LC / CH, NL = T / CH;
    ChunkInfo c;
    c.isctx = ci < NC;
    const int cidx = c.isctx ? ci : ci - NC;
    const int nch = c.isctx ? NC : NL;
    const int chunk = dir ? (nch - 1 - cidx) : cidx;
    c.Tseg = c.isctx ? LC : T;
    c.rowbase = c.isctx ? (size_t)LAT + (size_t)b * LC : (size_t)b * T;
    c.t0 = chunk * CH;
    return c;
}

__device__ void phase_lru(const Params& p, int l, char* smem, int vb, int nvb) {
    constexpr int CH = 64;
    float* xb = (float*)smem;
    float* uc = xb + (CH + 3) * 64;
    float* hb = uc + CH * 64;
    bf16_t* U = (bf16_t*)(p.ws + OFF_U);
    bf16_t* TMP = (bf16_t*)(p.ws + OFF_T0);
    const int tid = threadIdx.x;
    const bool with_ctx = l < 3;
    for (int it = vb; it < 32; it += nvb) {
        const int b = it >> 2, n = it & 3;
        const int d = tid >> 2, kg = tid & 3, ch = n * 64 + d;
        for (int pass = 0; pass < 2; ++pass) {
            const int dir = 1 - pass;
            float wr[16], wi[16];
#pragma unroll
            for (int i = 0; i < 16; ++i) {
                const size_t wo = ((size_t)((l * 2 + dir) * 4 + n) * 64 + (kg * 16 + i)) * 64 + d;
                wr[i] = p.in[I_LWR][wo];
                wi[i] = p.in[I_LWI][wo];
            }
            const float br = p.in[I_LBR][(l * 2 + dir) * 256 + ch];
            const float bi = p.in[I_LBI][(l * 2 + dir) * 256 + ch];
            const float sp = softplusf_(-p.in[I_LLAM][(l * 2 + dir) * 256 + ch]);
            float h = 0.f;
            for (int ci = 0; ci < (LC + T) / CH; ++ci) {
                const ChunkInfo c = chunk_info<CH>(ci, dir, b);
                __syncthreads();
                for (int idx = tid; idx < (CH + 3) * 64; idx += NT) {
                    const int r = idx >> 6, cc = idx & 63, t = c.t0 - 2 + r;
                    xb[idx] = (t >= 0 && t < c.Tseg) ? bf2f(U[(c.rowbase + t) * INW + C_LRUX + n * 64 + cc]) : 0.f;
                }
                __syncthreads();
                for (int idx = tid; idx < CH * 64; idx += NT) {
                    const int t = idx >> 6, cc = idx & 63;
                    float a = p.in[I_LCB][l * 256 + n * 64 + cc];
#pragma unroll
                    for (int j = 0; j < 4; ++j) a += p.in[I_LCW][(l * 4 + j) * 256 + n * 64 + cc] * xb[(t + j) * 64 + cc];
                    uc[idx] = a;
                }
                __syncthreads();
                for (int tt = 0; tt < CH; ++tt) {
                    const int t = dir ? (CH - 1 - tt) : tt;
                    float pr = 0.f, pi = 0.f;
#pragma unroll
                    for (int i = 0; i < 16; ++i) {
                        const float u = uc[t * 64 + kg * 16 + i];
                        pr += u * wr[i];
                        pi += u * wi[i];
                    }
                    pr += __shfl_xor(pr, 1); pr += __shfl_xor(pr, 2);
                    pi += __shfl_xor(pi, 1); pi += __shfl_xor(pi, 2);
                    const float r = sigmoidf_(pr + br), ig = sigmoidf_(pi + bi);
                    const float la = -8.f * r * sp;
                    const float a = __expf(la);
                    const float mult = sqrtf(fmaxf(0.f, -expm1f(2.f * la)));
                    h = a * h + mult * ig * uc[t * 64 + d];
                    if (kg == 0) hb[t * 65 + d] = h;
                }
                __syncthreads();
                if (!c.isctx || with_ctx) {
                    const int t = tid >> 2, pr = tid & 3;
                    const size_t row = c.rowbase + c.t0 + t;
                    if (dir == 1) {
#pragma unroll
                        for (int i = 0; i < 16; ++i) TMP[row * 256 + n * 64 + pr * 16 + i] = f2bf(hb[t * 65 + pr * 16 + i]);
                    } else {
#pragma unroll
                        for (int i = 0; i < 16; ++i) {
                            const int cc = n * 64 + pr * 16 + i;
                            const float hs = hb[t * 65 + pr * 16 + i] + bf2f(TMP[row * 256 + cc]);
                            const float z = bf2f(U[row * INW + C_LRUZ + cc]);
                            U[row * INW + C_LRUZ + cc] = f2bf(hs * siluf_(z));
                        }
                    }
                }
            }
        }
    }
}

__device__ void phase_gdn(const Params& p, int l, char* smem, int vb, int nvb) {
    constexpr int CH = 32;
    bf16_t* raw = (bf16_t*)smem;
    float* cv = (float*)(smem + ((CH + 3) * 192 * 2 + 15) / 16 * 16);
    float* ob = cv + CH * 193;
    float* egs = ob + CH * 65;
    float* bts = egs + CH;
    bf16_t* U = (bf16_t*)(p.ws + OFF_U);
    bf16_t* TMP = (bf16_t*)(p.ws + OFF_T0 + SZ_T);
    const int tid = threadIdx.x;
    const bool with_ctx = l < 3;
    for (int it = vb; it < 32; it += nvb) {
        const int b = it >> 2, h = it & 3;
        const int e = tid >> 2, dg = tid & 3;
        for (int pass = 0; pass < 2; ++pass) {
            const int dir = 1 - pass;
            float S[16];
#pragma unroll
            for (int i = 0; i < 16; ++i) S[i] = 0.f;
            const float neg_ea = -__expf(p.in[I_GALOG][(l * 2 + dir) * 4 + h]);
            const float dtb = p.in[I_GDT][(l * 2 + dir) * 4 + h];
            for (int ci = 0; ci < (LC + T) / CH; ++ci) {
                const ChunkInfo c = chunk_info<CH>(ci, dir, b);
                __syncthreads();
                for (int idx = tid; idx < (CH + 3) * 24; idx += NT) {
                    const int r = idx / 24, c8 = idx % 24, t = c.t0 - 2 + r;
                    uint4 v = make_uint4(0, 0, 0, 0);
                    if (t >= 0 && t < c.Tseg)
                        v = *(const uint4*)(U + (c.rowbase + t) * INW + C_GQ + (c8 >> 3) * 256 + h * 64 + (c8 & 7) * 8);
                    *(uint4*)(raw + r * 192 + c8 * 8) = v;
                }
                if (tid < CH) {
                    const size_t row = c.rowbase + c.t0 + tid;
                    const float alpha = bf2f(U[row * INW + C_GA + dir * 4 + h]);
                    const float beta = bf2f(U[row * INW + C_GB + dir * 4 + h]);
                    egs[tid] = __expf(neg_ea * softplusf_(alpha + dtb));
                    bts[tid] = sigmoidf_(beta);
                }
                __syncthreads();
                for (int idx = tid; idx < CH * 192; idx += NT) {
                    const int t = idx / 192, cc = idx % 192;
                    const int gc = (cc >> 6) * 256 + h * 64 + (cc & 63);
                    float a = 0.f;
#pragma unroll
                    for (int j = 0; j < 4; ++j) a += p.in[I_GCW][(l * 4 + j) * 768 + gc] * bf2f(raw[(t + j) * 192 + cc]);
                    cv[t * 193 + cc] = siluf_(a);
                }
                __syncthreads();
                if (tid < CH * 4) {
                    const int t = tid >> 2, pr = tid & 3;
                    float sq = 0.f, sk = 0.f;
#pragma unroll
                    for (int i = 0; i < 16; ++i) {
                        const float q = cv[t * 193 + pr * 16 + i], k = cv[t * 193 + 64 + pr * 16 + i];
                        sq += q * q;
                        sk += k * k;
                    }
                    sq += __shfl_xor(sq, 1); sq += __shfl_xor(sq, 2);
                    sk += __shfl_xor(sk, 1); sk += __shfl_xor(sk, 2);
                    const float rq = rsqrtf(sq + EPS) * 0.125f, rk = rsqrtf(sk + EPS);
#pragma unroll
                    for (int i = 0; i < 16; ++i) {
                        cv[t * 193 + pr * 16 + i] *= rq;
                        cv[t * 193 + 64 + pr * 16 + i] *= rk;
                    }
                }
                __syncthreads();
                for (int tt = 0; tt < CH; ++tt) {
                    const int t = dir ? (CH - 1 - tt) : tt;
                    const float eg = egs[t], bt = bts[t];
                    const float* qr = cv + t * 193 + dg * 16;
                    const float* kr = qr + 64;
                    const float vv = cv[t * 193 + 128 + e];
                    float dot = 0.f;
#pragma unroll
                    for (int i = 0; i < 16; ++i) {
                        S[i] *= eg;
                        dot += S[i] * kr[i];
                    }
                    dot += __shfl_xor(dot, 1); dot += __shfl_xor(dot, 2);
                    const float vn = bt * (vv - dot);
                    float o = 0.f;
#pragma unroll
                    for (int i = 0; i < 16; ++i) {
                        S[i] += kr[i] * vn;
                        o += S[i] * qr[i];
                    }
                    o += __shfl_xor(o, 1); o += __shfl_xor(o, 2);
                    if (dg == 0) ob[t * 65 + e] = o;
                }
                __syncthreads();
                if ((!c.isctx || with_ctx) && tid < CH * 4) {
                    const int t = tid >> 2, pr = tid & 3;
                    const size_t row = c.rowbase + c.t0 + t;
                    if (dir == 1) {
#pragma unroll
                        for (int i = 0; i < 16; ++i) TMP[row * 256 + h * 64 + pr * 16 + i] = f2bf(ob[t * 65 + pr * 16 + i]);
                    } else {
                        float o16[16];
                        float ss = 0.f;
#pragma unroll
                        for (int i = 0; i < 16; ++i) {
                            o16[i] = ob[t * 65 + pr * 16 + i] + bf2f(TMP[row * 256 + h * 64 + pr * 16 + i]);
                            ss += o16[i] * o16[i];
                        }
                        ss += __shfl_xor(ss, 1); ss += __shfl_xor(ss, 2);
                        const float rs = rsqrtf(ss * (1.f / 64.f) + EPS);
#pragma unroll
                        for (int i = 0; i < 16; ++i) {
                            const int e2 = pr * 16 + i;
                            const float z = bf2f(U[row * INW + C_GZ + h * 64 + e2]);
                            U[row * INW + C_GZ + h * 64 + e2] = f2bf(o16[i] * rs * p.in[I_GNG][l * 64 + e2] * siluf_(z));
                        }
                    }
                }
            }
        }
    }
}

__device__ void phase_ret(const Params& p, int l, char* smem, int vb, int nvb) {
    constexpr int CH = 32;
    float* sq = (float*)smem;
    float* sk = sq + CH * 64;
    float* sv = sk + CH * 64;
    float* ob = sv + CH * 64;
    bf16_t* U = (bf16_t*)(p.ws + OFF_U);
    bf16_t* TMP = (bf16_t*)(p.ws + OFF_T0 + 2 * SZ_T);
    const int tid = threadIdx.x;
    const bool with_ctx = l < 3;
    for (int it = vb; it < 32; it += nvb) {
        const int b = it >> 2, h = it & 3;
        const int e = tid >> 2, dg = tid & 3;
        for (int pass = 0; pass < 2; ++pass) {
            const int dir = 1 - pass;
            float S[16];
#pragma unroll
            for (int i = 0; i < 16; ++i) S[i] = 0.f;
            const float gamma = sigmoidf_(p.in[I_RDEC][(l * 2 + dir) * 4 + h]);
            for (int ci = 0; ci < (LC + T) / CH; ++ci) {
                const ChunkInfo c = chunk_info<CH>(ci, dir, b);
                __syncthreads();
                if (tid < CH * 4) {
                    const int t = tid >> 2, pr = tid & 3;
                    const size_t row = c.rowbase + c.t0 + t;
#pragma unroll
                    for (int i = 0; i < 16; ++i) {
                        const int dd = pr * 16 + i;
                        sq[t * 64 + dd] = bf2f(U[row * INW + C_RQ + h * 64 + dd]);
                        sk[t * 64 + dd] = bf2f(U[row * INW + C_RK + h * 64 + dd]) * 0.125f;
                        sv[t * 64 + dd] = bf2f(U[row * INW + C_RV + h * 64 + dd]);
                    }
                }
                __syncthreads();
                if (!c.isctx && tid < CH * 4) {
                    const int t = tid >> 2, pr = tid & 3;
                    const float pos = (float)(c.t0 + t);
#pragma unroll
                    for (int ii = 0; ii < 8; ++ii) {
                        const int i = pr * 8 + ii;
                        const float inv = expf(-(float)i * (9.210340371976184f / 32.f));
                        const float ang = pos * inv;
                        const float cs = cosf(ang), sn = sinf(ang);
                        const float q1 = sq[t * 64 + i], q2 = sq[t * 64 + i + 32];
                        sq[t * 64 + i] = q1 * cs - q2 * sn;
                        sq[t * 64 + i + 32] = q1 * sn + q2 * cs;
                        const float k1 = sk[t * 64 + i], k2 = sk[t * 64 + i + 32];
                        sk[t * 64 + i] = k1 * cs - k2 * sn;
                        sk[t * 64 + i + 32] = k1 * sn + k2 * cs;
                    }
                }
                __syncthreads();
                for (int tt = 0; tt < CH; ++tt) {
                    const int t = dir ? (CH - 1 - tt) : tt;
                    const float vv = sv[t * 64 + e];
                    float o = 0.f;
#pragma unroll
                    for (int i = 0; i < 16; ++i) {
                        S[i] = gamma * S[i] + sk[t * 64 + dg * 16 + i] * vv;
                        o += sq[t * 64 + dg * 16 + i] * S[i];
                    }
                    o += __shfl_xor(o, 1); o += __shfl_xor(o, 2);
                    if (dg == 0) ob[t * 65 + e] = o;
                }
                __syncthreads();
                if ((!c.isctx || with_ctx) && tid < CH * 4) {
                    const int t = tid >> 2, pr = tid & 3;
                    const size_t row = c.rowbase + c.t0 + t;
                    if (dir == 1) {
#pragma unroll
                        for (int i = 0; i < 16; ++i) TMP[row * 256 + h * 64 + pr * 16 + i] = f2bf(ob[t * 65 + pr * 16 + i]);
                    } else {
                        float o16[16];
                        float s1 = 0.f;
#pragma unroll
                        for (int i = 0; i < 16; ++i) {
                            o16[i] = ob[t * 65 + pr * 16 + i] + bf2f(TMP[row * 256 + h * 64 + pr * 16 + i]);
                            s1 += o16[i];
                        }
                        s1 += __shfl_xor(s1, 1); s1 += __shfl_xor(s1, 2);
                        const float mu = s1 * (1.f / 64.f);
                        float s2 = 0.f;
#pragma unroll
                        for (int i = 0; i < 16; ++i) {
                            const float dd = o16[i] - mu;
                            s2 += dd * dd;
                        }
                        s2 += __shfl_xor(s2, 1); s2 += __shfl_xor(s2, 2);
                        const float rs = rsqrtf(s2 * (1.f / 64.f) + EPS);
#pragma unroll
                        for (int i = 0; i < 16; ++i) {
                            const int e2 = pr * 16 + i;
                            const float z = bf2f(U[row * INW + C_RZ + h * 64 + e2]);
                            U[row * INW + C_RZ + h * 64 + e2] = f2bf((o16[i] - mu) * rs * siluf_(z));
                        }
                    }
                }
            }
        }
    }
}

__device__ void phase_swa(const Params& p, int l, char* smem, int vb, int nvb) {
    float* sK = (float*)smem;
    float* sV = sK + 64 * 68;
    bf16_t* U = (bf16_t*)(p.ws + OFF_U);
    const int tid = threadIdx.x;
    const bool with_ctx = l < 3;
    const int nlat = 8 * 4 * 32, nctx = with_ctx ? 8 * 4 * 4 : 0;
    for (int it = vb; it < nlat + nctx; it += nvb) {
        const bool cq = it >= nlat;
        const int id = cq ? it - nlat : it;
        int qt, hq, b;
        if (!cq) { qt = id & 31; hq = (id >> 5) & 3; b = id >> 7; }
        else     { qt = id & 3;  hq = (id >> 2) & 3; b = id >> 4; }
        const int kvh = hq >> 1;
        const int qi = tid >> 2, part = tid & 3;
        const int tq = qt * 64 + qi;
        const size_t qrow = cq ? (size_t)LAT + b * LC + tq : (size_t)b * T + tq;
        float q[64];
        {
            const bf16_t* qp = U + qrow * INW + C_SQ + hq * 64;
#pragma unroll
            for (int j = 0; j < 64; ++j) q[j] = bf2f(qp[j]);
        }
        if (!cq) {
            const float prow = (float)(tq >> 6), pcol = (float)(tq & 63);
#pragma unroll
            for (int i = 0; i < 32; ++i) {
                const float inv = expf(-(float)(i & 15) * (9.210340371976184f / 16.f));
                const float ang = ((i < 16) ? prow : pcol) * inv;
                const float cs = __cosf(ang), sn = __sinf(ang);
                const float x1 = q[i], x2 = q[i + 32];
                q[i] = x1 * cs - x2 * sn;
                q[i + 32] = x1 * sn + x2 * cs;
            }
        }
#pragma unroll
        for (int j = 0; j < 64; ++j) q[j] *= 0.125f;
        float m = -1e30f, lsum = 0.f, acc[64];
#pragma unroll
        for (int j = 0; j < 64; ++j) acc[j] = 0.f;
        const int nloc = cq ? 0 : 5;
        for (int ti = 0; ti < nloc + 4; ++ti) {
            const bool kctx = ti >= nloc;
            const int ktile = kctx ? ti - nloc : qt - 2 + ti;
            if (!kctx && (ktile < 0 || ktile >= 32)) continue;
            __syncthreads();
            {
                const int kk = tid >> 2, d0 = (tid & 3) * 16;
                const int tk = ktile * 64 + kk;
                const size_t krow = kctx ? (size_t)LAT + b * LC + tk : (size_t)b * T + tk;
#pragma unroll
                for (int i = 0; i < 16; ++i) {
                    sK[kk * 68 + d0 + i] = bf2f(U[krow * INW + C_SK + kvh * 64 + d0 + i]);
                    sV[kk * 68 + d0 + i] = bf2f(U[krow * INW + C_SV + kvh * 64 + d0 + i]);
                }
            }
            __syncthreads();
            if (!kctx) {
                const int kk = tid >> 2, pr = tid & 3;
                const int tk = ktile * 64 + kk;
                const float prow = (float)(tk >> 6), pcol = (float)(tk & 63);
#pragma unroll
                for (int ii = 0; ii < 8; ++ii) {
                    const int i = pr * 8 + ii;
                    const float inv = expf(-(float)(i & 15) * (9.210340371976184f / 16.f));
                    const float ang = ((i < 16) ? prow : pcol) * inv;
                    const float cs = __cosf(ang), sn = __sinf(ang);
                    const float x1 = sK[kk * 68 + i], x2 = sK[kk * 68 + i + 32];
                    sK[kk * 68 + i] = x1 * cs - x2 * sn;
                    sK[kk * 68 + i + 32] = x1 * sn + x2 * cs;
                }
                __syncthreads();
            }
            for (int jj = 0; jj < 16; ++jj) {
                const int j = jj * 4 + part;
                const int tk = ktile * 64 + j;
                int dlt = tk - tq;
                dlt = dlt < 0 ? -dlt : dlt;
                const bool valid = kctx || (dlt <= 128);
                if (valid) {
                    float s = 0.f;
#pragma unroll
                    for (int d = 0; d < 64; ++d) s += q[d] * sK[j * 68 + d];
                    if (s > m) {
                        const float sc = __expf(m - s);
                        lsum *= sc;
#pragma unroll
                        for (int d = 0; d < 64; ++d) acc[d] *= sc;
                        m = s;
                    }
                    const float pw = __expf(s - m);
                    lsum += pw;
#pragma unroll
                    for (int d = 0; d < 64; ++d) acc[d] += pw * sV[j * 68 + d];
                }
            }
        }
#pragma unroll
        for (int off = 1; off <= 2; off <<= 1) {
            const float m2 = __shfl_xor(m, off), l2 = __shfl_xor(lsum, off);
            const float mn = fmaxf(m, m2);
            const float s1 = __expf(m - mn), s2 = __expf(m2 - mn);
            lsum = lsum * s1 + l2 * s2;
#pragma unroll
            for (int d = 0; d < 64; ++d) acc[d] = acc[d] * s1 + __shfl_xor(acc[d], off) * s2;
            m = mn;
        }
        const float snk = p.in[I_SINK][l * 4 + hq];
        const float mn = fmaxf(m, snk);
        const float s1 = __expf(m - mn);
        lsum = lsum * s1 + __expf(snk - mn);
        const float sc = s1 / lsum;
#pragma unroll
        for (int i = 0; i < 16; ++i) {
            const float a = (part == 0) ? acc[i] : (part == 1) ? acc[16 + i] : (part == 2) ? acc[32 + i] : acc[48 + i];
            const int e2 = part * 16 + i;
            const float z = bf2f(U[qrow * INW + C_SZ + hq * 64 + e2]);
            U[qrow * INW + C_SZ + hq * 64 + e2] = f2bf(a * sc * siluf_(z));
        }
    }
}


#include <hip/hip_cooperative_groups.h>
namespace cg = cooperative_groups;

constexpr int SMEM_BYTES = 60 * 1024;

__global__ void __launch_bounds__(NT) fwd_megakernel(Params p) {
    __shared__ __attribute__((aligned(16))) char smem[SMEM_BYTES];
    cg::grid_group grid = cg::this_grid();
    const int vb = blockIdx.x, nvb = gridDim.x;
    phase_prep(p, smem, vb, nvb);
    grid.sync();
    for (int l = 0; l < 4; ++l) {
        phase_E(p, l, smem, vb, nvb);
        grid.sync();
        phase_gemm<false>(p, l, smem, vb, nvb);
        grid.sync();
        if (vb < 32) phase_gdn(p, l, smem, vb, 32);
        else if (vb < 64) phase_ret(p, l, smem, vb - 32, 32);
        else if (vb < 96) phase_lru(p, l, smem, vb - 64, 32);
        else phase_swa(p, l, smem, vb - 96, nvb - 96);
        grid.sync();
        phase_gemm<true>(p, l, smem, vb, nvb);
        grid.sync();
    }
    phase_E(p, 4, smem, vb, nvb);
}

extern "C" void kernel_launch(void* const* d_in, const int* in_sizes, int n_in, void* d_out, int out_size, void* d_ws,
                              size_t ws_size, hipStream_t stream) {
    static int grid_blocks = 0;
    if (grid_blocks == 0) {
        if (n_in != 23 || ws_size < WS_END) {
            fprintf(stderr, "kernel_launch: unexpected n_in %d or ws_size %zu (< %zu)\n", n_in, ws_size, (size_t)WS_END);
            grid_blocks = -1;
            return;
        }
        int dev = 0, cus = 0, per_cu = 0;
        (void)hipGetDevice(&dev);
        (void)hipDeviceGetAttribute(&cus, hipDeviceAttributeMultiprocessorCount, dev);
        (void)hipOccupancyMaxActiveBlocksPerMultiprocessor(&per_cu, fwd_megakernel, NT, 0);
        if (per_cu < 1) per_cu = 1;
        if (per_cu > 2) per_cu = 2;
        grid_blocks = cus * per_cu;
        fprintf(stderr, "kernel_launch: cus %d per_cu %d grid %d\n", cus, per_cu, grid_blocks);
    }
    if (grid_blocks < 0) return;
    Params p{};
    for (int i = 0; i < 23; ++i) p.in[i] = (const float*)d_in[i];
    p.out = (float*)d_out;
    p.ws = (unsigned char*)d_ws;
    void* args[] = {&p};
    hipError_t e = hipLaunchCooperativeKernel((void*)fwd_megakernel, dim3(grid_blocks), dim3(NT), args, 0, stream);
    if (e != hipSuccess) fprintf(stderr, "cooperative launch failed: %s (grid %d)\n", hipGetErrorString(e), grid_blocks);
}
```

```cpp
#include <hip/hip_runtime.h>
#include <hip/hip_bf16.h>
#include <cstdio>
#include <cstdint>

typedef unsigned short bf16_t;
typedef __attribute__((ext_vector_type(8))) short bf16x8;
typedef __attribute__((ext_vector_type(4))) float f32x4;

#define NT 256
constexpr int Bsz = 8, T = 2048, LC = 256, DM = 1024, INW = 3344;
constexpr int LAT = Bsz * T, NROW = LAT + Bsz * LC;
constexpr int C_LRUX = 0, C_LRUZ = 256, C_GQ = 512, C_GZ = 1280, C_GA = 1536, C_GB = 1544;
constexpr int C_RQ = 1552, C_RK = 1808, C_RV = 2064, C_RZ = 2320, C_SQ = 2576, C_SK = 2832, C_SV = 2960, C_SZ = 3088;
constexpr float EPS = 1e-6f;

enum { I_X = 0, I_C, I_CTX, I_CCTX, I_WMOD, I_BMOD, I_PREG, I_POSTG, I_WIN, I_WOUT, I_LCW, I_LCB, I_LWR, I_LBR, I_LWI, I_LBI,
       I_LLAM, I_GCW, I_GALOG, I_GDT, I_GNG, I_RDEC, I_SINK };

constexpr size_t OFF_MOD = 0;
constexpr size_t OFF_WINT = 1u << 19;
constexpr size_t SZ_WINT = 4ull * INW * DM * 2;
constexpr size_t OFF_WOUTT = OFF_WINT + SZ_WINT;
constexpr size_t SZ_WOUTT = 4ull * DM * DM * 2;
constexpr size_t OFF_U = OFF_WOUTT + SZ_WOUTT;
constexpr size_t SZ_U = (size_t)NROW * INW * 2;
constexpr size_t OFF_P = OFF_U + SZ_U;
constexpr size_t SZ_P = (size_t)NROW * DM * 2;
constexpr size_t OFF_XC = OFF_P + SZ_P;
constexpr size_t SZ_XC = (size_t)Bsz * LC * DM * 4;
constexpr size_t OFF_T0 = OFF_XC + SZ_XC;
constexpr size_t SZ_T = (size_t)NROW * 256 * 2;
constexpr size_t WS_END = OFF_T0 + 3 * SZ_T;

struct Params {
    const float* in[23];
    float* out;
    unsigned char* ws;
};

__device__ __forceinline__ float bf2f(bf16_t v) { return __uint_as_float(((unsigned)v) << 16); }
__device__ __forceinline__ bf16_t f2bf(float f) {
    unsigned u = __float_as_uint(f);
    u += 0x7fffu + ((u >> 16) & 1u);
    return (bf16_t)(u >> 16);
}
__device__ __forceinline__ float sigmoidf_(float x) { return 1.f / (1.f + __expf(-x)); }
__device__ __forceinline__ float siluf_(float x) { return x / (1.f + __expf(-x)); }
__device__ __forceinline__ float softplusf_(float x) { return x > 20.f ? x : log1pf(__expf(x)); }

__device__ __forceinline__ float wave_sum(float v) {
#pragma unroll
    for (int o = 32; o >= 1; o >>= 1) v += __shfl_xor(v, o);
    return v;
}
__device__ __forceinline__ float block_sum(float v, float* red) {
    v = wave_sum(v);
    __syncthreads();
    if ((threadIdx.x & 63) == 0) red[threadIdx.x >> 6] = v;
    __syncthreads();
    return red[0] + red[1] + red[2] + red[3];
}

__device__ void phase_prep(const Params& p, char* smem, int vb, int nvb) {
    const int tid = threadIdx.x;
    float* mod = (float*)(p.ws + OFF_MOD);
    bf16_t* wint = (bf16_t*)(p.ws + OFF_WINT);
    bf16_t* woutt = (bf16_t*)(p.ws + OFF_WOUTT);
    const int nA = 48, nB = 4 * 16 * 53, nC = 4 * 16 * 16;
    for (int it = vb; it < nA + nB + nC; it += nvb) {
        __syncthreads();
        if (it < nA) {
            float* s = (float*)smem;
            const int l = it / 12, col = (it % 12) * 256 + tid;
            for (int i = tid; i < 9 * 1024; i += NT) {
                const int r = i >> 10, k = i & 1023;
                const float cv = (r < 8) ? p.in[I_C][r * 1024 + k] : p.in[I_CCTX][k];
                s[i] = siluf_(cv);
            }
            __syncthreads();
            float acc[9];
#pragma unroll
            for (int r = 0; r < 9; ++r) acc[r] = 0.f;
            const float* w = p.in[I_WMOD] + (size_t)l * 1024 * 3072 + col;
            for (int k = 0; k < 1024; ++k) {
                const float wv = w[(size_t)k * 3072];
#pragma unroll
                for (int r = 0; r < 9; ++r) acc[r] += s[r * 1024 + k] * wv;
            }
            const float bm = p.in[I_BMOD][l * 3072 + col];
#pragma unroll
            for (int r = 0; r < 9; ++r) mod[(l * 9 + r) * 3072 + col] = acc[r] + bm;
        } else {
            float* tile = (float*)smem;
            const bool isin = it < nA + nB;
            const int id = isin ? it - nA : it - nA - nB;
            const int NN = isin ? INW : DM;
            const int ntn = isin ? 53 : 16;
            const int l = id / (16 * ntn), rem = id % (16 * ntn);
            const int k0 = (rem / ntn) * 64, n0 = (rem % ntn) * 64;
            const float* W = (isin ? p.in[I_WIN] : p.in[I_WOUT]) + (size_t)l * 1024 * NN;
            bf16_t* Wt = (isin ? wint : woutt) + (size_t)l * NN * 1024;
#pragma unroll
            for (int i = 0; i < 16; ++i) {
                const int r = i * 4 + (tid >> 6), cc = tid & 63;
                const int n = n0 + cc;
                tile[r * 65 + cc] = (n < NN) ? W[(size_t)(k0 + r) * NN + n] : 0.f;
            }
            __syncthreads();
#pragma unroll
            for (int i = 0; i < 16; ++i) {
                const int r2 = i * 4 + (tid >> 6), c2 = tid & 63;
                const int n = n0 + r2;
                if (n < NN) Wt[(size_t)n * 1024 + k0 + c2] = f2bf(tile[c2 * 65 + r2]);
            }
        }
    }
}

__device__ void phase_E(const Params& p, int l, char* smem, int vb, int nvb) {
    const int tid = threadIdx.x;
    float* red = (float*)smem;
    const float* mod = (const float*)(p.ws + OFF_MOD);
    bf16_t* P = (bf16_t*)(p.ws + OFF_P);
    float* XC = (float*)(p.ws + OFF_XC);
    const int nrows = (l == 4) ? LAT : NROW;
    const int col = tid * 4;
    for (int row = vb; row < nrows; row += nvb) {
        const bool isctx = row >= LAT;
        const int mr = isctx ? 8 : row / T;
        float* xcur = isctx ? XC + (size_t)(row - LAT) * DM + col : p.out + (size_t)row * DM + col;
        float4 xv;
        if (l == 0) {
            const float* src = isctx ? p.in[I_CTX] + (size_t)(row - LAT) * DM + col : p.in[I_X] + (size_t)row * DM + col;
            xv = *(const float4*)src;
        } else {
            xv = *(const float4*)xcur;
            const uint2 yr = *(const uint2*)(P + (size_t)row * DM + col);
            const float y0 = bf2f((bf16_t)(yr.x & 0xffff)), y1 = bf2f((bf16_t)(yr.x >> 16));
            const float y2 = bf2f((bf16_t)(yr.y & 0xffff)), y3 = bf2f((bf16_t)(yr.y >> 16));
            const float ss = block_sum(y0 * y0 + y1 * y1 + y2 * y2 + y3 * y3, red);
            const float rs = rsqrtf(ss * (1.f / DM) + EPS);
            const float4 g = *(const float4*)(mod + ((l - 1) * 9 + mr) * 3072 + 2048 + col);
            const float4 pg = *(const float4*)(p.in[I_POSTG] + (l - 1) * DM + col);
            xv.x += g.x * (y0 * rs * pg.x);
            xv.y += g.y * (y1 * rs * pg.y);
            xv.z += g.z * (y2 * rs * pg.z);
            xv.w += g.w * (y3 * rs * pg.w);
        }
        *(float4*)xcur = xv;
        if (l < 4) {
            const float ss2 = block_sum(xv.x * xv.x + xv.y * xv.y + xv.z * xv.z + xv.w * xv.w, red);
            const float rs2 = rsqrtf(ss2 * (1.f / DM) + EPS);
            const float4 pg = *(const float4*)(p.in[I_PREG] + l * DM + col);
            const float4 sh = *(const float4*)(mod + (l * 9 + mr) * 3072 + col);
            const float4 sc = *(const float4*)(mod + (l * 9 + mr) * 3072 + 1024 + col);
            const float h0 = xv.x * rs2 * pg.x * (1.f + sc.x) + sh.x;
            const float h1 = xv.y * rs2 * pg.y * (1.f + sc.y) + sh.y;
            const float h2 = xv.z * rs2 * pg.z * (1.f + sc.z) + sh.z;
            const float h3 = xv.w * rs2 * pg.w * (1.f + sc.w) + sh.w;
            uint2 hv;
            hv.x = (unsigned)f2bf(h0) | ((unsigned)f2bf(h1) << 16);
            hv.y = (unsigned)f2bf(h2) | ((unsigned)f2bf(h3) << 16);
            *(uint2*)(P + (size_t)row * DM + col) = hv;
        }
    }
}

template <bool OUTP>
__device__ void phase_gemm(const Params& p, int l, char* smem, int vb, int nvb) {
    constexpr int BK = 32, LDS_S = 40;
    bf16_t* sA = (bf16_t*)smem;
    bf16_t* sB = sA + 128 * LDS_S;
    const int tid = threadIdx.x, lane = tid & 63, wave = tid >> 6, wm = wave >> 1, wn = wave & 1;
    const int N = OUTP ? DM : INW;
    const int mtiles = OUTP ? ((l == 3) ? LAT / 128 : NROW / 128) : NROW / 128;
    const int ntiles = (N + 127) / 128;
    const bf16_t* A = OUTP ? (const bf16_t*)(p.ws + OFF_U) : (const bf16_t*)(p.ws + OFF_P);
    const int lda = OUTP ? INW : DM;
    const bf16_t* Wt = OUTP ? (const bf16_t*)(p.ws + OFF_WOUTT) + (size_t)l * DM * DM
                            : (const bf16_t*)(p.ws + OFF_WINT) + (size_t)l * INW * DM;
    bf16_t* C = OUTP ? (bf16_t*)(p.ws + OFF_P) : (bf16_t*)(p.ws + OFF_U);
    const int ldc = OUTP ? DM : INW;

    for (int tile = vb; tile < mtiles * ntiles; tile += nvb) {
        const int tm = tile / ntiles, tn = tile % ntiles;
        f32x4 acc[4][4];
#pragma unroll
        for (int m = 0; m < 4; ++m)
#pragma unroll
            for (int n = 0; n < 4; ++n) acc[m][n] = (f32x4){0.f, 0.f, 0.f, 0.f};

        const int r0_ = tid >> 2, kc_ = (tid & 3) * 8;
        const bf16_t* aptr0 = A + (size_t)(tm * 128 + r0_) * lda + kc_;
        const bf16_t* aptr1 = A + (size_t)(tm * 128 + r0_ + 64) * lda + kc_;
        int n0_ = tn * 128 + r0_, n1_ = tn * 128 + r0_ + 64;
        if (n0_ > N - 1) n0_ = N - 1;
        if (n1_ > N - 1) n1_ = N - 1;
        const bf16_t* bptr0 = Wt + (size_t)n0_ * DM + kc_;
        const bf16_t* bptr1 = Wt + (size_t)n1_ * DM + kc_;
        const int lofs0 = r0_ * LDS_S + kc_, lofs1 = (r0_ + 64) * LDS_S + kc_;
        uint4 ra0, ra1, rb0, rb1;
#define GLOAD(k0_)                                                                                   \
    {                                                                                                \
        const int k0__ = (k0_);                                                                      \
        int acol;                                                                                    \
        if (OUTP) {                                                                                  \
            const int g = k0__ >> 8;                                                                 \
            const int zoff = (g == 0) ? C_LRUZ : (g == 1) ? C_GZ : (g == 2) ? C_RZ : C_SZ;           \
            acol = zoff + (k0__ & 255);                                                              \
        } else {                                                                                     \
            acol = k0__;                                                                             \
        }                                                                                            \
        ra0 = *(const uint4*)(aptr0 + acol);                                                         \
        ra1 = *(const uint4*)(aptr1 + acol);                                                         \
        rb0 = *(const uint4*)(bptr0 + k0__);                                                         \
        rb1 = *(const uint4*)(bptr1 + k0__);                                                         \
    }
        GLOAD(0);
        for (int k0 = 0; k0 < DM; k0 += BK) {
            __syncthreads();
            *(uint4*)(sA + lofs0) = ra0;
            *(uint4*)(sA + lofs1) = ra1;
            *(uint4*)(sB + lofs0) = rb0;
            *(uint4*)(sB + lofs1) = rb1;
            __syncthreads();
            if (k0 + BK < DM) GLOAD(k0 + BK);
            bf16x8 af[4], bfr[4];
#pragma unroll
            for (int m = 0; m < 4; ++m)
                af[m] = *(const bf16x8*)(sA + (wm * 64 + m * 16 + (lane & 15)) * LDS_S + (lane >> 4) * 8);
#pragma unroll
            for (int n = 0; n < 4; ++n)
                bfr[n] = *(const bf16x8*)(sB + (wn * 64 + n * 16 + (lane & 15)) * LDS_S + (lane >> 4) * 8);
#pragma unroll
            for (int m = 0; m < 4; ++m)
#pragma unroll
                for (int n = 0; n < 4; ++n)
                    acc[m][n] = __builtin_amdgcn_mfma_f32_16x16x32_bf16(af[m], bfr[n], acc[m][n], 0, 0, 0);
        }
#pragma unroll
        for (int m = 0; m < 4; ++m)
#pragma unroll
            for (int n = 0; n < 4; ++n) {
                const int gcol = tn * 128 + wn * 64 + n * 16 + (lane & 15);
                if (gcol < N) {
#pragma unroll
                    for (int r = 0; r < 4; ++r) {
                        const int grow = tm * 128 + wm * 64 + m * 16 + (lane >> 4) * 4 + r;
                        C[(size_t)grow * ldc + gcol] = f2bf(acc[m][n][r]);
                    }
                }
            }
    }
}

typedef __attribute__((ext_vector_type(4))) short bf16x4;
typedef __attribute__((ext_vector_type(4))) unsigned u32x4;
#define MFMA32(a, b, c) __builtin_amdgcn_mfma_f32_16x16x32_bf16((a), (b), (c), 0, 0, 0)
__device__ __forceinline__ unsigned cvt_pk(float lo, float hi) {
    unsigned r;
    asm("v_cvt_pk_bf16_f32 %0, %1, %2" : "=v"(r) : "v"(lo), "v"(hi));
    return r;
}
__device__ __forceinline__ bf16x8 pack8(f32x4 a, f32x4 b) {
    u32x4 u = {cvt_pk(a[0], a[1]), cvt_pk(a[2], a[3]), cvt_pk(b[0], b[1]), cvt_pk(b[2], b[3])};
    return __builtin_bit_cast(bf16x8, u);
}
__device__ __forceinline__ bf16x8 cat8(bf16x4 a, bf16x4 b) { return __builtin_shufflevector(a, b, 0, 1, 2, 3, 4, 5, 6, 7); }
__device__ __forceinline__ bf16x4 lds_tr(const bf16_t* p) {
    return __builtin_amdgcn_ds_read_tr16_b64_v4i16((__attribute__((address_space(3))) bf16x4*)p);
}
__device__ __forceinline__ float lo16(unsigned u) { return __uint_as_float(u << 16); }
__device__ __forceinline__ float hi16(unsigned u) { return __uint_as_float(u & 0xffff0000u); }

struct ChunkInfo {
    bool isctx;
    int t0, Tseg;
    size_t rowbase;
};
template <int CH>
__device__ __forceinline__ ChunkInfo chunk_info(int ci, int dir, int b) {
    constexpr int NC = LC / CH, NL = T / CH;
    ChunkInfo c;
    c.isctx = ci < NC;
    const int cidx = c.isctx ? ci : ci - NC;
    const int nch = c.isctx ? NC : NL;
    const int chunk = dir ? (nch - 1 - cidx) : cidx;
    c.Tseg = c.isctx ? LC : T;
    c.rowbase = c.isctx ? (size_t)LAT + (size_t)b * LC : (size_t)b * T;
    c.t0 = chunk * CH;
    return c;
}

__device__ void phase_lru(const Params& p, int l, char* smem, int vb, int nvb) {
    constexpr int CH = 64;
    float* xb = (float*)smem;
    float* uc = xb + (CH + 3) * 64;
    float* hb = uc + CH * 64;
    bf16_t* U = (bf16_t*)(p.ws + OFF_U);
    bf16_t* TMP = (bf16_t*)(p.ws + OFF_T0);
    const int tid = threadIdx.x;
    const bool with_ctx = l < 3;
    for (int it = vb; it < 32; it += nvb) {
        const int b = it >> 2, n = it & 3;
        const int d = tid >> 2, kg = tid & 3, ch = n * 64 + d;
        for (int pass = 0; pass < 2; ++pass) {
            const int dir = 1 - pass;
            float wr[16], wi[16];
#pragma unroll
            for (int i = 0; i < 16; ++i) {
                const size_t wo = ((size_t)((l * 2 + dir) * 4 + n) * 64 + (kg * 16 + i)) * 64 + d;
                wr[i] = p.in[I_LWR][wo];
                wi[i] = p.in[I_LWI][wo];
            }
            const float br = p.in[I_LBR][(l * 2 + dir) * 256 + ch];
            const float bi = p.in[I_LBI][(l * 2 + dir) * 256 + ch];
            const float sp = softplusf_(-p.in[I_LLAM][(l * 2 + dir) * 256 + ch]);
            float h = 0.f;
            for (int ci = 0; ci < (LC + T) / CH; ++ci) {
                const ChunkInfo c = chunk_info<CH>(ci, dir, b);
                __syncthreads();
                for (int idx = tid; idx < (CH + 3) * 64; idx += NT) {
                    const int r = idx >> 6, cc = idx & 63, t = c.t0 - 2 + r;
                    xb[idx] = (t >= 0 && t < c.Tseg) ? bf2f(U[(c.rowbase + t) * INW + C_LRUX + n * 64 + cc]) : 0.f;
                }
                __syncthreads();
                for (int idx = tid; idx < CH * 64; idx += NT) {
                    const int t = idx >> 6, cc = idx & 63;
                    float a = p.in[I_LCB][l * 256 + n * 64 + cc];
#pragma unroll
                    for (int j = 0; j < 4; ++j) a += p.in[I_LCW][(l * 4 + j) * 256 + n * 64 + cc] * xb[(t + j) * 64 + cc];
                    uc[idx] = a;
                }
                __syncthreads();
                for (int tt = 0; tt < CH; ++tt) {
                    const int t = dir ? (CH - 1 - tt) : tt;
                    float pr = 0.f, pi = 0.f;
#pragma unroll
                    for (int i = 0; i < 16; ++i) {
                        const float u = uc[t * 64 + kg * 16 + i];
                        pr += u * wr[i];
                        pi += u * wi[i];
                    }
                    pr += __shfl_xor(pr, 1); pr += __shfl_xor(pr, 2);
                    pi += __shfl_xor(pi, 1); pi += __shfl_xor(pi, 2);
                    const float r = sigmoidf_(pr + br), ig = sigmoidf_(pi + bi);
                    const float la = -8.f * r * sp;
                    const float a = __expf(la);
                    const float mult = sqrtf(fmaxf(0.f, -expm1f(2.f * la)));
                    h = a * h + mult * ig * uc[t * 64 + d];
                    if (kg == 0) hb[t * 65 + d] = h;
                }
                __syncthreads();
                if (!c.isctx || with_ctx) {
                    const int t = tid >> 2, pr = tid & 3;
                    const size_t row = c.rowbase + c.t0 + t;
                    if (dir == 1) {
#pragma unroll
                        for (int i = 0; i < 16; ++i) TMP[row * 256 + n * 64 + pr * 16 + i] = f2bf(hb[t * 65 + pr * 16 + i]);
                    } else {
#pragma unroll
                        for (int i = 0; i < 16; ++i) {
                            const int cc = n * 64 + pr * 16 + i;
                            const float hs = hb[t * 65 + pr * 16 + i] + bf2f(TMP[row * 256 + cc]);
                            const float z = bf2f(U[row * INW + C_LRUZ + cc]);
                            U[row * INW + C_LRUZ + cc] = f2bf(hs * siluf_(z));
                        }
                    }
                }
            }
        }
    }
}

__device__ void phase_gdn(const Params& p, int l, char* smem, int vb, int nvb) {
    constexpr int CH = 32;
    bf16_t* raw = (bf16_t*)smem;
    float* cv = (float*)(smem + ((CH + 3) * 192 * 2 + 15) / 16 * 16);
    float* ob = cv + CH * 193;
    float* egs = ob + CH * 65;
    float* bts = egs + CH;
    bf16_t* U = (bf16_t*)(p.ws + OFF_U);
    bf16_t* TMP = (bf16_t*)(p.ws + OFF_T0 + SZ_T);
    const int tid = threadIdx.x;
    const bool with_ctx = l < 3;
    for (int it = vb; it < 32; it += nvb) {
        const int b = it >> 2, h = it & 3;
        const int e = tid >> 2, dg = tid & 3;
        for (int pass = 0; pass < 2; ++pass) {
            const int dir = 1 - pass;
            float S[16];
#pragma unroll
            for (int i = 0; i < 16; ++i) S[i] = 0.f;
            const float neg_ea = -__expf(p.in[I_GALOG][(l * 2 + dir) * 4 + h]);
            const float dtb = p.in[I_GDT][(l * 2 + dir) * 4 + h];
            for (int ci = 0; ci < (LC + T) / CH; ++ci) {
                const ChunkInfo c = chunk_info<CH>(ci, dir, b);
                __syncthreads();
                for (int idx = tid; idx < (CH + 3) * 24; idx += NT) {
                    const int r = idx / 24, c8 = idx % 24, t = c.t0 - 2 + r;
                    uint4 v = make_uint4(0, 0, 0, 0);
                    if (t >= 0 && t < c.Tseg)
                        v = *(const uint4*)(U + (c.rowbase + t) * INW + C_GQ + (c8 >> 3) * 256 + h * 64 + (c8 & 7) * 8);
                    *(uint4*)(raw + r * 192 + c8 * 8) = v;
                }
                if (tid < CH) {
                    const size_t row = c.rowbase + c.t0 + tid;
                    const float alpha = bf2f(U[row * INW + C_GA + dir * 4 + h]);
                    const float beta = bf2f(U[row * INW + C_GB + dir * 4 + h]);
                    egs[tid] = __expf(neg_ea * softplusf_(alpha + dtb));
                    bts[tid] = sigmoidf_(beta);
                }
                __syncthreads();
                for (int idx = tid; idx < CH * 192; idx += NT) {
                    const int t = idx / 192, cc = idx % 192;
                    const int gc = (cc >> 6) * 256 + h * 64 + (cc & 63);
                    float a = 0.f;
#pragma unroll
                    for (int j = 0; j < 4; ++j) a += p.in[I_GCW][(l * 4 + j) * 768 + gc] * bf2f(raw[(t + j) * 192 + cc]);
                    cv[t * 193 + cc] = siluf_(a);
                }
                __syncthreads();
                if (tid < CH * 4) {
                    const int t = tid >> 2, pr = tid & 3;
                    float sq = 0.f, sk = 0.f;
#pragma unroll
                    for (int i = 0; i < 16; ++i) {
                        const float q = cv[t * 193 + pr * 16 + i], k = cv[t * 193 + 64 + pr * 16 + i];
                        sq += q * q;
                        sk += k * k;
                    }
                    sq += __shfl_xor(sq, 1); sq += __shfl_xor(sq, 2);
                    sk += __shfl_xor(sk, 1); sk += __shfl_xor(sk, 2);
                    const float rq = rsqrtf(sq + EPS) * 0.125f, rk = rsqrtf(sk + EPS);
#pragma unroll
                    for (int i = 0; i < 16; ++i) {
                        cv[t * 193 + pr * 16 + i] *= rq;
                        cv[t * 193 + 64 + pr * 16 + i] *= rk;
                    }
                }
                __syncthreads();
                for (int tt = 0; tt < CH; ++tt) {
                    const int t = dir ? (CH - 1 - tt) : tt;
                    const float eg = egs[t], bt = bts[t];
                    const float* qr = cv + t * 193 + dg * 16;
                    const float* kr = qr + 64;
                    const float vv = cv[t * 193 + 128 + e];
                    float dot = 0.f;
#pragma unroll
                    for (int i = 0; i < 16; ++i) {
                        S[i] *= eg;
                        dot += S[i] * kr[i];
                    }
                    dot += __shfl_xor(dot, 1); dot += __shfl_xor(dot, 2);
                    const float vn = bt * (vv - dot);
                    float o = 0.f;
#pragma unroll
                    for (int i = 0; i < 16; ++i) {
                        S[i] += kr[i] * vn;
                        o += S[i] * qr[i];
                    }
                    o += __shfl_xor(o, 1); o += __shfl_xor(o, 2);
                    if (dg == 0) ob[t * 65 + e] = o;
                }
                __syncthreads();
                if ((!c.isctx || with_ctx) && tid < CH * 4) {
                    const int t = tid >> 2, pr = tid & 3;
                    const size_t row = c.rowbase + c.t0 + t;
                    if (dir == 1) {
#pragma unroll
                        for (int i = 0; i < 16; ++i) TMP[row * 256 + h * 64 + pr * 16 + i] = f2bf(ob[t * 65 + pr * 16 + i]);
                    } else {
                        float o16[16];
                        float ss = 0.f;
#pragma unroll
                        for (int i = 0; i < 16; ++i) {
                            o16[i] = ob[t * 65 + pr * 16 + i] + bf2f(TMP[row * 256 + h * 64 + pr * 16 + i]);
                            ss += o16[i] * o16[i];
                        }
                        ss += __shfl_xor(ss, 1); ss += __shfl_xor(ss, 2);
                        const float rs = rsqrtf(ss * (1.f / 64.f) + EPS);
#pragma unroll
                        for (int i = 0; i < 16; ++i) {
                            const int e2 = pr * 16 + i;
                            const float z = bf2f(U[row * INW + C_GZ + h * 64 + e2]);
                            U[row * INW + C_GZ + h * 64 + e2] = f2bf(o16[i] * rs * p.in[I_GNG][l * 64 + e2] * siluf_(z));
                        }
                    }
                }
            }
        }
    }
}

__device__ void phase_ret(const Params& p, int l, char* smem, int vb, int nvb) {
    constexpr int CH = 32;
    float* sq = (float*)smem;
    float* sk = sq + CH * 64;
    float* sv = sk + CH * 64;
    float* ob = sv + CH * 64;
    bf16_t* U = (bf16_t*)(p.ws + OFF_U);
    bf16_t* TMP = (bf16_t*)(p.ws + OFF_T0 + 2 * SZ_T);
    const int tid = threadIdx.x;
    const bool with_ctx = l < 3;
    for (int it = vb; it < 32; it += nvb) {
        const int b = it >> 2, h = it & 3;
        const int e = tid >> 2, dg = tid & 3;
        for (int pass = 0; pass < 2; ++pass) {
            const int dir = 1 - pass;
            float S[16];
#pragma unroll
            for (int i = 0; i < 16; ++i) S[i] = 0.f;
            const float gamma = sigmoidf_(p.in[I_RDEC][(l * 2 + dir) * 4 + h]);
            for (int ci = 0; ci < (LC + T) / CH; ++ci) {
                const ChunkInfo c = chunk_info<CH>(ci, dir, b);
                __syncthreads();
                if (tid < CH * 4) {
                    const int t = tid >> 2, pr = tid & 3;
                    const size_t row = c.rowbase + c.t0 + t;
#pragma unroll
                    for (int i = 0; i < 16; ++i) {
                        const int dd = pr * 16 + i;
                        sq[t * 64 + dd] = bf2f(U[row * INW + C_RQ + h * 64 + dd]);
                        sk[t * 64 + dd] = bf2f(U[row * INW + C_RK + h * 64 + dd]) * 0.125f;
                        sv[t * 64 + dd] = bf2f(U[row * INW + C_RV + h * 64 + dd]);
                    }
                }
                __syncthreads();
                if (!c.isctx && tid < CH * 4) {
                    const int t = tid >> 2, pr = tid & 3;
                    const float pos = (float)(c.t0 + t);
#pragma unroll
                    for (int ii = 0; ii < 8; ++ii) {
                        const int i = pr * 8 + ii;
                        const float inv = expf(-(float)i * (9.210340371976184f / 32.f));
                        const float ang = pos * inv;
                        const float cs = cosf(ang), sn = sinf(ang);
                        const float q1 = sq[t * 64 + i], q2 = sq[t * 64 + i + 32];
                        sq[t * 64 + i] = q1 * cs - q2 * sn;
                        sq[t * 64 + i + 32] = q1 * sn + q2 * cs;
                        const float k1 = sk[t * 64 + i], k2 = sk[t * 64 + i + 32];
                        sk[t * 64 + i] = k1 * cs - k2 * sn;
                        sk[t * 64 + i + 32] = k1 * sn + k2 * cs;
                    }
                }
                __syncthreads();
                for (int tt = 0; tt < CH; ++tt) {
                    const int t = dir ? (CH - 1 - tt) : tt;
                    const float vv = sv[t * 64 + e];
                    float o = 0.f;
#pragma unroll
                    for (int i = 0; i < 16; ++i) {
                        S[i] = gamma * S[i] + sk[t * 64 + dg * 16 + i] * vv;
                        o += sq[t * 64 + dg * 16 + i] * S[i];
                    }
                    o += __shfl_xor(o, 1); o += __shfl_xor(o, 2);
                    if (dg == 0) ob[t * 65 + e] = o;
                }
                __syncthreads();
                if ((!c.isctx || with_ctx) && tid < CH * 4) {
                    const int t = tid >> 2, pr = tid & 3;
                    const size_t row = c.rowbase + c.t0 + t;
                    if (dir == 1) {
#pragma unroll
                        for (int i = 0; i < 16; ++i) TMP[row * 256 + h * 64 + pr * 16 + i] = f2bf(ob[t * 65 + pr * 16 + i]);
                    } else {
                        float o16[16];
                        float s1 = 0.f;
#pragma unroll
                        for (int i = 0; i < 16; ++i) {
                            o16[i] = ob[t * 65 + pr * 16 + i] + bf2f(TMP[row * 256 + h * 64 + pr * 16 + i]);
                            s1 += o16[i];
                        }
                        s1 += __shfl_xor(s1, 1); s1 += __shfl_xor(s1, 2);
                        const float mu = s1 * (1.f / 64.f);
                        float s2 = 0.f;
#pragma unroll
                        for (int i = 0; i < 16; ++i) {
                            const float dd = o16[i] - mu;
                            s2 += dd * dd;
                        }
                        s2 += __shfl_xor(s2, 1); s2 += __shfl_xor(s2, 2);
                        const float rs = rsqrtf(s2 * (1.f / 64.f) + EPS);
#pragma unroll
                        for (int i = 0; i < 16; ++i) {
                            const int e2 = pr * 16 + i;
                            const float z = bf2f(U[row * INW + C_RZ + h * 64 + e2]);
                            U[row * INW + C_RZ + h * 64 + e2] = f2bf((o16[i] - mu) * rs * siluf_(z));
                        }
                    }
                }
            }
        }
    }
}

template <int DIR>
__device__ __forceinline__ void ret_step(const bf16_t* Q, const bf16_t* K, const bf16_t* V, f32x4 (&S)[4][2], f32x4 (&o)[4][2],
                                         int sl, int g, int li, float g64, bool need_o) {
    constexpr int LS = 72;
    const int q4 = li >> 2, p4 = li & 3;
    bf16x8 vf[2][2];
#pragma unroll
    for (int s = 0; s < 2; ++s)
#pragma unroll
        for (int nt = 0; nt < 2; ++nt)
            vf[s][nt] = cat8(lds_tr(V + (32 * s + 4 * g + q4) * LS + 32 * sl + 16 * nt + 4 * p4),
                             lds_tr(V + (32 * s + 16 + 4 * g + q4) * LS + 32 * sl + 16 * nt + 4 * p4));
    if (need_o) {
        bf16x8 sf[2][2];
#pragma unroll
        for (int s = 0; s < 2; ++s)
#pragma unroll
            for (int nt = 0; nt < 2; ++nt) sf[s][nt] = pack8(S[2 * s][nt], S[2 * s + 1][nt]);
        bf16x8 af[4][2];
#pragma unroll
        for (int ci = 0; ci < 4; ++ci) {
            u32x4 fr[2];
#pragma unroll
            for (int bi = 0; bi < 4; ++bi) {
                const bool needed = DIR ? (bi >= ci) : (bi <= ci);
                unsigned w0 = 0, w1 = 0;
                if (needed) {
                    f32x4 t = {0.f, 0.f, 0.f, 0.f};
#pragma unroll
                    for (int s2 = 0; s2 < 2; ++s2) {
                        const bf16x8 a = *(const bf16x8*)(K + (16 * bi + li) * LS + 32 * s2 + 8 * g);
                        const bf16x8 bq = *(const bf16x8*)(Q + (16 * ci + li) * LS + 32 * s2 + 8 * g);
                        t = MFMA32(a, bq, t);
                    }
                    if (bi == ci) {
#pragma unroll
                        for (int r = 0; r < 4; ++r) {
                            const bool keep = DIR ? (4 * g + r >= li) : (4 * g + r <= li);
                            t[r] = keep ? t[r] : 0.f;
                        }
                    }
                    w0 = cvt_pk(t[0], t[1]);
                    w1 = cvt_pk(t[2], t[3]);
                }
                fr[bi >> 1][(bi & 1) * 2] = w0;
                fr[bi >> 1][(bi & 1) * 2 + 1] = w1;
            }
            af[ci][0] = __builtin_bit_cast(bf16x8, fr[0]);
            af[ci][1] = __builtin_bit_cast(bf16x8, fr[1]);
        }
#pragma unroll
        for (int mt = 0; mt < 4; ++mt) {
            bf16x8 qa[2];
#pragma unroll
            for (int s = 0; s < 2; ++s)
                qa[s] = cat8(*(const bf16x4*)(Q + (16 * mt + li) * LS + 32 * s + 4 * g),
                             *(const bf16x4*)(Q + (16 * mt + li) * LS + 32 * s + 16 + 4 * g));
#pragma unroll
            for (int nt = 0; nt < 2; ++nt) {
                f32x4 acc = {0.f, 0.f, 0.f, 0.f};
#pragma unroll
                for (int s = 0; s < 2; ++s) {
                    acc = MFMA32(qa[s], sf[s][nt], acc);
                    acc = MFMA32(af[mt][s], vf[s][nt], acc);
                }
                o[mt][nt] = acc;
            }
        }
    }
#pragma unroll
    for (int mt = 0; mt < 4; ++mt) {
        bf16x8 ka[2];
#pragma unroll
        for (int s = 0; s < 2; ++s)
            ka[s] = cat8(lds_tr(K + (32 * s + 4 * g + q4) * LS + 16 * mt + 4 * p4),
                         lds_tr(K + (32 * s + 16 + 4 * g + q4) * LS + 16 * mt + 4 * p4));
#pragma unroll
        for (int nt = 0; nt < 2; ++nt) {
            f32x4 acc = S[mt][nt];
#pragma unroll
            for (int s = 0; s < 2; ++s) acc = MFMA32(ka[s], vf[s][nt], acc);
            S[mt][nt] = acc * g64;
        }
    }
}

__device__ void phase_ret_chain(const Params& p, int l, char* smem, int vb, int nvb) {
    constexpr int LS = 72;
    bf16_t* lds = (bf16_t*)smem;
    bf16_t* U = (bf16_t*)(p.ws + OFF_U);
    bf16_t* TMP = (bf16_t*)(p.ws + OFF_T0 + 2 * SZ_T);
    const int tid = threadIdx.x, lane = tid & 63, wave = tid >> 6;
    const int dir = wave >> 1, sl = wave & 1, g = lane >> 4, li = lane & 15;
    const int fr = tid >> 2, fj = tid & 3;
    const bool with_ctx = l < 3;
    for (int it = vb; it < 32; it += nvb) {
        const int b = it >> 2, h = it & 3;
        float lg2[2];
#pragma unroll
        for (int dd = 0; dd < 2; ++dd) lg2[dd] = log2f(sigmoidf_(p.in[I_RDEC][(l * 2 + dd) * 4 + h]));
        const float g64 = exp2f((dir ? lg2[1] : lg2[0]) * 64.f);
        float invr[8];
#pragma unroll
        for (int ii = 0; ii < 8; ++ii) invr[ii] = expf(-(float)(8 * fj + ii) * (9.210340371976184f / 32.f)) * 0.15915494309189535f;
        f32x4 S[4][2];
#pragma unroll
        for (int mt = 0; mt < 4; ++mt)
#pragma unroll
            for (int nt = 0; nt < 2; ++nt) S[mt][nt] = (f32x4){0.f, 0.f, 0.f, 0.f};
        u32x4 rq[2][2], rk[2][2], rv[2][2];
#define RET_PREFETCH(ci_)                                                                             \
    _Pragma("unroll") for (int dd = 0; dd < 2; ++dd) {                                                \
        const ChunkInfo cc = chunk_info<64>((ci_), dd, b);                                            \
        const bf16_t* base = U + (cc.rowbase + cc.t0 + fr) * INW + h * 64 + 8 * fj;                   \
        rq[dd][0] = *(const u32x4*)(base + C_RQ);                                                     \
        rq[dd][1] = *(const u32x4*)(base + C_RQ + 32);                                                \
        rk[dd][0] = *(const u32x4*)(base + C_RK);                                                     \
        rk[dd][1] = *(const u32x4*)(base + C_RK + 32);                                                \
        rv[dd][0] = *(const u32x4*)(base + C_RV);                                                     \
        rv[dd][1] = *(const u32x4*)(base + C_RV + 32);                                                \
    }
        RET_PREFETCH(0);
        for (int ci = 0; ci < 36; ++ci) {
            __syncthreads();
#pragma unroll
            for (int dd = 0; dd < 2; ++dd) {
                const ChunkInfo cc = chunk_info<64>(ci, dd, b);
                bf16_t* Q = lds + dd * 3 * 64 * LS;
                bf16_t* K = Q + 64 * LS;
                bf16_t* V = K + 64 * LS;
                const float pp1 = (float)((dd ? 63 - fr : fr) + 1);
                const float fq = exp2f(lg2[dd] * pp1), fk = 0.125f * exp2f(-lg2[dd] * pp1);
                const unsigned qa[4] = {rq[dd][0][0], rq[dd][0][1], rq[dd][0][2], rq[dd][0][3]};
                const unsigned qb[4] = {rq[dd][1][0], rq[dd][1][1], rq[dd][1][2], rq[dd][1][3]};
                const unsigned ka[4] = {rk[dd][0][0], rk[dd][0][1], rk[dd][0][2], rk[dd][0][3]};
                const unsigned kb[4] = {rk[dd][1][0], rk[dd][1][1], rk[dd][1][2], rk[dd][1][3]};
                float q1[8], q2[8], k1[8], k2[8];
#pragma unroll
                for (int w = 0; w < 4; ++w) {
                    q1[2 * w] = lo16(qa[w]); q1[2 * w + 1] = hi16(qa[w]);
                    q2[2 * w] = lo16(qb[w]); q2[2 * w + 1] = hi16(qb[w]);
                    k1[2 * w] = lo16(ka[w]); k1[2 * w + 1] = hi16(ka[w]);
                    k2[2 * w] = lo16(kb[w]); k2[2 * w + 1] = hi16(kb[w]);
                }
                if (!cc.isctx) {
                    const float pos = (float)(cc.t0 + fr);
#pragma unroll
                    for (int ii = 0; ii < 8; ++ii) {
                        float rev = pos * invr[ii];
                        rev -= floorf(rev);
                        const float cs = __builtin_amdgcn_cosf(rev), sn = __builtin_amdgcn_sinf(rev);
                        const float a1 = q1[ii], a2 = q2[ii];
                        q1[ii] = a1 * cs - a2 * sn;
                        q2[ii] = a1 * sn + a2 * cs;
                        const float b1 = k1[ii], b2 = k2[ii];
                        k1[ii] = b1 * cs - b2 * sn;
                        k2[ii] = b1 * sn + b2 * cs;
                    }
                }
                uint4 o1, o2;
                o1.x = cvt_pk(q1[0] * fq, q1[1] * fq); o1.y = cvt_pk(q1[2] * fq, q1[3] * fq);
                o1.z = cvt_pk(q1[4] * fq, q1[5] * fq); o1.w = cvt_pk(q1[6] * fq, q1[7] * fq);
                o2.x = cvt_pk(q2[0] * fq, q2[1] * fq); o2.y = cvt_pk(q2[2] * fq, q2[3] * fq);
                o2.z = cvt_pk(q2[4] * fq, q2[5] * fq); o2.w = cvt_pk(q2[6] * fq, q2[7] * fq);
                *(uint4*)(Q + fr * LS + 8 * fj) = o1;
                *(uint4*)(Q + fr * LS + 32 + 8 * fj) = o2;
                o1.x = cvt_pk(k1[0] * fk, k1[1] * fk); o1.y = cvt_pk(k1[2] * fk, k1[3] * fk);
                o1.z = cvt_pk(k1[4] * fk, k1[5] * fk); o1.w = cvt_pk(k1[6] * fk, k1[7] * fk);
                o2.x = cvt_pk(k2[0] * fk, k2[1] * fk); o2.y = cvt_pk(k2[2] * fk, k2[3] * fk);
                o2.z = cvt_pk(k2[4] * fk, k2[5] * fk); o2.w = cvt_pk(k2[6] * fk, k2[7] * fk);
                *(uint4*)(K + fr * LS + 8 * fj) = o1;
                *(uint4*)(K + fr * LS + 32 + 8 * fj) = o2;
                *(u32x4*)(V + fr * LS + 8 * fj) = rv[dd][0];
                *(u32x4*)(V + fr * LS + 32 + 8 * fj) = rv[dd][1];
            }
            __syncthreads();
            if (ci + 1 < 36) { RET_PREFETCH(ci + 1); }
            const ChunkInfo c = chunk_info<64>(ci, dir, b);
            const bool need_o = !c.isctx || with_ctx;
            const bf16_t* Q = lds + dir * 3 * 64 * LS;
            const bf16_t* K = Q + 64 * LS;
            const bf16_t* V = K + 64 * LS;
            f32x4 o[4][2];
            if (dir == 0) ret_step<0>(Q, K, V, S, o, sl, g, li, g64, need_o);
            else          ret_step<1>(Q, K, V, S, o, sl, g, li, g64, need_o);
            if (need_o) {
                const int chunk = c.t0 >> 6;
                const bool second = c.isctx ? (dir ? chunk <= 1 : chunk >= 2) : (dir ? chunk <= 15 : chunk >= 16);
#pragma unroll
                for (int mt = 0; mt < 4; ++mt)
#pragma unroll
                    for (int nt = 0; nt < 2; ++nt)
#pragma unroll
                        for (int r = 0; r < 4; ++r) {
                            const size_t row = c.rowbase + c.t0 + 16 * mt + 4 * g + r;
                            bf16_t* dst = TMP + row * 256 + h * 64 + 32 * sl + 16 * nt + li;
                            float v = o[mt][nt][r];
                            if (second) v += bf2f(*dst);
                            *dst = f2bf(v);
                        }
            }
        }
#undef RET_PREFETCH
        __syncthreads();
        const int nrt = with_ctx ? (T + LC) : T;
        for (int r0 = 0; r0 < nrt; r0 += 64) {
            const int rr = r0 + (tid >> 2), pr = tid & 3;
            const size_t row = rr < T ? (size_t)b * T + rr : (size_t)LAT + (size_t)b * LC + (rr - T);
            const uint4 t0v = *(const uint4*)(TMP + row * 256 + h * 64 + pr * 16);
            const uint4 t1v = *(const uint4*)(TMP + row * 256 + h * 64 + pr * 16 + 8);
            const unsigned tw[8] = {t0v.x, t0v.y, t0v.z, t0v.w, t1v.x, t1v.y, t1v.z, t1v.w};
            float o16[16];
            float s1 = 0.f;
#pragma unroll
            for (int w = 0; w < 8; ++w) {
                o16[2 * w] = lo16(tw[w]);
                o16[2 * w + 1] = hi16(tw[w]);
                s1 += o16[2 * w] + o16[2 * w + 1];
            }
            s1 += __shfl_xor(s1, 1); s1 += __shfl_xor(s1, 2);
            const float mu = s1 * (1.f / 64.f);
            float s2 = 0.f;
#pragma unroll
            for (int i = 0; i < 16; ++i) { const float dd = o16[i] - mu; s2 += dd * dd; }
            s2 += __shfl_xor(s2, 1); s2 += __shfl_xor(s2, 2);
            const float rs = rsqrtf(s2 * (1.f / 64.f) + EPS);
            bf16_t* zp = U + row * INW + C_RZ + h * 64 + pr * 16;
            const uint4 z0 = *(const uint4*)zp;
            const uint4 z1 = *(const uint4*)(zp + 8);
            const unsigned zw[8] = {z0.x, z0.y, z0.z, z0.w, z1.x, z1.y, z1.z, z1.w};
            unsigned yw[8];
#pragma unroll
            for (int w = 0; w < 8; ++w) {
                const float ya = (o16[2 * w] - mu) * rs * siluf_(lo16(zw[w]));
                const float yb = (o16[2 * w + 1] - mu) * rs * siluf_(hi16(zw[w]));
                yw[w] = cvt_pk(ya, yb);
            }
            *(uint4*)zp = make_uint4(yw[0], yw[1], yw[2], yw[3]);
            *(uint4*)(zp + 8) = make_uint4(yw[4], yw[5], yw[6], yw[7]);
        }
        __syncthreads();
    }
}

__device__ void phase_swa(const Params& p, int l, char* smem, int vb, int nvb) {
    float* sK = (float*)smem;
    float* sV = sK + 64 * 68;
    bf16_t* U = (bf16_t*)(p.ws + OFF_U);
    const int tid = threadIdx.x;
    const bool with_ctx = l < 3;
    const int nlat = 8 * 4 * 32, nctx = with_ctx ? 8 * 4 * 4 : 0;
    for (int it = vb; it < nlat + nctx; it += nvb) {
        const bool cq = it >= nlat;
        const int id = cq ? it - nlat : it;
        int qt, hq, b;
        if (!cq) { qt = id & 31; hq = (id >> 5) & 3; b = id >> 7; }
        else     { qt = id & 3;  hq = (id >> 2) & 3; b = id >> 4; }
        const int kvh = hq >> 1;
        const int qi = tid >> 2, part = tid & 3;
        const int tq = qt * 64 + qi;
        const size_t qrow = cq ? (size_t)LAT + b * LC + tq : (size_t)b * T + tq;
        float q[64];
        {
            const bf16_t* qp = U + qrow * INW + C_SQ + hq * 64;
#pragma unroll
            for (int j = 0; j < 64; ++j) q[j] = bf2f(qp[j]);
        }
        if (!cq) {
            const float prow = (float)(tq >> 6), pcol = (float)(tq & 63);
#pragma unroll
            for (int i = 0; i < 32; ++i) {
                const float inv = expf(-(float)(i & 15) * (9.210340371976184f / 16.f));
                const float ang = ((i < 16) ? prow : pcol) * inv;
                const float cs = __cosf(ang), sn = __sinf(ang);
                const float x1 = q[i], x2 = q[i + 32];
                q[i] = x1 * cs - x2 * sn;
                q[i + 32] = x1 * sn + x2 * cs;
            }
        }
#pragma unroll
        for (int j = 0; j < 64; ++j) q[j] *= 0.125f;
        float m = -1e30f, lsum = 0.f, acc[64];
#pragma unroll
        for (int j = 0; j < 64; ++j) acc[j] = 0.f;
        const int nloc = cq ? 0 : 5;
        for (int ti = 0; ti < nloc + 4; ++ti) {
            const bool kctx = ti >= nloc;
            const int ktile = kctx ? ti - nloc : qt - 2 + ti;
            if (!kctx && (ktile < 0 || ktile >= 32)) continue;
            __syncthreads();
            {
                const int kk = tid >> 2, d0 = (tid & 3) * 16;
                const int tk = ktile * 64 + kk;
                const size_t krow = kctx ? (size_t)LAT + b * LC + tk : (size_t)b * T + tk;
#pragma unroll
                for (int i = 0; i < 16; ++i) {
                    sK[kk * 68 + d0 + i] = bf2f(U[krow * INW + C_SK + kvh * 64 + d0 + i]);
                    sV[kk * 68 + d0 + i] = bf2f(U[krow * INW + C_SV + kvh * 64 + d0 + i]);
                }
            }
            __syncthreads();
            if (!kctx) {
                const int kk = tid >> 2, pr = tid & 3;
                const int tk = ktile * 64 + kk;
                const float prow = (float)(tk >> 6), pcol = (float)(tk & 63);
#pragma unroll
                for (int ii = 0; ii < 8; ++ii) {
                    const int i = pr * 8 + ii;
                    const float inv = expf(-(float)(i & 15) * (9.210340371976184f / 16.f));
                    const float ang = ((i < 16) ? prow : pcol) * inv;
                    const float cs = __cosf(ang), sn = __sinf(ang);
                    const float x1 = sK[kk * 68 + i], x2 = sK[kk * 68 + i + 32];
                    sK[kk * 68 + i] = x1 * cs - x2 * sn;
                    sK[kk * 68 + i + 32] = x1 * sn + x2 * cs;
                }
                __syncthreads();
            }
            for (int jj = 0; jj < 16; ++jj) {
                const int j = jj * 4 + part;
                const int tk = ktile * 64 + j;
                int dlt = tk - tq;
                dlt = dlt < 0 ? -dlt : dlt;
                const bool valid = kctx || (dlt <= 128);
                if (valid) {
                    float s = 0.f;
#pragma unroll
                    for (int d = 0; d < 64; ++d) s += q[d] * sK[j * 68 + d];
                    if (s > m) {
                        const float sc = __expf(m - s);
                        lsum *= sc;
#pragma unroll
                        for (int d = 0; d < 64; ++d) acc[d] *= sc;
                        m = s;
                    }
                    const float pw = __expf(s - m);
                    lsum += pw;
#pragma unroll
                    for (int d = 0; d < 64; ++d) acc[d] += pw * sV[j * 68 + d];
                }
            }
        }
#pragma unroll
        for (int off = 1; off <= 2; off <<= 1) {
            const float m2 = __shfl_xor(m, off), l2 = __shfl_xor(lsum, off);
            const float mn = fmaxf(m, m2);
            const float s1 = __expf(m - mn), s2 = __expf(m2 - mn);
            lsum = lsum * s1 + l2 * s2;
#pragma unroll
            for (int d = 0; d < 64; ++d) acc[d] = acc[d] * s1 + __shfl_xor(acc[d], off) * s2;
            m = mn;
        }
        const float snk = p.in[I_SINK][l * 4 + hq];
        const float mn = fmaxf(m, snk);
        const float s1 = __expf(m - mn);
        lsum = lsum * s1 + __expf(snk - mn);
        const float sc = s1 / lsum;
#pragma unroll
        for (int i = 0; i < 16; ++i) {
            const float a = (part == 0) ? acc[i] : (part == 1) ? acc[16 + i] : (part == 2) ? acc[32 + i] : acc[48 + i];
            const int e2 = part * 16 + i;
            const float z = bf2f(U[qrow * INW + C_SZ + hq * 64 + e2]);
            U[qrow * INW + C_SZ + hq * 64 + e2] = f2bf(a * sc * siluf_(z));
        }
    }
}


#include <hip/hip_cooperative_groups.h>
namespace cg = cooperative_groups;

constexpr int SMEM_BYTES = 60 * 1024;

__global__ void __launch_bounds__(NT) fwd_megakernel(Params p) {
    __shared__ __attribute__((aligned(16))) char smem[SMEM_BYTES];
    cg::grid_group grid = cg::this_grid();
    const int vb = blockIdx.x, nvb = gridDim.x;
    phase_prep(p, smem, vb, nvb);
    grid.sync();
    for (int l = 0; l < 4; ++l) {
        phase_E(p, l, smem, vb, nvb);
        grid.sync();
        phase_gemm<false>(p, l, smem, vb, nvb);
        grid.sync();
        if (vb < 32) phase_gdn(p, l, smem, vb, 32);
        else if (vb < 64) phase_ret_chain(p, l, smem, vb - 32, 32);
        else if (vb < 96) phase_lru(p, l, smem, vb - 64, 32);
        else phase_swa(p, l, smem, vb - 96, nvb - 96);
        grid.sync();
        phase_gemm<true>(p, l, smem, vb, nvb);
        grid.sync();
    }
    phase_E(p, 4, smem, vb, nvb);
}

extern "C" void kernel_launch(void* const* d_in, const int* in_sizes, int n_in, void* d_out, int out_size, void* d_ws,
                              size_t ws_size, hipStream_t stream) {
    static int grid_blocks = 0;
    if (grid_blocks == 0) {
        if (n_in != 23 || ws_size < WS_END) {
            fprintf(stderr, "kernel_launch: unexpected n_in %d or ws_size %zu (< %zu)\n", n_in, ws_size, (size_t)WS_END);
            grid_blocks = -1;
            return;
        }
        int dev = 0, cus = 0, per_cu = 0;
        (void)hipGetDevice(&dev);
        (void)hipDeviceGetAttribute(&cus, hipDeviceAttributeMultiprocessorCount, dev);
        (void)hipOccupancyMaxActiveBlocksPerMultiprocessor(&per_cu, fwd_megakernel, NT, 0);
        if (per_cu < 1) per_cu = 1;
        if (per_cu > 2) per_cu = 2;
        grid_blocks = cus * per_cu;
        fprintf(stderr, "kernel_launch: cus %d per_cu %d grid %d\n", cus, per_cu, grid_blocks);
    }
    if (grid_blocks < 0) return;
    Params p{};
    for (int i = 0; i < 23; ++i) p.in[i] = (const float*)d_in[i];
    p.out = (float*)d_out;
    p.ws = (unsigned char*)d_ws;
    void* args[] = {&p};
    hipError_t e = hipLaunchCooperativeKernel((void*)fwd_megakernel, dim3(grid_blocks), dim3(NT), args, 0, stream);
    if (e != hipSuccess) fprintf(stderr, "cooperative launch failed: %s (grid %d)\n", hipGetErrorString(e), grid_blocks);
}
```

```cpp
#include <hip/hip_runtime.h>
#include <hip/hip_bf16.h>
#include <cstdio>
#include <cstdint>

typedef unsigned short bf16_t;
typedef __attribute__((ext_vector_type(8))) short bf16x8;
typedef __attribute__((ext_vector_type(4))) float f32x4;
typedef __attribute__((ext_vector_type(4))) short bf16x4;
typedef __attribute__((ext_vector_type(4))) unsigned u32x4;
typedef __attribute__((ext_vector_type(2))) unsigned u32x2;
typedef __attribute__((ext_vector_type(2))) float f32x2;
typedef __attribute__((ext_vector_type(2))) __bf16 bf16v2;

#define NT 512
constexpr int Bsz = 8, T = 2048, LC = 256, DM = 1024, INW = 3344, NPAD = 3584;
constexpr int LAT = Bsz * T, NROW = LAT + Bsz * LC;
constexpr int C_LRUX = 0, C_LRUZ = 256, C_GQ = 512, C_GZ = 1280, C_GA = 1536, C_GB = 1544;
constexpr int C_RQ = 1552, C_RK = 1808, C_RV = 2064, C_RZ = 2320, C_SQ = 2576, C_SK = 2832, C_SV = 2960, C_SZ = 3088;
constexpr float EPS = 1e-6f;

enum { I_X = 0, I_C, I_CTX, I_CCTX, I_WMOD, I_BMOD, I_PREG, I_POSTG, I_WIN, I_WOUT, I_LCW, I_LCB, I_LWR, I_LBR, I_LWI, I_LBI,
       I_LLAM, I_GCW, I_GALOG, I_GDT, I_GNG, I_RDEC, I_SINK };

constexpr int GI = 8 * 4 * 36;
constexpr size_t OFF_MOD = 0;
constexpr size_t OFF_WINT = 1u << 19;
constexpr size_t SZ_WINT = (size_t)NPAD * DM * 2;
constexpr size_t OFF_WOUTT = OFF_WINT + SZ_WINT;
constexpr size_t SZ_WOUTT = (size_t)DM * DM * 2;
constexpr size_t OFF_U = OFF_WOUTT + 2 * SZ_WOUTT;
constexpr size_t SZ_U = (size_t)NROW * INW * 2;
constexpr size_t OFF_P = OFF_U + SZ_U;
constexpr size_t SZ_P = (size_t)NROW * DM * 2;
constexpr size_t OFF_XC = OFF_P + SZ_P;
constexpr size_t SZ_XC = (size_t)Bsz * LC * DM * 4;
constexpr size_t SZ_GT = (size_t)GI * 4096 * 2;
constexpr size_t OFF_GQ = OFF_XC + SZ_XC;
constexpr size_t OFF_GKT = OFF_GQ + SZ_GT;
constexpr size_t OFF_GWD = OFF_GKT + SZ_GT;
constexpr size_t OFF_GUV = OFF_GWD + 2 * SZ_GT;
constexpr size_t OFF_GATT = OFF_GUV + 2 * SZ_GT;
constexpr size_t OFF_GVEC = OFF_GATT + 2 * SZ_GT;
constexpr size_t OFF_AGG = OFF_GVEC + (size_t)2 * GI * 256 * 4;
constexpr size_t WS_END = OFF_AGG + (size_t)8 * 2 * 36 * 256 * 8;
constexpr size_t SZ_T = (size_t)NROW * 256 * 2;
static_assert(4 * SZ_T <= SZ_P, "chain outputs must fit in P");

struct Params {
    const float* in[23];
    float* out;
    unsigned char* ws;
};

__device__ __forceinline__ float bf2f(bf16_t v) { return __uint_as_float(((unsigned)v) << 16); }
__device__ __forceinline__ bf16_t f2bf(float f) {
    unsigned u = __float_as_uint(f);
    u += 0x7fffu + ((u >> 16) & 1u);
    return (bf16_t)(u >> 16);
}
__device__ __forceinline__ float fexp(float x) { return __builtin_amdgcn_exp2f(x * 1.4426950408889634f); }
__device__ __forceinline__ float sigmoidf_(float x) { return __builtin_amdgcn_rcpf(1.f + fexp(-x)); }
__device__ __forceinline__ float siluf_(float x) { return x * __builtin_amdgcn_rcpf(1.f + fexp(-x)); }
__device__ __forceinline__ float softplusf_(float x) { return x > 20.f ? x : log1pf(fexp(x)); }
__device__ __forceinline__ float wave_sum(float v) {
#pragma unroll
    for (int o = 32; o >= 1; o >>= 1) v += __shfl_xor(v, o);
    return v;
}
#define LDS_BARRIER() asm volatile("s_waitcnt lgkmcnt(0)\n\ts_barrier" ::: "memory")
#define MFMA32(a, b, c) __builtin_amdgcn_mfma_f32_16x16x32_bf16((a), (b), (c), 0, 0, 0)
#define MFMA16(a, b, c) __builtin_amdgcn_mfma_f32_16x16x16bf16_1k((a), (b), (c), 0, 0, 0)
__device__ __forceinline__ unsigned cvt_pk(float lo, float hi) {
    const f32x2 v = {lo, hi};
    const bf16v2 b = __builtin_convertvector(v, bf16v2);
    return __builtin_bit_cast(unsigned, b);
}
__device__ __forceinline__ bf16x8 pack8(f32x4 a, f32x4 b) {
    u32x4 u = {cvt_pk(a[0], a[1]), cvt_pk(a[2], a[3]), cvt_pk(b[0], b[1]), cvt_pk(b[2], b[3])};
    return __builtin_bit_cast(bf16x8, u);
}
__device__ __forceinline__ bf16x4 pack4(f32x4 a) {
    u32x2 u = {cvt_pk(a[0], a[1]), cvt_pk(a[2], a[3])};
    return __builtin_bit_cast(bf16x4, u);
}
__device__ __forceinline__ bf16x8 cat8(bf16x4 a, bf16x4 b) { return __builtin_shufflevector(a, b, 0, 1, 2, 3, 4, 5, 6, 7); }
__device__ __forceinline__ bf16x4 lds_tr(const bf16_t* p) {
    return __builtin_amdgcn_ds_read_tr16_b64_v4i16((__attribute__((address_space(3))) bf16x4*)p);
}
__device__ __forceinline__ float lo16(unsigned u) { return __uint_as_float(u << 16); }
__device__ __forceinline__ float hi16(unsigned u) { return __uint_as_float(u & 0xffff0000u); }

__device__ void phase_prep_mod(const Params& p, char* smem, int vb, int nvb, int oz) {
    const int tid = threadIdx.x + oz;
    float* mod = (float*)(p.ws + OFF_MOD);
    float* s = (float*)smem;
    float* red = s + 9 * 1024;
    for (int it = vb; it < 192; it += nvb) {
        __syncthreads();
        const int l = it / 48, c = tid & 63, ks = tid >> 6, col = (it % 48) * 64 + c;
        for (int i = tid; i < 9 * 1024; i += NT) {
            const int r = i >> 10, k = i & 1023;
            const float cv = (r < 8) ? p.in[I_C][r * 1024 + k] : p.in[I_CCTX][k];
            s[i] = siluf_(cv);
        }
        __syncthreads();
        float acc[9];
#pragma unroll
        for (int r = 0; r < 9; ++r) acc[r] = 0.f;
        const float* w = p.in[I_WMOD] + (size_t)l * 1024 * 3072 + (size_t)(ks * 128) * 3072 + col;
#pragma unroll 8
        for (int k = 0; k < 128; ++k) {
            const float wv = w[(size_t)k * 3072];
#pragma unroll
            for (int r = 0; r < 9; ++r) acc[r] += s[r * 1024 + ks * 128 + k] * wv;
        }
#pragma unroll
        for (int r = 0; r < 9; ++r) red[(ks * 9 + r) * 64 + c] = acc[r];
        __syncthreads();
        for (int i = tid; i < 9 * 64; i += NT) {
            const int r = i >> 6, cc = i & 63;
            float v = p.in[I_BMOD][l * 3072 + (it % 48) * 64 + cc];
#pragma unroll
            for (int k = 0; k < 8; ++k) v += red[(k * 9 + r) * 64 + cc];
            mod[(l * 9 + r) * 3072 + (it % 48) * 64 + cc] = v;
        }
    }
}

constexpr int WCONV_TILES = 16 * 27 + 16 * 8;
__device__ __forceinline__ void wconv_tile(const Params& p, int l, int id, char* smem, int oz) {
    const int tid = threadIdx.x + oz;
    float* tile = (float*)smem;
    const bool isin = id < 16 * 27;
    if (!isin) id -= 16 * 27;
    const int NN = isin ? INW : DM;
    const int ntn = isin ? 27 : 8;
    const int k0 = (id / ntn) * 64, n0 = (id % ntn) * 128;
    const float* W = (isin ? p.in[I_WIN] : p.in[I_WOUT]) + (size_t)l * 1024 * NN;
    bf16_t* Wt = (bf16_t*)(p.ws + (isin ? OFF_WINT : OFF_WOUTT + (size_t)(l & 1) * SZ_WOUTT));
    float4 v[4];
#pragma unroll
    for (int i = 0; i < 4; ++i) {
        const int pc = tid + 512 * i, r = pc >> 5, c4 = (pc & 31) * 4;
        const int n = n0 + c4;
        v[i] = (n < NN) ? *(const float4*)(W + (size_t)(k0 + r) * NN + n) : make_float4(0.f, 0.f, 0.f, 0.f);
    }
    __syncthreads();
#pragma unroll
    for (int i = 0; i < 4; ++i) {
        const int pc = tid + 512 * i, r = pc >> 5, c4 = (pc & 31) * 4;
        tile[r * 129 + c4] = v[i].x; tile[r * 129 + c4 + 1] = v[i].y; tile[r * 129 + c4 + 2] = v[i].z; tile[r * 129 + c4 + 3] = v[i].w;
    }
    __syncthreads();
    {
        const int nn = tid >> 2, q = tid & 3, n = n0 + nn;
        if (n < NN) {
            u32x4 o0, o1;
#pragma unroll
            for (int w = 0; w < 4; ++w) {
                o0[w] = cvt_pk(tile[(q * 16 + 2 * w) * 129 + nn], tile[(q * 16 + 2 * w + 1) * 129 + nn]);
                o1[w] = cvt_pk(tile[(q * 16 + 8 + 2 * w) * 129 + nn], tile[(q * 16 + 8 + 2 * w + 1) * 129 + nn]);
            }
            *(u32x4*)(Wt + (size_t)n * 1024 + k0 + q * 16) = o0;
            *(u32x4*)(Wt + (size_t)n * 1024 + k0 + q * 16 + 8) = o1;
        }
    }
}

__device__ void phase_prep(const Params& p, char* smem, int vb, int nvb, int oz) {
    if (vb < 192) phase_prep_mod(p, smem, vb, 192, oz);
    else for (int id = vb - 192; id < WCONV_TILES; id += nvb - 192) wconv_tile(p, 0, id, smem, oz);
}

__device__ void phase_E_rows(const Params& p, int l, char* smem, int vb, int nvb, int oz) {
    const int tid = threadIdx.x + oz, lane = tid & 63, wave = tid >> 6;
    const float* mod = (const float*)(p.ws + OFF_MOD);
    bf16_t* P = (bf16_t*)(p.ws + OFF_P);
    float* XC = (float*)(p.ws + OFF_XC);
    const int nrows = (l == 4) ? LAT : NROW;
    const int per = (nrows + nvb * 8 - 1) / (nvb * 8);
    const int rbeg = (vb * 8 + wave) * per, rend = (rbeg + per < nrows) ? rbeg + per : nrows;
    if (rbeg >= nrows) return;
    float4 gp[4], pa[4], sh[4];
    int cur_mr = -1;
    float4 nx[4];
    u32x2 ny[4];
#define E2_LOAD(row_)                                                                              \
    {                                                                                              \
        const int rr_ = (row_);                                                                    \
        const float* src_ = (l == 0) ? ((rr_ >= LAT) ? p.in[I_CTX] + (size_t)(rr_ - LAT) * DM : p.in[I_X] + (size_t)rr_ * DM) \
                                     : ((rr_ >= LAT) ? XC + (size_t)(rr_ - LAT) * DM : p.out + (size_t)rr_ * DM); \
        _Pragma("unroll") for (int k = 0; k < 4; ++k) {                                            \
            nx[k] = *(const float4*)(src_ + k * 256 + lane * 4);                                   \
            if (l > 0) ny[k] = *(const u32x2*)(P + (size_t)rr_ * DM + k * 256 + lane * 4);         \
        }                                                                                          \
    }
    E2_LOAD(rbeg)
    for (int row = rbeg; row < rend; ++row) {
        const bool isctx = row >= LAT;
        const int mr = isctx ? 8 : row / T;
        if (mr != cur_mr) {
            cur_mr = mr;
#pragma unroll
            for (int k = 0; k < 4; ++k) {
                const int col = k * 256 + lane * 4;
                if (l > 0) {
                    const float4 g = *(const float4*)(mod + ((l - 1) * 9 + mr) * 3072 + 2048 + col);
                    const float4 pg = *(const float4*)(p.in[I_POSTG] + (l - 1) * DM + col);
                    gp[k] = make_float4(g.x * pg.x, g.y * pg.y, g.z * pg.z, g.w * pg.w);
                }
                if (l < 4) {
                    const float4 pre = *(const float4*)(p.in[I_PREG] + l * DM + col);
                    const float4 sc = *(const float4*)(mod + (l * 9 + mr) * 3072 + 1024 + col);
                    sh[k] = *(const float4*)(mod + (l * 9 + mr) * 3072 + col);
                    pa[k] = make_float4(pre.x * (1.f + sc.x), pre.y * (1.f + sc.y), pre.z * (1.f + sc.z), pre.w * (1.f + sc.w));
                }
            }
        }
        float* xcur = isctx ? XC + (size_t)(row - LAT) * DM : p.out + (size_t)row * DM;
        float4 xv[4];
        u32x2 yr[4];
#pragma unroll
        for (int k = 0; k < 4; ++k) { xv[k] = nx[k]; yr[k] = ny[k]; }
        if (row + 1 < rend) E2_LOAD(row + 1)
        float y[4][4];
        float ss = 0.f;
#pragma unroll
        for (int k = 0; k < 4; ++k) {
            y[k][0] = lo16(yr[k][0]); y[k][1] = hi16(yr[k][0]); y[k][2] = lo16(yr[k][1]); y[k][3] = hi16(yr[k][1]);
            ss += y[k][0] * y[k][0] + y[k][1] * y[k][1] + y[k][2] * y[k][2] + y[k][3] * y[k][3];
        }
        float rs = 0.f;
        if (l > 0) {
            ss = wave_sum(ss);
            rs = rsqrtf(ss * (1.f / DM) + EPS);
        }
        float ss2 = 0.f;
#pragma unroll
        for (int k = 0; k < 4; ++k) {
            if (l > 0) {
                xv[k].x += gp[k].x * (y[k][0] * rs);
                xv[k].y += gp[k].y * (y[k][1] * rs);
                xv[k].z += gp[k].z * (y[k][2] * rs);
                xv[k].w += gp[k].w * (y[k][3] * rs);
            }
            *(float4*)(xcur + k * 256 + lane * 4) = xv[k];
            ss2 += xv[k].x * xv[k].x + xv[k].y * xv[k].y + xv[k].z * xv[k].z + xv[k].w * xv[k].w;
        }
        if (l < 4) {
            ss2 = wave_sum(ss2);
            const float rs2 = rsqrtf(ss2 * (1.f / DM) + EPS);
#pragma unroll
            for (int k = 0; k < 4; ++k) {
                u32x2 hv;
                hv[0] = cvt_pk(xv[k].x * rs2 * pa[k].x + sh[k].x, xv[k].y * rs2 * pa[k].y + sh[k].y);
                hv[1] = cvt_pk(xv[k].z * rs2 * pa[k].z + sh[k].z, xv[k].w * rs2 * pa[k].w + sh[k].w);
                *(u32x2*)(P + (size_t)row * DM + k * 256 + lane * 4) = hv;
            }
        }
    }
#undef E2_LOAD
}


namespace g8 {
#define G8_LAS __attribute__((address_space(3)))
constexpr int BM = 256, BK = 64, HALF = 128, HTB = HALF * BK * 2, STAGE_BYTES = 8 * HTB, NXCD = 8, WGM = 8;
__device__ __forceinline__ int lds_byte(int r, int c) { const int st = (r >> 4) * 2 + (c >> 5), rr = r & 15, cc = c & 31, ob = rr * 64 + cc * 2; return st * 1024 + (ob ^ (((ob >> 9) & 1) << 5)); }
__device__ __forceinline__ void stage_rc(int b, int& R, int& C) { const int st = b / 1024, sb = b % 1024, swz = sb ^ (((sb >> 9) & 1) << 5); R = (st >> 1) * 16 + swz / 64; C = (st & 1) * 32 + (swz % 64) / 2; }
__device__ __forceinline__ int perm32(int rho) { const int n = rho >> 4, i = rho & 15; return 8 * (i >> 2) + 4 * n + (i & 3); }
struct Unit { int pm, pn; };
struct Order {
    int nM, nN, nwg, G, c;
    __device__ __forceinline__ void init(int M, int N, int G_, int c_) { nM = M / BM; nN = N / BM; nwg = nM * nN; G = G_; c = c_; }
    __device__ __forceinline__ bool next(int i, Unit& u) const {
        const long L = (long)i * G + c; if (L >= nwg) return false;
        int wgid = (int)L; { const int q = nwg / NXCD, r = nwg % NXCD, xcd = wgid % NXCD, off = wgid / NXCD; wgid = (xcd < r ? xcd * (q + 1) : r * (q + 1) + (xcd - r) * q) + off; }
        const int nig = WGM * nN, gid = wgid / nig, fm = gid * WGM, gsz = (nM - fm) < WGM ? (nM - fm) : WGM;
        u.pm = fm + ((wgid % nig) % gsz); u.pn = (wgid % nig) / gsz; return true;
    }
};
template <bool OUTP>
__device__ __forceinline__ size_t colb(int t) {
    if (OUTP) {
        const int gsel = t >> 2;
        const int zoff = (gsel == 0) ? C_LRUZ : (gsel == 1) ? C_GZ : (gsel == 2) ? C_RZ : C_SZ;
        return (size_t)(zoff + (t & 3) * 64) * 2;
    }
    return (size_t)t * (BK * 2);
}
template <bool OUTP>
__device__ __forceinline__ void gemm_phase(const Params& p, int l, char* smem, int vb, int nvb) {
    G8_LAS unsigned char* lds = (G8_LAS unsigned char*)smem;
    const int tid = threadIdx.x, wid = __builtin_amdgcn_readfirstlane(tid >> 6), lane = tid & 63, wr = wid >> 2, wc = wid & 3, fr = lane & 15, fq = lane >> 4;
    constexpr int K = DM, nt = K / BK;
    const int M = OUTP ? ((l == 3) ? LAT : NROW) : NROW;
    const int N = OUTP ? DM : INW;
    const int NP = OUTP ? DM : NPAD;
    const int lda = OUTP ? INW : DM;
    const bf16_t* Aptr = OUTP ? (const bf16_t*)(p.ws + OFF_U) : (const bf16_t*)(p.ws + OFF_P);
    const bf16_t* Bptr = OUTP ? (const bf16_t*)(p.ws + OFF_WOUTT + (size_t)(l & 1) * SZ_WOUTT) : (const bf16_t*)(p.ws + OFF_WINT);
    bf16_t* Cptr = OUTP ? (bf16_t*)(p.ws + OFF_P) : (bf16_t*)(p.ws + OFF_U);
    const int ldc = OUTP ? DM : INW;
    Order S; S.init(M, NP, nvb, vb);
    unsigned voffA[2], voffB[2];
#pragma unroll
    for (int i = 0; i < 2; ++i) { int R, C; stage_rc(tid * 16 + i * 8192, R, C); const int Rb = (R & ~31) + perm32(R & 31);
        voffA[i] = (unsigned)(R * lda + C) * 2u; voffB[i] = (unsigned)(Rb * K + C) * 2u; }
    const size_t kstep = (size_t)(BK * 2);
    const size_t hstepA = (size_t)HALF * lda * 2, hstepB = (size_t)HALF * K * 2;
    const size_t tstepA = 2 * hstepA, tstepB = 2 * hstepB;
    const unsigned ldsw = (unsigned)wid * 1024u;
    const int aoff = lds_byte(wr * 64 + fr, fq * 8), boff = lds_byte(wc * 32 + fr, fq * 8);
#define G8_SA(b, h) (((b) * 2 + (h)) * HTB)
#define G8_SB(b, h) ((4 + (b) * 2 + (h)) * HTB)
#define G8_STAGE(bufoff, gbase, voff) do { _Pragma("unroll") for (int _i = 0; _i < 2; ++_i) \
        __builtin_amdgcn_global_load_lds((const unsigned*)((const char*)(gbase) + (voff)[_i]), (G8_LAS unsigned*)(lds + (bufoff) + ldsw + _i * 8192), 16, 0, 0); } while (0)
#define G8_LDA(dst, b, h) do { _Pragma("unroll") for (int m = 0; m < 4; ++m) _Pragma("unroll") for (int k = 0; k < 2; ++k) dst[m][k] = *(const G8_LAS bf16x8*)(lds + G8_SA(b, h) + aoff + m * 2048 + k * 1024); } while (0)
#define G8_LDB(dst, b, h) do { _Pragma("unroll") for (int n = 0; n < 2; ++n) _Pragma("unroll") for (int k = 0; k < 2; ++k) dst[n][k] = *(const G8_LAS bf16x8*)(lds + G8_SB(b, h) + boff + n * 2048 + k * 1024); } while (0)
#define G8_MMA(ai, bj, At, Bt) do { __builtin_amdgcn_s_setprio(1); _Pragma("unroll") for (int m = 0; m < 4; ++m) _Pragma("unroll") for (int n = 0; n < 2; ++n) _Pragma("unroll") for (int k = 0; k < 2; ++k) \
        acc[ai][bj][m][n] = __builtin_amdgcn_mfma_f32_16x16x32_bf16(Bt[n][k], At[m][k], acc[ai][bj][m][n], 0, 0, 0); __builtin_amdgcn_s_setprio(0); } while (0)
#define G8_WAIT_V(n) asm volatile("s_waitcnt vmcnt(" #n ")" ::: "memory")
#define G8_WAIT_L(n) asm volatile("s_waitcnt lgkmcnt(" #n ")" ::: "memory")
#define G8_BAR __builtin_amdgcn_s_barrier()
#define G8_SCHED __builtin_amdgcn_sched_barrier(0)
    Unit cur, nxt; int ui = 0;
    if (!S.next(0, cur)) return;
    f32x4 acc[2][2][4][2];
#pragma unroll
    for (int a = 0; a < 2; ++a)
#pragma unroll
        for (int b = 0; b < 2; ++b)
#pragma unroll
            for (int m = 0; m < 4; ++m)
#pragma unroll
                for (int n = 0; n < 2; ++n) acc[a][b][m][n] = (f32x4){0.f, 0.f, 0.f, 0.f};
    bf16x8 At[4][2], B0[2][2], B1[2][2];
    const char* cA = (const char*)Aptr + (size_t)cur.pm * tstepA; const char* cB = (const char*)Bptr + (size_t)cur.pn * tstepB;
    {
        const char* a0 = cA + colb<OUTP>(0);
        G8_STAGE(G8_SB(0, 0), cB, voffB); G8_STAGE(G8_SA(0, 0), a0, voffA); G8_STAGE(G8_SB(0, 1), cB + hstepB, voffB); G8_STAGE(G8_SA(0, 1), a0 + hstepA, voffA);
        if (wr == 1) G8_BAR;
        G8_WAIT_V(4); G8_BAR;
        G8_STAGE(G8_SB(1, 0), cB + kstep, voffB); G8_STAGE(G8_SA(1, 0), a0 + kstep, voffA); G8_STAGE(G8_SB(1, 1), cB + hstepB + kstep, voffB);
        G8_WAIT_V(6); G8_BAR;
    }
    for (;;) {
        const bool has_next = S.next(ui + 1, nxt);
        const char* nA = has_next ? (const char*)Aptr + (size_t)nxt.pm * tstepA : cA; const char* nB = has_next ? (const char*)Bptr + (size_t)nxt.pn * tstepB : cB;
#pragma clang loop unroll(disable)
        for (int t = 0; t < nt; t += 2) {
            const bool last = (t == nt - 2);
            const char* a1 = cA + colb<OUTP>(t) + kstep;
            const char* a2 = last ? nA + colb<OUTP>(0) : cA + colb<OUTP>(t + 2); const char* b2 = last ? nB : cB + (size_t)(t + 2) * kstep;
            const char* a3 = a2 + kstep; const char* b3 = b2 + kstep;
            G8_LDB(B0, 0, 0); G8_SCHED; G8_LDA(At, 0, 0); G8_STAGE(G8_SA(1, 1), a1 + hstepA, voffA);
            G8_WAIT_L(8); G8_BAR; G8_WAIT_L(0); G8_MMA(0, 0, At, B0); G8_BAR; G8_SCHED;
            G8_LDB(B1, 0, 1); G8_STAGE(G8_SB(0, 0), b2, voffB);
            G8_BAR; G8_WAIT_L(0); G8_MMA(0, 1, At, B1); G8_BAR;
            G8_LDA(At, 0, 1); G8_STAGE(G8_SA(0, 0), a2, voffA);
            G8_BAR; G8_WAIT_L(0); G8_MMA(1, 0, At, B0); G8_BAR; G8_SCHED;
            G8_STAGE(G8_SB(0, 1), b2 + hstepB, voffB);
            G8_WAIT_V(6); G8_BAR; G8_MMA(1, 1, At, B1); G8_BAR;
            G8_LDB(B0, 1, 0); G8_SCHED; G8_LDA(At, 1, 0); G8_STAGE(G8_SA(0, 1), a2 + hstepA, voffA);
            G8_WAIT_L(8); G8_BAR; G8_WAIT_L(0); G8_MMA(0, 0, At, B0); G8_BAR; G8_SCHED;
            G8_LDB(B1, 1, 1); G8_STAGE(G8_SB(1, 0), b3, voffB);
            G8_BAR; G8_WAIT_L(0); G8_MMA(0, 1, At, B1); G8_BAR;
            G8_LDA(At, 1, 1); G8_STAGE(G8_SA(1, 0), a3, voffA);
            G8_BAR; G8_WAIT_L(0); G8_MMA(1, 0, At, B0); G8_BAR; G8_SCHED;
            G8_STAGE(G8_SB(1, 1), b3 + hstepB, voffB);
            G8_WAIT_V(6); G8_BAR; G8_MMA(1, 1, At, B1); G8_BAR;
        }
        {
            const int row0 = cur.pm * BM + wr * 64 + fr, col0 = cur.pn * BM + wc * 32 + 8 * fq;
#pragma unroll
            for (int ai = 0; ai < 2; ++ai)
#pragma unroll
                for (int m = 0; m < 4; ++m) {
                    bf16_t* rowp = Cptr + (size_t)(row0 + ai * HALF + m * 16) * ldc + col0;
#pragma unroll
                    for (int bj = 0; bj < 2; ++bj) {
                        if (col0 + bj * HALF < N) {
                            const f32x4 v0 = acc[ai][bj][m][0], v1 = acc[ai][bj][m][1];
                            u32x4 w = {cvt_pk(v0[0], v0[1]), cvt_pk(v0[2], v0[3]), cvt_pk(v1[0], v1[1]), cvt_pk(v1[2], v1[3])};
                            *(u32x4*)(rowp + bj * HALF) = w;
                        }
                    }
                }
        }
        if (!has_next) break;
#pragma unroll
        for (int a = 0; a < 2; ++a)
#pragma unroll
            for (int b = 0; b < 2; ++b)
#pragma unroll
                for (int m = 0; m < 4; ++m)
#pragma unroll
                    for (int n = 0; n < 2; ++n) acc[a][b][m][n] = (f32x4){0.f, 0.f, 0.f, 0.f};
        cur = nxt; cA = nA; cB = nB; ++ui;
    }
    G8_WAIT_V(0);
    if (wr == 0) G8_BAR;
    G8_BAR;
#undef G8_SA
#undef G8_SB
#undef G8_STAGE
#undef G8_LDA
#undef G8_LDB
#undef G8_MMA
#undef G8_WAIT_V
#undef G8_WAIT_L
#undef G8_BAR
#undef G8_SCHED
}
}

struct ChunkInfo {
    bool isctx;
    int t0, Tseg;
    size_t rowbase;
};
template <int CH>
__device__ __forceinline__ ChunkInfo chunk_info(int ci, int dir, int b) {
    constexpr int NC = LC / CH, NL = T / CH;
    ChunkInfo c;
    c.isctx = ci < NC;
    const int cidx = c.isctx ? ci : ci - NC;
    const int nch = c.isctx ? NC : NL;
    const int chunk = dir ? (nch - 1 - cidx) : cidx;
    c.Tseg = c.isctx ? LC : T;
    c.rowbase = c.isctx ? (size_t)LAT + (size_t)b * LC : (size_t)b * T;
    c.t0 = chunk * CH;
    return c;
}

template <int DIR>
__device__ __forceinline__ void ret_step(const bf16_t* Q, const bf16_t* K, const bf16_t* V, f32x4 (&S)[4], f32x4 (&o)[4],
                                         int sl, int g, int li, float g64, bool need_o) {
    constexpr int LS = 72;
    const int q4 = li >> 2, p4 = li & 3;
    bf16x8 vf[2];
#pragma unroll
    for (int s = 0; s < 2; ++s)
        vf[s] = cat8(lds_tr(V + (32 * s + 4 * g + q4) * LS + 16 * sl + 4 * p4), lds_tr(V + (32 * s + 16 + 4 * g + q4) * LS + 16 * sl + 4 * p4));
    bf16x8 kr[4][2], qr[4][2];
    if (need_o) {
#pragma unroll
        for (int bi = 0; bi < 4; ++bi)
#pragma unroll
            for (int s2 = 0; s2 < 2; ++s2) {
                kr[bi][s2] = *(const bf16x8*)(K + (16 * bi + li) * LS + 32 * s2 + 8 * g);
                qr[bi][s2] = *(const bf16x8*)(Q + (16 * bi + li) * LS + 32 * s2 + 8 * g);
            }
    }
    __builtin_amdgcn_sched_barrier(0);
    bf16x8 af[4][2];
    if (need_o) {
#pragma unroll
        for (int ci = 0; ci < 4; ++ci) {
            u32x4 fr[2];
#pragma unroll
            for (int bi = 0; bi < 4; ++bi) {
                const bool needed = DIR ? (bi >= ci) : (bi <= ci);
                unsigned w0 = 0, w1 = 0;
                if (needed) {
                    f32x4 t = {0.f, 0.f, 0.f, 0.f};
#pragma unroll
                    for (int s2 = 0; s2 < 2; ++s2) t = MFMA32(kr[bi][s2], qr[ci][s2], t);
                    if (bi == ci) {
#pragma unroll
                        for (int r = 0; r < 4; ++r) {
                            const bool keep = DIR ? (4 * g + r >= li) : (4 * g + r <= li);
                            t[r] = keep ? t[r] : 0.f;
                        }
                    }
                    w0 = cvt_pk(t[0], t[1]);
                    w1 = cvt_pk(t[2], t[3]);
                }
                fr[bi >> 1][(bi & 1) * 2] = w0;
                fr[bi >> 1][(bi & 1) * 2 + 1] = w1;
            }
            af[ci][0] = __builtin_bit_cast(bf16x8, fr[0]);
            af[ci][1] = __builtin_bit_cast(bf16x8, fr[1]);
        }
    }
    bf16x8 ka[4][2], qa[4][2];
#pragma unroll
    for (int mt = 0; mt < 4; ++mt)
#pragma unroll
        for (int s = 0; s < 2; ++s) {
            ka[mt][s] = cat8(lds_tr(K + (32 * s + 4 * g + q4) * LS + 16 * mt + 4 * p4), lds_tr(K + (32 * s + 16 + 4 * g + q4) * LS + 16 * mt + 4 * p4));
            if (need_o) qa[mt][s] = cat8(*(const bf16x4*)(Q + (16 * mt + li) * LS + 32 * s + 4 * g), *(const bf16x4*)(Q + (16 * mt + li) * LS + 32 * s + 16 + 4 * g));
        }
    __builtin_amdgcn_sched_barrier(0);
    if (need_o) {
        bf16x8 sf[2];
#pragma unroll
        for (int s = 0; s < 2; ++s) sf[s] = pack8(S[2 * s], S[2 * s + 1]);
#pragma unroll
        for (int ci = 0; ci < 4; ++ci) {
            f32x4 acc = {0.f, 0.f, 0.f, 0.f};
#pragma unroll
            for (int s = 0; s < 2; ++s) {
                acc = MFMA32(sf[s], qa[ci][s], acc);
                acc = MFMA32(vf[s], af[ci][s], acc);
            }
            o[ci] = acc;
        }
    }
#pragma unroll
    for (int mt = 0; mt < 4; ++mt) {
        f32x4 acc = S[mt];
#pragma unroll
        for (int s = 0; s < 2; ++s) acc = MFMA32(ka[mt][s], vf[s], acc);
        S[mt] = acc * g64;
    }
}

__device__ void phase_ret_chain(const Params& p, int l, char* smem, int vb, int nvb, int oz) {
    constexpr int LS = 72;
    constexpr int BUFE = 3 * 64 * LS;
    bf16_t* lds = (bf16_t*)smem;
    bf16_t* U = (bf16_t*)(p.ws + OFF_U);
    const int tid = threadIdx.x + oz, lane = tid & 63, wave = tid >> 6;
    const int sl = wave & 3, g = lane >> 4, li = lane & 15;
    const bool loader = wave >= 4;
    const int at = tid & 255, fr = at >> 2, fj = at & 3;
    const bool with_ctx = l < 3;
    for (int it = vb; it < 64; it += nvb) {
        const int b = it >> 3, h = (it >> 1) & 3, dir = it & 1;
        const float lg2 = log2f(sigmoidf_(p.in[I_RDEC][(l * 2 + dir) * 4 + h]));
        if (loader) {
            float invr[8];
#pragma unroll
            for (int ii = 0; ii < 8; ++ii) invr[ii] = expf(-(float)(8 * fj + ii) * (9.210340371976184f / 32.f)) * 0.15915494309189535f;
            const float pp1 = (float)((dir ? 63 - fr : fr) + 1);
            const float fq = exp2f(lg2 * pp1), fk = 0.125f * exp2f(-lg2 * pp1);
            u32x4 ra[6], rb[6], rc[6];
#define RET_LOAD(R, ci_)                                                                              \
    {                                                                                                 \
        const ChunkInfo cc = chunk_info<64>((ci_), dir, b);                                           \
        const bf16_t* base = U + (cc.rowbase + cc.t0 + fr) * INW + h * 64 + 8 * fj;                   \
        R[0] = *(const u32x4*)(base + C_RQ); R[1] = *(const u32x4*)(base + C_RQ + 32);                \
        R[2] = *(const u32x4*)(base + C_RK); R[3] = *(const u32x4*)(base + C_RK + 32);                \
        R[4] = *(const u32x4*)(base + C_RV); R[5] = *(const u32x4*)(base + C_RV + 32);                \
    }
#define RET_FILL(R, ci_, buf_)                                                                        \
    {                                                                                                 \
        const ChunkInfo cc = chunk_info<64>((ci_), dir, b);                                           \
        bf16_t* Q = lds + (buf_) * BUFE;                                                              \
        bf16_t* K = Q + 64 * LS;                                                                      \
        bf16_t* V = K + 64 * LS;                                                                      \
        float q1[8], q2[8], k1[8], k2[8];                                                             \
        _Pragma("unroll") for (int w = 0; w < 4; ++w) {                                               \
            q1[2 * w] = lo16(R[0][w]); q1[2 * w + 1] = hi16(R[0][w]);                                 \
            q2[2 * w] = lo16(R[1][w]); q2[2 * w + 1] = hi16(R[1][w]);                                 \
            k1[2 * w] = lo16(R[2][w]); k1[2 * w + 1] = hi16(R[2][w]);                                 \
            k2[2 * w] = lo16(R[3][w]); k2[2 * w + 1] = hi16(R[3][w]);                                 \
        }                                                                                             \
        if (!cc.isctx) {                                                                              \
            const float pos = (float)(cc.t0 + fr);                                                    \
            _Pragma("unroll") for (int ii = 0; ii < 8; ++ii) {                                        \
                float rev = pos * invr[ii];                                                           \
                rev -= floorf(rev);                                                                   \
                const float cs = __builtin_amdgcn_cosf(rev), sn = __builtin_amdgcn_sinf(rev);         \
                const float a1 = q1[ii], a2 = q2[ii];                                                 \
                q1[ii] = a1 * cs - a2 * sn;                                                           \
                q2[ii] = a1 * sn + a2 * cs;                                                           \
                const float b1 = k1[ii], b2 = k2[ii];                                                 \
                k1[ii] = b1 * cs - b2 * sn;                                                           \
                k2[ii] = b1 * sn + b2 * cs;                                                           \
            }                                                                                         \
        }                                                                                             \
        u32x4 o1, o2;                                                                                 \
        _Pragma("unroll") for (int w = 0; w < 4; ++w) { o1[w] = cvt_pk(q1[2 * w] * fq, q1[2 * w + 1] * fq); o2[w] = cvt_pk(q2[2 * w] * fq, q2[2 * w + 1] * fq); } \
        *(u32x4*)(Q + fr * LS + 8 * fj) = o1;                                                         \
        *(u32x4*)(Q + fr * LS + 32 + 8 * fj) = o2;                                                    \
        _Pragma("unroll") for (int w = 0; w < 4; ++w) { o1[w] = cvt_pk(k1[2 * w] * fk, k1[2 * w + 1] * fk); o2[w] = cvt_pk(k2[2 * w] * fk, k2[2 * w + 1] * fk); } \
        *(u32x4*)(K + fr * LS + 8 * fj) = o1;                                                         \
        *(u32x4*)(K + fr * LS + 32 + 8 * fj) = o2;                                                    \
        *(u32x4*)(V + fr * LS + 8 * fj) = R[4];                                                       \
        *(u32x4*)(V + fr * LS + 32 + 8 * fj) = R[5];                                                  \
    }
            RET_LOAD(ra, 0)
            RET_LOAD(rb, 1)
            RET_LOAD(rc, 2)
            RET_FILL(ra, 0, 0)
            RET_LOAD(ra, 3)
            LDS_BARRIER();
            for (int ci = 0; ci < 36; ci += 6) {
                RET_FILL(rb, ci + 1, 1)  if (ci + 4 < 36) RET_LOAD(rb, ci + 4)  LDS_BARRIER();
                RET_FILL(rc, ci + 2, 0)  if (ci + 5 < 36) RET_LOAD(rc, ci + 5)  LDS_BARRIER();
                RET_FILL(ra, ci + 3, 1)  if (ci + 6 < 36) RET_LOAD(ra, ci + 6)  LDS_BARRIER();
                RET_FILL(rb, ci + 4, 0)  if (ci + 7 < 36) RET_LOAD(rb, ci + 7)  LDS_BARRIER();
                RET_FILL(rc, ci + 5, 1)  if (ci + 8 < 36) RET_LOAD(rc, ci + 8)  LDS_BARRIER();
                if (ci + 6 < 36) RET_FILL(ra, ci + 6, 0)  if (ci + 9 < 36) RET_LOAD(ra, ci + 9)  LDS_BARRIER();
            }
#undef RET_LOAD
#undef RET_FILL
        } else {
            const float g64 = exp2f(lg2 * 64.f);
            bf16_t* OUTB = (bf16_t*)(p.ws + OFF_P + (size_t)(2 + dir) * SZ_T);
            f32x4 S[4];
#pragma unroll
            for (int mt = 0; mt < 4; ++mt) S[mt] = (f32x4){0.f, 0.f, 0.f, 0.f};
            bf16x4 ost[4];
            size_t orow = 0;
            bool ohave = false;
            if (__builtin_amdgcn_readfirstlane(wave) < 4) __builtin_amdgcn_s_setprio(3);
            LDS_BARRIER();
            for (int ci = 0; ci < 36; ++ci) {
                if (ohave) {
#pragma unroll
                    for (int mt = 0; mt < 4; ++mt) *(bf16x4*)(OUTB + (orow + 16 * mt + li) * 256 + h * 64 + 16 * sl + 4 * g) = ost[mt];
                }
                const ChunkInfo c = chunk_info<64>(ci, dir, b);
                const bool need_o = !c.isctx || with_ctx;
                const bf16_t* Q = lds + (ci & 1) * BUFE;
                const bf16_t* K = Q + 64 * LS;
                const bf16_t* V = K + 64 * LS;
                f32x4 o[4];
                if (dir == 0) ret_step<0>(Q, K, V, S, o, sl, g, li, g64, need_o);
                else          ret_step<1>(Q, K, V, S, o, sl, g, li, g64, need_o);
                ohave = need_o;
                if (need_o) {
                    orow = c.rowbase + c.t0;
#pragma unroll
                    for (int mt = 0; mt < 4; ++mt) ost[mt] = pack4(o[mt]);
                }
                LDS_BARRIER();
            }
            if (ohave) {
#pragma unroll
                for (int mt = 0; mt < 4; ++mt) *(bf16x4*)(OUTB + (orow + 16 * mt + li) * 256 + h * 64 + 16 * sl + 4 * g) = ost[mt];
            }
        }
        __builtin_amdgcn_s_setprio(0);
        LDS_BARRIER();
    }
}

template <int DIR>
__device__ __forceinline__ void lru_scan(const float (&av)[4][4], const float (&bv)[4][4], float (&hv)[4][4], float& hc, float& pc, int g, int li) {
#pragma unroll
    for (int mi = 0; mi < 4; ++mi) {
        const int mt = DIR ? 3 - mi : mi;
        const float a0 = av[mt][DIR ? 3 : 0], a1 = av[mt][DIR ? 2 : 1], a2 = av[mt][DIR ? 1 : 2], a3 = av[mt][DIR ? 0 : 3];
        const float b0 = bv[mt][DIR ? 3 : 0], b1 = bv[mt][DIR ? 2 : 1], b2 = bv[mt][DIR ? 1 : 2], b3 = bv[mt][DIR ? 0 : 3];
        const float A4 = a0 * a1 * a2 * a3;
        const float B4 = ((b0 * a1 + b1) * a2 + b2) * a3 + b3;
        float hs = hc, hend = hc, pend = pc;
#pragma unroll
        for (int gi = 0; gi < 4; ++gi) {
            const int gg = DIR ? 3 - gi : gi;
            const float Ag = __shfl(A4, gg * 16 + li), Bg = __shfl(B4, gg * 16 + li);
            hs = (gg == g) ? hend : hs;
            hend = Ag * hend + Bg;
            pend = Ag * pend;
        }
        hc = hend;
        pc = pend;
        const float h0 = a0 * hs + b0, h1 = a1 * h0 + b1, h2 = a2 * h1 + b2, h3 = a3 * h2 + b3;
        hv[mt][DIR ? 3 : 0] = h0;
        hv[mt][DIR ? 2 : 1] = h1;
        hv[mt][DIR ? 1 : 2] = h2;
        hv[mt][DIR ? 0 : 3] = h3;
    }
}

template <int PASS>
__device__ void lru_loop(const Params& p, int l, char* smem, int first, int end, int stride, bool skip_ctx, int oz) {
    constexpr int LS = 72;
    if (first >= end) return;
    bf16_t* ul = (bf16_t*)smem;
    float* pre = (float*)(smem + 64 * LS * 2);
    float* car = pre + 2 * 35 * 64 * 2;
    float* exc = car + 128;
    bf16_t* U = (bf16_t*)(p.ws + OFF_U);
    float* AGG = (float*)(p.ws + OFF_AGG);
    int oz2 = oz;
    asm volatile("" : "+v"(oz2));
    const int tid = threadIdx.x + oz2, lane = tid & 63, wave = tid >> 6;
    const int dir = wave >> 2, nt = wave & 3, g = lane >> 4, li = lane & 15;
    const int c8 = tid & 7, ft = tid >> 3;
    const int n = first & 3;
    const int d = 16 * nt + li, ch = n * 64 + d;
    bf16x8 wf[2][2];
#pragma unroll
    for (int m = 0; m < 2; ++m)
#pragma unroll
        for (int s = 0; s < 2; ++s) {
            const float* W = (m ? p.in[I_LWI] : p.in[I_LWR]) + (size_t)((l * 2 + dir) * 4 + n) * 4096 + d;
            float w[8];
#pragma unroll
            for (int jj = 0; jj < 8; ++jj) w[jj] = W[(32 * s + 8 * g + jj) * 64];
            u32x4 u = {cvt_pk(w[0], w[1]), cvt_pk(w[2], w[3]), cvt_pk(w[4], w[5]), cvt_pk(w[6], w[7])};
            wf[m][s] = __builtin_bit_cast(bf16x8, u);
        }
    const float br = p.in[I_LBR][(l * 2 + dir) * 256 + ch];
    const float bi = p.in[I_LBI][(l * 2 + dir) * 256 + ch];
    const float sp8 = -8.f * softplusf_(-p.in[I_LLAM][(l * 2 + dir) * 256 + ch]);
    float cbv[8], cwv[4][8];
#pragma unroll
    for (int e = 0; e < 8; ++e) {
        cbv[e] = p.in[I_LCB][l * 256 + n * 64 + 8 * c8 + e];
#pragma unroll
        for (int j = 0; j < 4; ++j) cwv[j][e] = p.in[I_LCW][(l * 4 + j) * 256 + n * 64 + 8 * c8 + e];
    }
    u32x4 nrx[4], nzv = {0u, 0u, 0u, 0u};
#define LRU_ITEM_OF(idx_) (skip_ctx ? ((idx_) >> 7) * 144 + 16 + ((idx_) & 127) : (idx_))
#define LRU_LOAD(idx_)                                                                                      \
    {                                                                                                       \
        const int it_ = LRU_ITEM_OF(idx_);                                                                  \
        const int b_ = it_ / 144, cid_ = (it_ >> 2) % 36;                                                   \
        const bool ic_ = cid_ < 4;                                                                          \
        const int t0_ = (ic_ ? cid_ : cid_ - 4) * 64, Ts_ = ic_ ? LC : T;                                   \
        const size_t rb_ = ic_ ? (size_t)LAT + (size_t)b_ * LC : (size_t)b_ * T;                            \
        _Pragma("unroll") for (int j = 0; j < 4; ++j) {                                                     \
            int tt = t0_ + ft + j - 2;                                                                      \
            tt = tt < 0 ? 0 : (tt > Ts_ - 1 ? Ts_ - 1 : tt);                                                \
            nrx[j] = *(const u32x4*)(U + (rb_ + tt) * INW + C_LRUX + n * 64 + 8 * c8);                      \
        }                                                                                                   \
        if (PASS == 1) nzv = *(const u32x4*)(U + (rb_ + t0_ + ft) * INW + C_LRUZ + n * 64 + 8 * c8);        \
    }
    LRU_LOAD(first)
  for (int idx = first; idx < end; idx += stride) {
    const int item = LRU_ITEM_OF(idx);
    const int b = item / 144, cid = (item >> 2) % 36;
    const bool isctx = cid < 4;
    const int t0 = (isctx ? cid : cid - 4) * 64, Tseg = isctx ? LC : T;
    const size_t rowbase = isctx ? (size_t)LAT + (size_t)b * LC : (size_t)b * T;
    u32x4 rx[4];
#pragma unroll
    for (int j = 0; j < 4; ++j) rx[j] = nrx[j];
    const u32x4 zv = nzv;
    const int posf = cid, posb = isctx ? 3 - cid : 39 - cid;
    f32x4 pr[5];
    if (PASS == 1) {
#pragma unroll
        for (int k = 0; k < 5; ++k) {
            const int pidx = tid + 512 * k;
            const int dd = pidx / (35 * 32), rem = pidx % (35 * 32), q = rem >> 5, pc16 = rem & 31;
            const bool need = (dd < 2) && (q < (dd ? posb : posf));
            const int j = dd ? (q < 4 ? 3 - q : 39 - q) : q;
            pr[k] = (f32x4){1.f, 0.f, 1.f, 0.f};
            if (need) pr[k] = *(const f32x4*)(AGG + ((size_t)((b * 2 + dd) * 36 + j) * 256 + n * 64) * 2 + pc16 * 4);
        }
    }
    if (idx + stride < end) LRU_LOAD(idx + stride)
    __syncthreads();
    {
        float acc[8];
#pragma unroll
        for (int e = 0; e < 8; ++e) acc[e] = cbv[e];
#pragma unroll
        for (int j = 0; j < 4; ++j) {
            const int tt = t0 + ft + j - 2;
            const bool ok = (tt >= 0) && (tt < Tseg);
#pragma unroll
            for (int w = 0; w < 4; ++w) {
                const unsigned xw = ok ? rx[j][w] : 0u;
                acc[2 * w] += cwv[j][2 * w] * lo16(xw);
                acc[2 * w + 1] += cwv[j][2 * w + 1] * hi16(xw);
            }
        }
        u32x4 o = {cvt_pk(acc[0], acc[1]), cvt_pk(acc[2], acc[3]), cvt_pk(acc[4], acc[5]), cvt_pk(acc[6], acc[7])};
        *(u32x4*)(ul + ft * LS + 8 * c8) = o;
    }
    if (PASS == 1) {
#pragma unroll
        for (int k = 0; k < 5; ++k) {
            const int pidx = tid + 512 * k;
            if (pidx < 2 * 35 * 32) *(f32x4*)(pre + pidx * 4) = pr[k];
        }
    }
    __syncthreads();
    if (PASS == 1 && tid < 128) {
        const int dd = tid >> 6, cc = tid & 63, np = dd ? posb : posf;
        float h = 0.f;
        for (int q = 0; q < np; ++q) {
            const f32x2 ah = *(const f32x2*)(pre + ((dd * 35 + q) * 64 + cc) * 2);
            h = ah[0] * h + ah[1];
        }
        car[tid] = h;
    }
    float av[4][4], bv[4][4], hv[4][4];
#pragma unroll
    for (int mt = 0; mt < 4; ++mt) {
        f32x4 racc = {0.f, 0.f, 0.f, 0.f}, iacc = {0.f, 0.f, 0.f, 0.f};
#pragma unroll
        for (int s = 0; s < 2; ++s) {
            const bf16x8 a = *(const bf16x8*)(ul + (16 * mt + li) * LS + 32 * s + 8 * g);
            racc = MFMA32(a, wf[0][s], racc);
            iacc = MFMA32(a, wf[1][s], iacc);
        }
#pragma unroll
        for (int r = 0; r < 4; ++r) {
            const float uval = bf2f(ul[(16 * mt + 4 * g + r) * LS + d]);
            const float rg = sigmoidf_(racc[r] + br), ig = sigmoidf_(iacc[r] + bi);
            const float a = fexp(sp8 * rg);
            av[mt][r] = a;
            bv[mt][r] = __builtin_amdgcn_sqrtf(fmaxf(0.f, 1.f - a * a)) * ig * uval;
        }
    }
    if (PASS == 0) {
        float hc = 0.f, pc = 1.f;
        if (dir == 0) lru_scan<0>(av, bv, hv, hc, pc, g, li);
        else          lru_scan<1>(av, bv, hv, hc, pc, g, li);
        if (g == 0) *(f32x2*)(AGG + ((size_t)((b * 2 + dir) * 36 + cid) * 256 + ch) * 2) = (f32x2){pc, hc};
    } else {
        __syncthreads();
        float hc = car[dir * 64 + d], pc = 1.f;
        if (dir == 0) lru_scan<0>(av, bv, hv, hc, pc, g, li);
        else          lru_scan<1>(av, bv, hv, hc, pc, g, li);
#pragma unroll
        for (int mt = 0; mt < 4; ++mt)
#pragma unroll
            for (int r = 0; r < 4; ++r) exc[dir * 4096 + (16 * mt + 4 * g + r) * 64 + d] = hv[mt][r];
        __syncthreads();
        const float* ef = exc + ft * 64 + 8 * c8;
        const f32x4 f0 = *(const f32x4*)ef, f1 = *(const f32x4*)(ef + 4), b0 = *(const f32x4*)(ef + 4096), b1 = *(const f32x4*)(ef + 4100);
        u32x4 y;
        y[0] = cvt_pk((f0[0] + b0[0]) * siluf_(lo16(zv[0])), (f0[1] + b0[1]) * siluf_(hi16(zv[0])));
        y[1] = cvt_pk((f0[2] + b0[2]) * siluf_(lo16(zv[1])), (f0[3] + b0[3]) * siluf_(hi16(zv[1])));
        y[2] = cvt_pk((f1[0] + b1[0]) * siluf_(lo16(zv[2])), (f1[1] + b1[1]) * siluf_(hi16(zv[2])));
        y[3] = cvt_pk((f1[2] + b1[2]) * siluf_(lo16(zv[3])), (f1[3] + b1[3]) * siluf_(hi16(zv[3])));
        *(u32x4*)(U + (rowbase + t0 + ft) * INW + C_LRUZ + n * 64 + 8 * c8) = y;
    }
  }
#undef LRU_LOAD
#undef LRU_ITEM_OF
}

template <int DIR>
__device__ __forceinline__ void gdn_prep_wave(const bf16_t* qs, const bf16_t* ks, const bf16_t* vs, const float* beta, const float* G,
                                              int half, int g, int li, int lane, bf16_t* gwd, bf16_t* guv, bf16_t* gatt) {
    constexpr int LS = 72;
    float bcol[4], Gcol[4];
    f32x4 Grow[4], brow[4];
#pragma unroll
    for (int i = 0; i < 4; ++i) {
        bcol[i] = beta[16 * i + li];
        Gcol[i] = G[16 * i + li];
        Grow[i] = *(const f32x4*)(G + 16 * i + 4 * g);
        brow[i] = *(const f32x4*)(beta + 16 * i + 4 * g);
    }
    bf16x4 LtF[4][4];
    f32x4 Ntile[4], NtT[4];
#pragma unroll
    for (int ib = 0; ib < 4; ++ib)
#pragma unroll
        for (int kb = 0; kb < 4; ++kb) {
            const bool needed = DIR ? (kb >= ib) : (kb <= ib);
            if (needed) {
                f32x4 t = {0.f, 0.f, 0.f, 0.f};
#pragma unroll
                for (int s2 = 0; s2 < 2; ++s2) {
                    const bf16x8 a = *(const bf16x8*)(ks + (16 * kb + li) * LS + 32 * s2 + 8 * g);
                    const bf16x8 bb = *(const bf16x8*)(ks + (16 * ib + li) * LS + 32 * s2 + 8 * g);
                    t = MFMA32(a, bb, t);
                }
                f32x4 lt;
#pragma unroll
                for (int r = 0; r < 4; ++r) lt[r] = -(bcol[ib] * t[r] * fexp(Gcol[ib] - Grow[kb][r]));
                if (kb == ib) {
                    f32x4 nn;
#pragma unroll
                    for (int r = 0; r < 4; ++r) {
                        const bool keepT = DIR ? (4 * g + r > li) : (4 * g + r < li);
                        lt[r] = keepT ? lt[r] : 0.f;
                        const bool keepN = DIR ? (li > 4 * g + r) : (li < 4 * g + r);
                        const float nv = -(brow[ib][r] * t[r] * fexp(Grow[ib][r] - Gcol[ib]));
                        nn[r] = keepN ? nv : 0.f;
                    }
                    NtT[ib] = lt;
                    Ntile[ib] = nn;
                } else {
                    LtF[ib][kb] = pack4(lt);
                }
            }
        }
    bf16x4 DtF[4];
#pragma unroll
    for (int i = 0; i < 4; ++i) {
        f32x4 M = Ntile[i], Mt = NtT[i], P = Ntile[i], Pt = NtT[i];
#pragma unroll
        for (int r = 0; r < 4; ++r) {
            const float one = (4 * g + r == li) ? 1.f : 0.f;
            P[r] += one;
            Pt[r] += one;
        }
#pragma unroll
        for (int k = 0; k < 3; ++k) {
            const bf16x4 fM = pack4(M), fMt = pack4(Mt);
            const f32x4 z = {0.f, 0.f, 0.f, 0.f};
            const f32x4 M2 = MFMA16(fMt, fM, z);
            const f32x4 Mt2 = MFMA16(fM, fMt, z);
            const bf16x4 fPt = pack4(Pt), fM2 = pack4(M2);
            P = MFMA16(fPt, fM2, P);
            Pt = MFMA16(fM2, fPt, Pt);
            M = M2;
            Mt = Mt2;
        }
        DtF[i] = pack4(Pt);
    }
    bf16x4 Xf[4][4];
#pragma unroll
    for (int si = 0; si < 4; ++si) {
        const int i = DIR ? 3 - si : si;
        f32x4 eg;
#pragma unroll
        for (int r = 0; r < 4; ++r) eg[r] = half ? brow[i][r] * fexp(Grow[i][r]) : brow[i][r];
        const bf16_t* src = half ? ks : vs;
#pragma unroll
        for (int ntl = 0; ntl < 4; ++ntl) {
            f32x4 Y;
#pragma unroll
            for (int r = 0; r < 4; ++r) Y[r] = eg[r] * bf2f(src[(16 * i + 4 * g + r) * LS + 16 * ntl + li]);
#pragma unroll
            for (int sk = 0; sk < si; ++sk) {
                const int k = DIR ? 3 - sk : sk;
                Y = MFMA16(LtF[i][k], Xf[k][ntl], Y);
            }
            const f32x4 z = {0.f, 0.f, 0.f, 0.f};
            const f32x4 X = MFMA16(DtF[i], pack4(Y), z);
            Xf[i][ntl] = pack4(X);
            if (half == 0) {
                *(bf16x4*)(guv + ((i * 4 + ntl) * 64 + lane) * 4) = Xf[i][ntl];
            } else {
#pragma unroll
                for (int r = 0; r < 4; ++r) gwd[(16 * i + 4 * g + r) * 64 + 16 * ntl + li] = f2bf(-X[r]);
            }
        }
    }
    for (int cix = 0; cix < 2; ++cix) {
        const int ci = 2 * half + cix;
        const float Gc = G[16 * ci + li];
#pragma unroll
        for (int bi = 0; bi < 4; ++bi) {
            const bool needed = DIR ? (bi >= ci) : (bi <= ci);
            f32x4 v = {0.f, 0.f, 0.f, 0.f};
            if (needed) {
                f32x4 t = {0.f, 0.f, 0.f, 0.f};
#pragma unroll
                for (int s2 = 0; s2 < 2; ++s2) {
                    const bf16x8 a = *(const bf16x8*)(ks + (16 * bi + li) * LS + 32 * s2 + 8 * g);
                    const bf16x8 bb = *(const bf16x8*)(qs + (16 * ci + li) * LS + 32 * s2 + 8 * g);
                    t = MFMA32(a, bb, t);
                }
#pragma unroll
                for (int r = 0; r < 4; ++r) {
                    const float x = t[r] * fexp(Gc - Grow[bi][r]);
                    const bool keep = (bi != ci) || (DIR ? (4 * g + r >= li) : (4 * g + r <= li));
                    v[r] = keep ? x : 0.f;
                }
            }
            *(bf16x4*)(gatt + (16 * ci + li) * 64 + 16 * bi + 4 * g) = pack4(v);
        }
    }
}

__device__ void phase_gdn_prep(const Params& p, int l, char* smem, int vb, int nvb, int pend, int oz) {
    constexpr int LS = 72;
    constexpr int HBYTES = 57984;
    const int hb = (int)((threadIdx.x + oz) >> 8);
    smem += hb * HBYTES;
    bf16_t* raw = (bf16_t*)smem;
    bf16_t* qs = (bf16_t*)(smem + 25728);
    bf16_t* ks = qs + 64 * LS;
    bf16_t* vs = ks + 64 * LS;
    float* cwl = (float*)(smem + 53376);
    float* gl = cwl + 768;
    float* bl = gl + 128;
    float* Gl = bl + 128;
    bf16_t* U = (bf16_t*)(p.ws + OFF_U);
    for (int pair = vb; pair < pend; pair += nvb) {
        int oz2 = oz;
        asm volatile("" : "+v"(oz2));
        const int tid = (threadIdx.x + oz2) & 255, lane = tid & 63, wave = tid >> 6, g = lane >> 4, li = lane & 15;
        const int it = 2 * pair + hb;
        const int b = it / 144, h = (it / 36) & 3, cid = it % 36;
        const bool isctx = cid < 4;
        const int t0 = (isctx ? cid : cid - 4) * 64;
        const int Tseg = isctx ? LC : T;
        const size_t rowbase = isctx ? (size_t)LAT + (size_t)b * LC : (size_t)b * T;
        __syncthreads();
        {
            u32x4 rv[7];
            float cv[3];
#pragma unroll
            for (int k = 0; k < 7; ++k) {
                const int idx = tid + 256 * k;
                const int r = idx / 24, c8 = idx % 24;
                int t = t0 - 2 + r;
                const bool ok = (idx < 67 * 24) && (t >= 0) && (t < Tseg);
                t = ok ? t : t0;
                rv[k] = *(const u32x4*)(U + (rowbase + t) * INW + C_GQ + (c8 >> 3) * 256 + h * 64 + (c8 & 7) * 8);
                if (!ok) rv[k] = (u32x4){0u, 0u, 0u, 0u};
            }
#pragma unroll
            for (int k = 0; k < 3; ++k) {
                const int idx = tid + 256 * k, j = idx / 192, cc = idx % 192;
                cv[k] = p.in[I_GCW][(l * 4 + j) * 768 + (cc >> 6) * 256 + h * 64 + (cc & 63)];
            }
#pragma unroll
            for (int k = 0; k < 7; ++k) {
                const int idx = tid + 256 * k;
                if (idx < 67 * 24) *(u32x4*)(raw + (idx / 24) * 192 + (idx % 24) * 8) = rv[k];
            }
#pragma unroll
            for (int k = 0; k < 3; ++k) cwl[tid + 256 * k] = cv[k];
        }
        if (tid < 128) {
            const int dd = tid >> 6, t = tid & 63;
            const size_t row = rowbase + t0 + t;
            const float alpha = bf2f(U[row * INW + C_GA + dd * 4 + h]);
            const float beta = bf2f(U[row * INW + C_GB + dd * 4 + h]);
            gl[tid] = -fexp(p.in[I_GALOG][(l * 2 + dd) * 4 + h]) * softplusf_(alpha + p.in[I_GDT][(l * 2 + dd) * 4 + h]);
            bl[tid] = sigmoidf_(beta);
        }
        __syncthreads();
        {
            const int t = tid >> 2, qt = tid & 3;
#pragma unroll
            for (int which = 0; which < 3; ++which) {
                float a[16];
#pragma unroll
                for (int i = 0; i < 16; ++i) a[i] = 0.f;
#pragma unroll
                for (int j = 0; j < 4; ++j) {
                    const u32x4 x0 = *(const u32x4*)(raw + (t + j) * 192 + which * 64 + qt * 16);
                    const u32x4 x1 = *(const u32x4*)(raw + (t + j) * 192 + which * 64 + qt * 16 + 8);
                    const float* cwp = cwl + j * 192 + which * 64 + qt * 16;
#pragma unroll
                    for (int w = 0; w < 4; ++w) {
                        a[2 * w] += cwp[2 * w] * lo16(x0[w]);
                        a[2 * w + 1] += cwp[2 * w + 1] * hi16(x0[w]);
                        a[8 + 2 * w] += cwp[8 + 2 * w] * lo16(x1[w]);
                        a[8 + 2 * w + 1] += cwp[8 + 2 * w + 1] * hi16(x1[w]);
                    }
                }
                float ss = 0.f;
#pragma unroll
                for (int i = 0; i < 16; ++i) {
                    a[i] = siluf_(a[i]);
                    ss += a[i] * a[i];
                }
                float sc = 1.f;
                if (which < 2) {
                    ss += __shfl_xor(ss, 1);
                    ss += __shfl_xor(ss, 2);
                    sc = rsqrtf(ss + EPS) * (which == 0 ? 0.125f : 1.f);
                }
                bf16_t* dst = (which == 0 ? qs : which == 1 ? ks : vs) + t * LS + qt * 16;
                u32x4 o0 = {cvt_pk(a[0] * sc, a[1] * sc), cvt_pk(a[2] * sc, a[3] * sc), cvt_pk(a[4] * sc, a[5] * sc), cvt_pk(a[6] * sc, a[7] * sc)};
                u32x4 o1 = {cvt_pk(a[8] * sc, a[9] * sc), cvt_pk(a[10] * sc, a[11] * sc), cvt_pk(a[12] * sc, a[13] * sc), cvt_pk(a[14] * sc, a[15] * sc)};
                *(u32x4*)dst = o0;
                *(u32x4*)(dst + 8) = o1;
            }
        }
        if (wave < 2) {
            float v = gl[wave * 64 + lane];
#pragma unroll
            for (int off = 1; off < 64; off <<= 1) {
                const float nb = wave == 0 ? __shfl_up(v, off) : __shfl_down(v, off);
                const bool ok = wave == 0 ? (lane >= off) : (lane + off < 64);
                v += ok ? nb : 0.f;
            }
            Gl[wave * 64 + lane] = v;
        }
        __syncthreads();
        bf16_t* gq = (bf16_t*)(p.ws + OFF_GQ) + (size_t)it * 4096;
        bf16_t* gkt = (bf16_t*)(p.ws + OFF_GKT) + (size_t)it * 4096;
#pragma unroll
        for (int k = 0; k < 2; ++k) {
            const int pc = tid + 256 * k, row = pc >> 3, c8 = pc & 7;
            *(u32x4*)(gq + row * 64 + 8 * c8) = *(const u32x4*)(qs + row * LS + 8 * c8);
            const int d = pc >> 3, c0 = (pc & 7) * 8;
            float kv[8];
#pragma unroll
            for (int i = 0; i < 8; ++i) kv[i] = bf2f(ks[(c0 + i) * LS + d]);
            u32x4 o = {cvt_pk(kv[0], kv[1]), cvt_pk(kv[2], kv[3]), cvt_pk(kv[4], kv[5]), cvt_pk(kv[6], kv[7])};
            *(u32x4*)(gkt + d * 64 + c0) = o;
        }
        if (tid < 128) {
            const int dd = tid >> 6, t = tid & 63;
            float* vec = (float*)(p.ws + OFF_GVEC) + ((size_t)dd * GI + it) * 256;
            const float Glast = dd ? Gl[64] : Gl[63];
            const float Gt = Gl[dd * 64 + t];
            vec[t] = fexp(Gt);
            vec[64 + t] = fexp(Glast - Gt);
            if (t == 0) vec[128] = fexp(Glast);
        }
        {
            const int dir = wave >> 1, half = wave & 1;
            bf16_t* gwd = (bf16_t*)(p.ws + OFF_GWD) + ((size_t)dir * GI + it) * 4096;
            bf16_t* guv = (bf16_t*)(p.ws + OFF_GUV) + ((size_t)dir * GI + it) * 4096;
            bf16_t* gatt = (bf16_t*)(p.ws + OFF_GATT) + ((size_t)dir * GI + it) * 4096;
            if (dir == 0) gdn_prep_wave<0>(qs, ks, vs, bl, Gl, half, g, li, lane, gwd, guv, gatt);
            else          gdn_prep_wave<1>(qs, ks, vs, bl + 64, Gl + 64, half, g, li, lane, gwd, guv, gatt);
        }
    }
}

__device__ void phase_gdn_chain(const Params& p, int l, char* smem, int vb, int nvb, int oz) {
    constexpr int LS = 72;
    constexpr int TILEB = 64 * LS * 2;
    constexpr int BUFB = 4 * TILEB + 8192 + 528;
    bf16_t* U = (bf16_t*)(p.ws + OFF_U);
    const int tid = threadIdx.x + oz, lane = tid & 63, wave = tid >> 6;
    const int sl = wave & 3, g = lane >> 4, li = lane & 15;
    const bool loader = wave >= 4;
    const int at = tid & 255;
    const bool with_ctx = l < 3;
    for (int it = vb; it < 64; it += nvb) {
        const int b = it >> 3, h = (it >> 1) & 3, dir = it & 1;
#define GDN_GI(ci_) ((b * 4 + h) * 36 + (dir ? ((ci_) < 4 ? 3 - (ci_) : 39 - (ci_)) : (ci_)))
        if (loader) {
            u32x4 ra[5][2], rb[5][2], rc[5][2];
            float va = 0.f, vb_ = 0.f, vc_ = 0.f, ga = 0.f, gb = 0.f, gc = 0.f;
#define GDN_LOAD(R, V, G, ci_)                                                                                   \
    {                                                                                                            \
        const size_t gi = GDN_GI(ci_);                                                                           \
        const bf16_t* tp[5] = {(const bf16_t*)(p.ws + OFF_GWD) + ((size_t)dir * GI + gi) * 4096,                 \
                               (const bf16_t*)(p.ws + OFF_GATT) + ((size_t)dir * GI + gi) * 4096,                \
                               (const bf16_t*)(p.ws + OFF_GKT) + gi * 4096,                                      \
                               (const bf16_t*)(p.ws + OFF_GQ) + gi * 4096,                                       \
                               (const bf16_t*)(p.ws + OFF_GUV) + ((size_t)dir * GI + gi) * 4096};                \
        _Pragma("unroll") for (int tl = 0; tl < 5; ++tl)                                                         \
            _Pragma("unroll") for (int k = 0; k < 2; ++k) R[tl][k] = *(const u32x4*)(tp[tl] + (at + 256 * k) * 8); \
        const float* vp = (const float*)(p.ws + OFF_GVEC) + ((size_t)dir * GI + gi) * 256;                       \
        if (at < 128) V = vp[at];                                                                                \
        if (at == 0) G = vp[128];                                                                                \
    }
#define GDN_FILL(R, V, G, buf_)                                                                                  \
    {                                                                                                            \
        char* bp = smem + (buf_) * BUFB;                                                                         \
        _Pragma("unroll") for (int tl = 0; tl < 4; ++tl)                                                         \
            _Pragma("unroll") for (int k = 0; k < 2; ++k) {                                                      \
                const int pc = at + 256 * k;                                                                     \
                *(u32x4*)(bp + tl * TILEB + ((pc >> 3) * LS + (pc & 7) * 8) * 2) = R[tl][k];                     \
            }                                                                                                    \
        _Pragma("unroll") for (int k = 0; k < 2; ++k) *(u32x4*)(bp + 4 * TILEB + (at + 256 * k) * 16) = R[4][k]; \
        float* vl = (float*)(bp + 4 * TILEB + 8192);                                                             \
        if (at < 128) vl[at] = V;                                                                                \
        if (at == 0) vl[128] = G;                                                                                \
    }
            GDN_LOAD(ra, va, ga, 0)
            GDN_LOAD(rb, vb_, gb, 1)
            GDN_LOAD(rc, vc_, gc, 2)
            GDN_FILL(ra, va, ga, 0)
            GDN_LOAD(ra, va, ga, 3)
            LDS_BARRIER();
            for (int ci = 0; ci < 36; ci += 6) {
                GDN_FILL(rb, vb_, gb, 1)  if (ci + 4 < 36) GDN_LOAD(rb, vb_, gb, ci + 4)  LDS_BARRIER();
                GDN_FILL(rc, vc_, gc, 0)  if (ci + 5 < 36) GDN_LOAD(rc, vc_, gc, ci + 5)  LDS_BARRIER();
                GDN_FILL(ra, va, ga, 1)  if (ci + 6 < 36) GDN_LOAD(ra, va, ga, ci + 6)  LDS_BARRIER();
                GDN_FILL(rb, vb_, gb, 0)  if (ci + 7 < 36) GDN_LOAD(rb, vb_, gb, ci + 7)  LDS_BARRIER();
                GDN_FILL(rc, vc_, gc, 1)  if (ci + 8 < 36) GDN_LOAD(rc, vc_, gc, ci + 8)  LDS_BARRIER();
                if (ci + 6 < 36) GDN_FILL(ra, va, ga, 0)  if (ci + 9 < 36) GDN_LOAD(ra, va, ga, ci + 9)  LDS_BARRIER();
            }
#undef GDN_LOAD
#undef GDN_FILL
        } else {
            f32x4 S[4];
#pragma unroll
            for (int mt = 0; mt < 4; ++mt) S[mt] = (f32x4){0.f, 0.f, 0.f, 0.f};
            bf16x4 ost[4], onew[4];
#pragma unroll
            for (int mt = 0; mt < 4; ++mt) { ost[mt] = (bf16x4){0, 0, 0, 0}; onew[mt] = (bf16x4){0, 0, 0, 0}; }
            size_t orow = 0;
            bool ohave = false;
            if (__builtin_amdgcn_readfirstlane(wave) < 4) __builtin_amdgcn_s_setprio(3);
            LDS_BARRIER();
            for (int ci = 0; ci < 36; ++ci) {
                if (ohave) {
#pragma unroll
                    for (int mt = 0; mt < 4; ++mt)
                        *(bf16x4*)(U + (orow + 16 * mt + li) * INW + C_GQ + dir * 256 + h * 64 + 16 * sl + 4 * g) = ost[mt];
                }
                const ChunkInfo c = chunk_info<64>(ci, dir, b);
                const bool need_o = !c.isctx || with_ctx;
                const char* bp = smem + (ci & 1) * BUFB;
                const bf16_t* WD = (const bf16_t*)bp;
                const bf16_t* AT = WD + 64 * LS;
                const bf16_t* KT = AT + 64 * LS;
                const bf16_t* QQ = KT + 64 * LS;
                const bf16_t* UVl = QQ + 64 * LS;
                const float* eG = (const float*)(bp + 4 * TILEB + 8192);
                const float* eT = eG + 64;
                const float gt = eG[128];
                u32x2 uvw[4];
                bf16x8 wa[4][2], ka[4][2];
                f32x4 e0[2], e1[2];
#pragma unroll
                for (int mt = 0; mt < 4; ++mt) {
                    uvw[mt] = *(const u32x2*)(UVl + ((mt * 4 + sl) * 64 + lane) * 4);
#pragma unroll
                    for (int s = 0; s < 2; ++s) {
                        wa[mt][s] = cat8(*(const bf16x4*)(WD + (16 * mt + li) * LS + 32 * s + 4 * g), *(const bf16x4*)(WD + (16 * mt + li) * LS + 32 * s + 16 + 4 * g));
                    }
                }
#pragma unroll
                for (int s = 0; s < 2; ++s) { e0[s] = *(const f32x4*)(eT + 32 * s + 4 * g); e1[s] = *(const f32x4*)(eT + 32 * s + 16 + 4 * g); }
                bf16x8 sf[2];
#pragma unroll
                for (int s = 0; s < 2; ++s) sf[s] = pack8(S[2 * s], S[2 * s + 1]);
                __builtin_amdgcn_sched_barrier(0);
                f32x4 vn[4];
#pragma unroll
                for (int mt = 0; mt < 4; ++mt) {
                    vn[mt] = (f32x4){lo16(uvw[mt][0]), hi16(uvw[mt][0]), lo16(uvw[mt][1]), hi16(uvw[mt][1])};
#pragma unroll
                    for (int s = 0; s < 2; ++s) vn[mt] = MFMA32(wa[mt][s], sf[s], vn[mt]);
                }
#pragma unroll
                for (int mt = 0; mt < 4; ++mt)
#pragma unroll
                    for (int s = 0; s < 2; ++s)
                        ka[mt][s] = cat8(*(const bf16x4*)(KT + (16 * mt + li) * LS + 32 * s + 4 * g), *(const bf16x4*)(KT + (16 * mt + li) * LS + 32 * s + 16 + 4 * g));
                bf16x8 qa[4][2], aa[4][2];
                float eGc[4];
                if (need_o) {
#pragma unroll
                    for (int mt = 0; mt < 4; ++mt) {
                        eGc[mt] = eG[16 * mt + li];
#pragma unroll
                        for (int s = 0; s < 2; ++s) {
                            qa[mt][s] = cat8(*(const bf16x4*)(QQ + (16 * mt + li) * LS + 32 * s + 4 * g), *(const bf16x4*)(QQ + (16 * mt + li) * LS + 32 * s + 16 + 4 * g));
                            aa[mt][s] = cat8(*(const bf16x4*)(AT + (16 * mt + li) * LS + 32 * s + 4 * g), *(const bf16x4*)(AT + (16 * mt + li) * LS + 32 * s + 16 + 4 * g));
                        }
                    }
                }
                __builtin_amdgcn_sched_barrier(0);
                bf16x8 vf[2], vsf[2];
#pragma unroll
                for (int s = 0; s < 2; ++s) {
                    vf[s] = pack8(vn[2 * s], vn[2 * s + 1]);
                    vsf[s] = pack8(vn[2 * s] * e0[s], vn[2 * s + 1] * e1[s]);
                }
#pragma unroll
                for (int mt = 0; mt < 4; ++mt) {
                    f32x4 acc = S[mt] * gt;
#pragma unroll
                    for (int s = 0; s < 2; ++s) acc = MFMA32(ka[mt][s], vsf[s], acc);
                    S[mt] = acc;
                }
                ohave = need_o;
                if (need_o) {
                    orow = c.rowbase + c.t0;
#pragma unroll
                    for (int mt = 0; mt < 4; ++mt) {
                        f32x4 acc = {0.f, 0.f, 0.f, 0.f};
#pragma unroll
                        for (int s = 0; s < 2; ++s) acc = MFMA32(sf[s], qa[mt][s], acc);
                        acc = acc * eGc[mt];
#pragma unroll
                        for (int s = 0; s < 2; ++s) acc = MFMA32(vf[s], aa[mt][s], acc);
                        onew[mt] = pack4(acc);
                    }
                }
                asm volatile("" :: "v"(ost[0]), "v"(ost[1]), "v"(ost[2]), "v"(ost[3]));
#pragma unroll
                for (int mt = 0; mt < 4; ++mt) ost[mt] = onew[mt];
                LDS_BARRIER();
            }
            if (ohave) {
#pragma unroll
                for (int mt = 0; mt < 4; ++mt)
                    *(bf16x4*)(U + (orow + 16 * mt + li) * INW + C_GQ + dir * 256 + h * 64 + 16 * sl + 4 * g) = ost[mt];
            }
        }
#undef GDN_GI
        __builtin_amdgcn_s_setprio(0);
        LDS_BARRIER();
    }
}

__device__ void phase_swa_mfma(const Params& p, int l, char* smem, int vb, int nvb, int pend, int oz) {
    constexpr int LS = 72;
    const int hb = (int)((threadIdx.x + oz) >> 8);
    smem += hb * (2 * 64 * LS * 2);
    bf16_t* Kl = (bf16_t*)smem;
    bf16_t* Vl = Kl + 64 * LS;
    bf16_t* U = (bf16_t*)(p.ws + OFF_U);
    const int tid = (threadIdx.x + oz) & 255, lane = tid & 63, wave = tid >> 6, g = lane >> 4, li = lane & 15;
    const int q4 = li >> 2, p4 = li & 3;
    const int fr = tid >> 2, fj = tid & 3;
    const bool with_ctx = l < 3;
    const int nlat = 8 * 2 * 32, nctx = with_ctx ? 8 * 2 * 4 : 0;
    float invq[8], invk[8];
#pragma unroll
    for (int j = 0; j < 8; ++j) {
        invq[j] = expf(-(float)((8 * g + j) & 15) * (9.210340371976184f / 16.f)) * 0.15915494309189535f;
        invk[j] = expf(-(float)((8 * fj + j) & 15) * (9.210340371976184f / 16.f)) * 0.15915494309189535f;
    }
    for (int pair = vb; pair < pend; pair += nvb) {
        const int it = 2 * pair + hb;
        const bool cq = it >= nlat;
        const int id = cq ? it - nlat : it;
        int qt, kvh, b;
        if (!cq) { qt = id & 31; kvh = (id >> 5) & 1; b = id >> 6; }
        else     { qt = id & 3;  kvh = (id >> 2) & 1; b = id >> 3; }
        const int hq = kvh * 2 + (wave >> 1), qsub = wave & 1;
        const size_t qbase = cq ? (size_t)LAT + (size_t)b * LC : (size_t)b * T;
        bf16x8 qf[2][2];
#pragma unroll
        for (int qt2 = 0; qt2 < 2; ++qt2) {
            const int tq = qt * 64 + 32 * qsub + 16 * qt2 + li;
            const bf16_t* qp = U + (qbase + tq) * INW + C_SQ + hq * 64 + 8 * g;
            const u32x4 r0 = *(const u32x4*)qp, r1 = *(const u32x4*)(qp + 32);
            float x1[8], x2[8];
#pragma unroll
            for (int w = 0; w < 4; ++w) {
                x1[2 * w] = lo16(r0[w]); x1[2 * w + 1] = hi16(r0[w]);
                x2[2 * w] = lo16(r1[w]); x2[2 * w + 1] = hi16(r1[w]);
            }
            if (!cq) {
                const float pos = (g < 2) ? (float)(tq >> 6) : (float)(tq & 63);
#pragma unroll
                for (int j = 0; j < 8; ++j) {
                    float rev = pos * invq[j];
                    rev -= floorf(rev);
                    const float cs = __builtin_amdgcn_cosf(rev), sn = __builtin_amdgcn_sinf(rev);
                    const float a1 = x1[j], a2 = x2[j];
                    x1[j] = a1 * cs - a2 * sn;
                    x2[j] = a1 * sn + a2 * cs;
                }
            }
            u32x4 o1, o2;
#pragma unroll
            for (int w = 0; w < 4; ++w) {
                o1[w] = cvt_pk(x1[2 * w] * 0.125f, x1[2 * w + 1] * 0.125f);
                o2[w] = cvt_pk(x2[2 * w] * 0.125f, x2[2 * w + 1] * 0.125f);
            }
            qf[qt2][0] = __builtin_bit_cast(bf16x8, o1);
            qf[qt2][1] = __builtin_bit_cast(bf16x8, o2);
        }
        float m[2] = {-1e30f, -1e30f}, lsum[2] = {0.f, 0.f};
        f32x4 O[4][2];
#pragma unroll
        for (int dt = 0; dt < 4; ++dt)
#pragma unroll
            for (int qt2 = 0; qt2 < 2; ++qt2) O[dt][qt2] = (f32x4){0.f, 0.f, 0.f, 0.f};
        const int nloc = cq ? 0 : 5;
        u32x4 pk0, pk1, pv0, pv1;
#define SWA_TILE(ti_, kctx_, ktile_, oob_)                                                      \
        const bool kctx_ = (ti_) >= nloc;                                                       \
        int ktile_ = kctx_ ? (ti_) - nloc : qt + (((ti_) == 0) ? 0 : ((ti_) == 1) ? -1 : ((ti_) == 2) ? 1 : ((ti_) == 3) ? -2 : 2); \
        const bool oob_ = !kctx_ && (ktile_ < 0 || ktile_ >= 32);                               \
        ktile_ = oob_ ? qt : ktile_;
#define SWA_PREFETCH(ti_)                                                                       \
        {                                                                                       \
            SWA_TILE((ti_), kc_, kt_, ob_)                                                      \
            const int tk_ = kt_ * 64 + fr;                                                      \
            const size_t krow_ = kc_ ? (size_t)LAT + (size_t)b * LC + tk_ : (size_t)b * T + tk_; \
            const bf16_t* kp_ = U + krow_ * INW + C_SK + kvh * 64 + 8 * fj;                     \
            const bf16_t* vp_ = U + krow_ * INW + C_SV + kvh * 64 + 8 * fj;                     \
            pk0 = *(const u32x4*)kp_; pk1 = *(const u32x4*)(kp_ + 32);                          \
            pv0 = *(const u32x4*)vp_; pv1 = *(const u32x4*)(vp_ + 32);                          \
        }
        SWA_PREFETCH(0)
        for (int ti = 0; ti < nloc + 4; ++ti) {
            SWA_TILE(ti, kctx, ktile, oob)
            const bool edge = !kctx && (ti >= 3 || oob);
            __syncthreads();
            {
                const int tk = ktile * 64 + fr;
                const u32x4 k0 = pk0, k1 = pk1, v0 = pv0, v1 = pv1;
                u32x4 o1 = k0, o2 = k1;
                if (!kctx) {
                    const float pos = (fj < 2) ? (float)(tk >> 6) : (float)(tk & 63);
                    float x1[8], x2[8];
#pragma unroll
                    for (int w = 0; w < 4; ++w) {
                        x1[2 * w] = lo16(k0[w]); x1[2 * w + 1] = hi16(k0[w]);
                        x2[2 * w] = lo16(k1[w]); x2[2 * w + 1] = hi16(k1[w]);
                    }
#pragma unroll
                    for (int j = 0; j < 8; ++j) {
                        float rev = pos * invk[j];
                        rev -= floorf(rev);
                        const float cs = __builtin_amdgcn_cosf(rev), sn = __builtin_amdgcn_sinf(rev);
                        const float a1 = x1[j], a2 = x2[j];
                        x1[j] = a1 * cs - a2 * sn;
                        x2[j] = a1 * sn + a2 * cs;
                    }
#pragma unroll
                    for (int w = 0; w < 4; ++w) {
                        o1[w] = cvt_pk(x1[2 * w], x1[2 * w + 1]);
                        o2[w] = cvt_pk(x2[2 * w], x2[2 * w + 1]);
                    }
                }
                *(u32x4*)(Kl + fr * LS + 8 * fj) = o1;
                *(u32x4*)(Kl + fr * LS + 32 + 8 * fj) = o2;
                *(u32x4*)(Vl + fr * LS + 8 * fj) = v0;
                *(u32x4*)(Vl + fr * LS + 32 + 8 * fj) = v1;
            }
            __syncthreads();
            if (ti + 1 < nloc + 4) SWA_PREFETCH(ti + 1)
            f32x4 st[4][2];
#pragma unroll
            for (int km = 0; km < 4; ++km) {
                bf16x8 ka[2];
#pragma unroll
                for (int ks = 0; ks < 2; ++ks) ka[ks] = *(const bf16x8*)(Kl + (16 * km + li) * LS + 32 * ks + 8 * g);
#pragma unroll
                for (int qt2 = 0; qt2 < 2; ++qt2) {
                    f32x4 acc = {0.f, 0.f, 0.f, 0.f};
#pragma unroll
                    for (int ks = 0; ks < 2; ++ks) acc = MFMA32(ka[ks], qf[qt2][ks], acc);
                    st[km][qt2] = acc;
                }
            }
            if (edge) {
#pragma unroll
                for (int qt2 = 0; qt2 < 2; ++qt2) {
                    const int tq = qt * 64 + 32 * qsub + 16 * qt2 + li;
#pragma unroll
                    for (int km = 0; km < 4; ++km)
#pragma unroll
                        for (int r = 0; r < 4; ++r) {
                            int dlt = ktile * 64 + 16 * km + 4 * g + r - tq;
                            dlt = dlt < 0 ? -dlt : dlt;
                            st[km][qt2][r] = (dlt <= 128 && !oob) ? st[km][qt2][r] : -1e30f;
                        }
                }
            }
            bf16x8 pf[2][2];
#pragma unroll
            for (int qt2 = 0; qt2 < 2; ++qt2) {
                float mx = st[0][qt2][0];
#pragma unroll
                for (int km = 0; km < 4; ++km)
#pragma unroll
                    for (int r = 0; r < 4; ++r) mx = fmaxf(mx, st[km][qt2][r]);
                mx = fmaxf(mx, __shfl_xor(mx, 16));
                mx = fmaxf(mx, __shfl_xor(mx, 32));
                const float mn = fmaxf(m[qt2], mx);
                const float sc = fexp(m[qt2] - mn);
                m[qt2] = mn;
                float ps = 0.f;
#pragma unroll
                for (int km = 0; km < 4; ++km)
#pragma unroll
                    for (int r = 0; r < 4; ++r) {
                        const float pv = fexp(st[km][qt2][r] - mn);
                        st[km][qt2][r] = pv;
                        ps += pv;
                    }
                lsum[qt2] = lsum[qt2] * sc + ps;
#pragma unroll
                for (int dt = 0; dt < 4; ++dt) O[dt][qt2] = O[dt][qt2] * sc;
                pf[qt2][0] = pack8(st[0][qt2], st[1][qt2]);
                pf[qt2][1] = pack8(st[2][qt2], st[3][qt2]);
            }
#pragma unroll
            for (int dt = 0; dt < 4; ++dt)
#pragma unroll
                for (int ks = 0; ks < 2; ++ks) {
                    const bf16x8 va = cat8(lds_tr(Vl + (32 * ks + 4 * g + q4) * LS + 16 * dt + 4 * p4),
                                           lds_tr(Vl + (32 * ks + 16 + 4 * g + q4) * LS + 16 * dt + 4 * p4));
#pragma unroll
                    for (int qt2 = 0; qt2 < 2; ++qt2) O[dt][qt2] = MFMA32(va, pf[qt2][ks], O[dt][qt2]);
                }
        }
#undef SWA_TILE
#undef SWA_PREFETCH
        const float snk = p.in[I_SINK][l * 4 + hq];
#pragma unroll
        for (int qt2 = 0; qt2 < 2; ++qt2) {
            float ls = lsum[qt2];
            ls += __shfl_xor(ls, 16);
            ls += __shfl_xor(ls, 32);
            const float mn = fmaxf(m[qt2], snk);
            const float s1 = fexp(m[qt2] - mn);
            const float inv = s1 / (ls * s1 + fexp(snk - mn));
            const int tq = qt * 64 + 32 * qsub + 16 * qt2 + li;
            bf16_t* zp = U + (qbase + tq) * INW + C_SZ + hq * 64 + 4 * g;
#pragma unroll
            for (int dt = 0; dt < 4; ++dt) {
                const u32x2 zv = *(const u32x2*)(zp + 16 * dt);
                u32x2 yv;
                yv[0] = cvt_pk(O[dt][qt2][0] * inv * siluf_(lo16(zv[0])), O[dt][qt2][1] * inv * siluf_(hi16(zv[0])));
                yv[1] = cvt_pk(O[dt][qt2][2] * inv * siluf_(lo16(zv[1])), O[dt][qt2][3] * inv * siluf_(hi16(zv[1])));
                *(u32x2*)(zp + 16 * dt) = yv;
            }
        }
    }
}


__device__ void phase_finish(const Params& p, int l, char* smem, int vb, int nvb, int oz) {
    bf16_t* U = (bf16_t*)(p.ws + OFF_U);
    const bf16_t* PF = (const bf16_t*)(p.ws + OFF_P);
    const int tid = threadIdx.x + oz, lane = tid & 63, wave = tid >> 6;
    const int nrows = (l < 3) ? NROW : LAT;
    const int per = (nrows + nvb * 8 - 1) / (nvb * 8);
    const int rbeg = (vb * 8 + wave) * per, rend = (rbeg + per < nrows) ? rbeg + per : nrows;
    if (rbeg >= nrows) return;
    const float4 ng = *(const float4*)(p.in[I_GNG] + l * 64 + (lane & 15) * 4);
    u32x2 nl[6];
#define F_LOAD(row_)                                                               \
    {                                                                              \
        const size_t r_ = (size_t)(row_);                                          \
        const bf16_t* ur_ = U + r_ * INW;                                          \
        nl[0] = *(const u32x2*)(PF + SZ_T + r_ * 256 + lane * 4);                  \
        nl[1] = *(const u32x2*)(PF + SZ_T / 2 * 3 + r_ * 256 + lane * 4);          \
        nl[2] = *(const u32x2*)(ur_ + C_GQ + lane * 4);                            \
        nl[3] = *(const u32x2*)(ur_ + C_GQ + 256 + lane * 4);                      \
        nl[4] = *(const u32x2*)(ur_ + C_GZ + lane * 4);                            \
        nl[5] = *(const u32x2*)(ur_ + C_RZ + lane * 4);                            \
    }
    F_LOAD(rbeg)
    for (int row = rbeg; row < rend; ++row) {
        bf16_t* ur = U + (size_t)row * INW;
        const u32x2 rf = nl[0], rb = nl[1], gf = nl[2], gb = nl[3], zg = nl[4], zr = nl[5];
        if (row + 1 < rend) F_LOAD(row + 1)
        {
            const float o0 = lo16(gf[0]) + lo16(gb[0]), o1 = hi16(gf[0]) + hi16(gb[0]);
            const float o2 = lo16(gf[1]) + lo16(gb[1]), o3 = hi16(gf[1]) + hi16(gb[1]);
            float ss = o0 * o0 + o1 * o1 + o2 * o2 + o3 * o3;
            ss += __shfl_xor(ss, 1); ss += __shfl_xor(ss, 2); ss += __shfl_xor(ss, 4); ss += __shfl_xor(ss, 8);
            const float rs = rsqrtf(ss * (1.f / 64.f) + EPS);
            u32x2 y;
            y[0] = cvt_pk(o0 * rs * ng.x * siluf_(lo16(zg[0])), o1 * rs * ng.y * siluf_(hi16(zg[0])));
            y[1] = cvt_pk(o2 * rs * ng.z * siluf_(lo16(zg[1])), o3 * rs * ng.w * siluf_(hi16(zg[1])));
            *(u32x2*)(ur + C_GZ + lane * 4) = y;
        }
        {
            const float o0 = lo16(rf[0]) + lo16(rb[0]), o1 = hi16(rf[0]) + hi16(rb[0]);
            const float o2 = lo16(rf[1]) + lo16(rb[1]), o3 = hi16(rf[1]) + hi16(rb[1]);
            float s1 = o0 + o1 + o2 + o3;
            s1 += __shfl_xor(s1, 1); s1 += __shfl_xor(s1, 2); s1 += __shfl_xor(s1, 4); s1 += __shfl_xor(s1, 8);
            const float mu = s1 * (1.f / 64.f);
            const float d0 = o0 - mu, d1 = o1 - mu, d2 = o2 - mu, d3 = o3 - mu;
            float s2 = d0 * d0 + d1 * d1 + d2 * d2 + d3 * d3;
            s2 += __shfl_xor(s2, 1); s2 += __shfl_xor(s2, 2); s2 += __shfl_xor(s2, 4); s2 += __shfl_xor(s2, 8);
            const float rs = rsqrtf(s2 * (1.f / 64.f) + EPS);
            u32x2 y;
            y[0] = cvt_pk(d0 * rs * siluf_(lo16(zr[0])), d1 * rs * siluf_(hi16(zr[0])));
            y[1] = cvt_pk(d2 * rs * siluf_(lo16(zr[1])), d3 * rs * siluf_(hi16(zr[1])));
            *(u32x2*)(ur + C_RZ + lane * 4) = y;
        }
    }
#undef F_LOAD
}

#include <hip/hip_cooperative_groups.h>
namespace cg = cooperative_groups;


#define XB_TMO      128
#define XB_XCNT(j)  (256  + 64 * (j))
#define XB_XSUB(j)  (1280 + 64 * (j))
#define XB_XGEN(j)  (2304 + 64 * (j))
#define XB_TOP      3328
#define XB_TOPGEN   3392
#define XCD_BAR_WORDS 3456
#define XB_SPIN_CAP (1u << 18)
#define XB_LAS __attribute__((address_space(3)))
constexpr size_t OFF_BAR = 450560;
static_assert(OFF_BAR + XCD_BAR_WORDS * 4 <= OFF_WINT && OFF_BAR >= 4 * 9 * 3072 * 4, "barrier words placement");
__device__ __forceinline__ unsigned xb_ld(unsigned* p)              { return __hip_atomic_load(p, __ATOMIC_RELAXED, __HIP_MEMORY_SCOPE_AGENT); }
__device__ __forceinline__ unsigned xb_add(unsigned* p, unsigned v) { return __hip_atomic_fetch_add(p, v, __ATOMIC_RELAXED, __HIP_MEMORY_SCOPE_AGENT); }
__device__ __forceinline__ unsigned xb_xcc_id() { return (unsigned)__builtin_amdgcn_s_getreg((3 << 11) | 20) & 0xFu; }
#define XB_SPIN(cond, bar) do { unsigned _sp = 0; while (cond) { __builtin_amdgcn_s_sleep(1); \
    if ((++_sp & 255u) == 0u) { if (xb_ld(&(bar)[XB_TMO])) break; if (_sp > XB_SPIN_CAP) { atomicAdd(&(bar)[XB_TMO], 1u); break; } } } } while (0)
struct XcdBarrier { unsigned* bar; unsigned x; volatile XB_LAS unsigned* st; };
__device__ __forceinline__ XcdBarrier xcd_barrier_post(unsigned* bar, volatile XB_LAS unsigned* st) {
    XcdBarrier b; b.bar = bar; b.x = xb_xcc_id(); b.st = st;
    if (threadIdx.x == 0) (void)xb_add(&bar[XB_XCNT(b.x)], 1u);
    return b;
}
__device__ __forceinline__ void xcd_barrier_complete(unsigned* bar, unsigned x, unsigned& nloc, unsigned& nx) {
    const unsigned G = gridDim.x * gridDim.y * gridDim.z;
    unsigned sum, cnt, mine, sp = 0u;
    for (;;) {
        sum = 0u; cnt = 0u; mine = 0u;
#pragma unroll
        for (unsigned j = 0; j < 16; ++j) { const unsigned c = xb_ld(&bar[XB_XCNT(j)]); sum += c; cnt += (c > 0u) ? 1u : 0u; mine = (j == x) ? c : mine; }
        if (sum == G) break;
        __builtin_amdgcn_s_sleep(1);
        if ((++sp & 255u) == 0u) { if (xb_ld(&bar[XB_TMO])) break; if (sp > XB_SPIN_CAP) { atomicAdd(&bar[XB_TMO], 1u); break; } }
    }
    nloc = mine > 0u ? mine : 1u; nx = cnt > 0u ? cnt : 1u;
}
__device__ __forceinline__ void xcd_barrier(const XcdBarrier& b) {
    asm volatile("s_waitcnt vmcnt(0)" ::: "memory");
    __syncthreads();
    if (threadIdx.x == 0) {
        unsigned* bar = b.bar;
        __builtin_amdgcn_s_waitcnt(0);
        unsigned nloc = b.st[0], nx = b.st[1];
        if (nloc == 0u) { xcd_barrier_complete(bar, b.x, nloc, nx); b.st[0] = nloc; b.st[1] = nx; }
        const unsigned old = xb_add(&bar[XB_XSUB(b.x)], 1u);
        const unsigned gen = old / nloc;
        if (old + 1u == (gen + 1u) * nloc) {
            __builtin_amdgcn_fence(__ATOMIC_RELEASE, "agent");
            asm volatile("s_waitcnt vmcnt(0)" ::: "memory");
            const unsigned og = xb_add(&bar[XB_TOP], 1u);
            const unsigned tg = og / nx;
            if (og + 1u == (tg + 1u) * nx) xb_add(&bar[XB_TOPGEN], 1u);
            else XB_SPIN(xb_ld(&bar[XB_TOPGEN]) == tg, bar);
            __builtin_amdgcn_fence(__ATOMIC_ACQUIRE, "agent");
            xb_add(&bar[XB_XGEN(b.x)], 1u);
            asm volatile("s_waitcnt vmcnt(0)" ::: "memory");
        } else {
            XB_SPIN(xb_ld(&bar[XB_XGEN(b.x)]) == gen, bar);
            __builtin_amdgcn_fence(__ATOMIC_ACQUIRE, "agent");
            asm volatile("s_waitcnt vmcnt(0)" ::: "memory");
        }
    }
    __syncthreads();
}

constexpr int SMEM_BYTES = 128 * 1024 + 16;

__global__ void __launch_bounds__(NT) fwd_megakernel(Params p) {
    extern __shared__ __attribute__((aligned(16))) char smem[];
    cg::grid_group grid = cg::this_grid();
    const int nvb = gridDim.x;
    volatile XB_LAS unsigned* xst = (volatile XB_LAS unsigned*)(smem + 128 * 1024);
    if (threadIdx.x == 0) { xst[0] = 0u; xst[1] = 0u; }
    __syncthreads();
    const XcdBarrier xb = xcd_barrier_post((unsigned*)(p.ws + OFF_BAR), xst);
    phase_prep(p, smem, blockIdx.x, nvb, 0);
    grid.sync();
    for (int l = 0; l < 4; ++l) {
        int oz = 0, vb = blockIdx.x;
        asm volatile("" : "+v"(oz));
        asm volatile("" : "+s"(vb));
        phase_E_rows(p, l, smem, vb, nvb, oz);
        xcd_barrier(xb);
        g8::gemm_phase<false>(p, l, smem, vb, nvb);
        xcd_barrier(xb);
        {
            const int cls = (vb < 32) ? 0 : (vb < 128) ? 1 : 2;
            const int nsw = (l < 3) ? 288 : 256;
            const int s0 = (cls == 0) ? 2 * vb : 64 + (vb - 32), s1 = (cls == 0) ? s0 + 2 : s0 + 1;
            phase_swa_mfma(p, l, smem, s0, 1, (s1 < nsw) ? s1 : nsw, oz);
            __syncthreads();
            const int g0 = (cls == 0) ? vb : (cls == 1) ? 32 + 3 * (vb - 32) : 320 + 2 * (vb - 128);
            const int g1 = g0 + ((cls == 0) ? 1 : (cls == 1) ? 3 : 2);
            phase_gdn_prep(p, l, smem, g0, 1, g1, oz);
            __syncthreads();
            const int n = vb & 3, j = vb >> 2;
            int m0, mc;
            if (j < 8) { m0 = 4 * j; mc = 4; }
            else if (j < 32) { m0 = 32 + 2 * (j - 8); mc = 2; }
            else if (j < 48) { m0 = 80 + 7 * (j - 32); mc = 7; }
            else { m0 = 192 + 6 * (j - 48); mc = 6; }
            lru_loop<0>(p, l, smem, n + 4 * m0, n + 4 * (m0 + mc), 4, false, oz);
        }
        xcd_barrier(xb);
        if (vb < 64) phase_gdn_chain(p, l, smem, vb, 64, oz);
        else if (vb < 128) phase_ret_chain(p, l, smem, vb - 64, 64, oz);
        else {
            lru_loop<1>(p, l, smem, vb - 128, (l < 3) ? 1152 : 1024, nvb - 128, l == 3, oz);
            __syncthreads();
            if (l < 3) for (int id = vb - 128; id < WCONV_TILES; id += nvb - 128) wconv_tile(p, l + 1, id, smem, oz);
        }
        xcd_barrier(xb);
        phase_finish(p, l, smem, vb, nvb, oz);
        xcd_barrier(xb);
        g8::gemm_phase<true>(p, l, smem, vb, nvb);
        xcd_barrier(xb);
    }
    {
        int oz = 0, vb = blockIdx.x;
        asm volatile("" : "+v"(oz));
        asm volatile("" : "+s"(vb));
        phase_E_rows(p, 4, smem, vb, nvb, oz);
    }
}

extern "C" void kernel_launch(void* const* d_in, const int* in_sizes, int n_in, void* d_out, int out_size, void* d_ws,
                              size_t ws_size, hipStream_t stream) {
    static int grid_blocks = 0;
    if (grid_blocks == 0) {
        if (n_in != 23 || ws_size < WS_END) {
            fprintf(stderr, "kernel_launch: unexpected n_in %d or ws_size %zu (< %zu)\n", n_in, ws_size, (size_t)WS_END);
            grid_blocks = -1;
            return;
        }
        int dev = 0, cus = 0, per_cu = 0;
        (void)hipGetDevice(&dev);
        (void)hipDeviceGetAttribute(&cus, hipDeviceAttributeMultiprocessorCount, dev);
        (void)hipFuncSetAttribute((const void*)fwd_megakernel, hipFuncAttributeMaxDynamicSharedMemorySize, SMEM_BYTES);
        (void)hipOccupancyMaxActiveBlocksPerMultiprocessor(&per_cu, fwd_megakernel, NT, SMEM_BYTES);
        if (per_cu < 1) per_cu = 1;
        if (per_cu > 1) per_cu = 1;
        grid_blocks = cus * per_cu;
        fprintf(stderr, "kernel_launch: cus %d per_cu %d grid %d\n", cus, per_cu, grid_blocks);
    }
    if (grid_blocks < 0) return;
    Params p{};
    for (int i = 0; i < 23; ++i) p.in[i] = (const float*)d_in[i];
    p.out = (float*)d_out;
    p.ws = (unsigned char*)d_ws;
    (void)hipMemsetAsync((unsigned char*)d_ws + OFF_BAR, 0, XCD_BAR_WORDS * 4, stream);
    void* args[] = {&p};
    hipError_t e = hipLaunchCooperativeKernel((void*)fwd_megakernel, dim3(grid_blocks), dim3(NT), args, SMEM_BYTES, stream);
    if (e != hipSuccess) fprintf(stderr, "cooperative launch failed: %s (grid %d)\n", hipGetErrorString(e), grid_blocks);
}
```

```cpp
#include <hip/hip_runtime.h>
#include <hip/hip_bf16.h>
#include <cstdio>
#include <cstdint>

typedef unsigned short bf16_t;
typedef __attribute__((ext_vector_type(8))) short bf16x8;
typedef __attribute__((ext_vector_type(4))) float f32x4;
typedef __attribute__((ext_vector_type(4))) short bf16x4;
typedef __attribute__((ext_vector_type(4))) unsigned u32x4;
typedef __attribute__((ext_vector_type(2))) unsigned u32x2;
typedef __attribute__((ext_vector_type(2))) float f32x2;
typedef __attribute__((ext_vector_type(2))) __bf16 bf16v2;

#define NT 512
constexpr int Bsz = 8, T = 2048, LC = 256, DM = 1024, INW = 3344, NPAD = 3584;
constexpr int LAT = Bsz * T, NROW = LAT + Bsz * LC;
constexpr int C_LRUX = 0, C_LRUZ = 256, C_GQ = 512, C_GZ = 1280, C_GA = 1536, C_GB = 1544;
constexpr int C_RQ = 1552, C_RK = 1808, C_RV = 2064, C_RZ = 2320, C_SQ = 2576, C_SK = 2832, C_SV = 2960, C_SZ = 3088;
constexpr float EPS = 1e-6f;

enum { I_X = 0, I_C, I_CTX, I_CCTX, I_WMOD, I_BMOD, I_PREG, I_POSTG, I_WIN, I_WOUT, I_LCW, I_LCB, I_LWR, I_LBR, I_LWI, I_LBI,
       I_LLAM, I_GCW, I_GALOG, I_GDT, I_GNG, I_RDEC, I_SINK };

constexpr int GI = 8 * 4 * 36;
constexpr size_t OFF_MOD = 0;
constexpr size_t OFF_WINT = 1u << 19;
constexpr size_t SZ_WINT = (size_t)NPAD * DM * 2;
constexpr size_t OFF_WOUTT = OFF_WINT + SZ_WINT;
constexpr size_t SZ_WOUTT = (size_t)DM * DM * 2;
constexpr size_t OFF_U = OFF_WOUTT + 2 * SZ_WOUTT;
constexpr size_t SZ_U = (size_t)NROW * INW * 2;
constexpr size_t OFF_P = OFF_U + SZ_U;
constexpr size_t SZ_P = (size_t)NROW * DM * 2;
constexpr size_t OFF_XC = OFF_P + SZ_P;
constexpr size_t SZ_XC = (size_t)Bsz * LC * DM * 4;
constexpr size_t SZ_GT = (size_t)GI * 4096 * 2;
constexpr size_t OFF_GQ = OFF_XC + SZ_XC;
constexpr size_t OFF_GKT = OFF_GQ + SZ_GT;
constexpr size_t OFF_GWD = OFF_GKT + SZ_GT;
constexpr size_t OFF_GUV = OFF_GWD + 2 * SZ_GT;
constexpr size_t OFF_GATT = OFF_GUV + 2 * SZ_GT;
constexpr size_t OFF_GVEC = OFF_GATT + 2 * SZ_GT;
constexpr size_t OFF_AGG = OFF_GVEC + (size_t)2 * GI * 256 * 4;
constexpr size_t WS_END = OFF_AGG + (size_t)8 * 2 * 36 * 256 * 8;
constexpr size_t SZ_T = (size_t)NROW * 256 * 2;
static_assert(4 * SZ_T <= SZ_P, "chain outputs must fit in P");

struct Params {
    const float* in[23];
    float* out;
    unsigned char* ws;
};

__device__ __forceinline__ float bf2f(bf16_t v) { return __uint_as_float(((unsigned)v) << 16); }
__device__ __forceinline__ bf16_t f2bf(float f) {
    unsigned u = __float_as_uint(f);
    u += 0x7fffu + ((u >> 16) & 1u);
    return (bf16_t)(u >> 16);
}
__device__ __forceinline__ float fexp(float x) { return __builtin_amdgcn_exp2f(x * 1.4426950408889634f); }
__device__ __forceinline__ float sigmoidf_(float x) { return __builtin_amdgcn_rcpf(1.f + fexp(-x)); }
__device__ __forceinline__ float siluf_(float x) { return x * __builtin_amdgcn_rcpf(1.f + fexp(-x)); }
__device__ __forceinline__ float softplusf_(float x) { return x > 20.f ? x : log1pf(fexp(x)); }
__device__ __forceinline__ float wave_sum(float v) {
#pragma unroll
    for (int o = 32; o >= 1; o >>= 1) v += __shfl_xor(v, o);
    return v;
}
#define LDS_BARRIER() asm volatile("s_waitcnt lgkmcnt(0)\n\ts_barrier" ::: "memory")
#define MFMA32(a, b, c) __builtin_amdgcn_mfma_f32_16x16x32_bf16((a), (b), (c), 0, 0, 0)
#define MFMA16(a, b, c) __builtin_amdgcn_mfma_f32_16x16x16bf16_1k((a), (b), (c), 0, 0, 0)
__device__ __forceinline__ unsigned cvt_pk(float lo, float hi) {
    const f32x2 v = {lo, hi};
    const bf16v2 b = __builtin_convertvector(v, bf16v2);
    return __builtin_bit_cast(unsigned, b);
}
__device__ __forceinline__ bf16x8 pack8(f32x4 a, f32x4 b) {
    u32x4 u = {cvt_pk(a[0], a[1]), cvt_pk(a[2], a[3]), cvt_pk(b[0], b[1]), cvt_pk(b[2], b[3])};
    return __builtin_bit_cast(bf16x8, u);
}
__device__ __forceinline__ bf16x4 pack4(f32x4 a) {
    u32x2 u = {cvt_pk(a[0], a[1]), cvt_pk(a[2], a[3])};
    return __builtin_bit_cast(bf16x4, u);
}
__device__ __forceinline__ bf16x8 cat8(bf16x4 a, bf16x4 b) { return __builtin_shufflevector(a, b, 0, 1, 2, 3, 4, 5, 6, 7); }
__device__ __forceinline__ bf16x4 lds_tr(const bf16_t* p) {
    return __builtin_amdgcn_ds_read_tr16_b64_v4i16((__attribute__((address_space(3))) bf16x4*)p);
}
__device__ __forceinline__ int permcol(int x) { return (x & ~31) | (((x >> 2) & 3) << 3) | (((x >> 4) & 1) << 2) | (x & 3); }
__device__ __forceinline__ float lo16(unsigned u) { return __uint_as_float(u << 16); }
__device__ __forceinline__ float hi16(unsigned u) { return __uint_as_float(u & 0xffff0000u); }

__device__ void phase_prep_mod(const Params& p, char* smem, int vb, int nvb, int oz) {
    const int tid = threadIdx.x + oz;
    float* mod = (float*)(p.ws + OFF_MOD);
    float* s = (float*)smem;
    float* red = s + 9 * 1024;
    for (int it = vb; it < 192; it += nvb) {
        __syncthreads();
        const int l = it / 48, c = tid & 63, ks = tid >> 6, col = (it % 48) * 64 + c;
        for (int i = tid; i < 9 * 1024; i += NT) {
            const int r = i >> 10, k = i & 1023;
            const float cv = (r < 8) ? p.in[I_C][r * 1024 + k] : p.in[I_CCTX][k];
            s[i] = siluf_(cv);
        }
        __syncthreads();
        float acc[9];
#pragma unroll
        for (int r = 0; r < 9; ++r) acc[r] = 0.f;
        const float* w = p.in[I_WMOD] + (size_t)l * 1024 * 3072 + (size_t)(ks * 128) * 3072 + col;
#pragma unroll 8
        for (int k = 0; k < 128; ++k) {
            const float wv = w[(size_t)k * 3072];
#pragma unroll
            for (int r = 0; r < 9; ++r) acc[r] += s[r * 1024 + ks * 128 + k] * wv;
        }
#pragma unroll
        for (int r = 0; r < 9; ++r) red[(ks * 9 + r) * 64 + c] = acc[r];
        __syncthreads();
        for (int i = tid; i < 9 * 64; i += NT) {
            const int r = i >> 6, cc = i & 63;
            float v = p.in[I_BMOD][l * 3072 + (it % 48) * 64 + cc];
#pragma unroll
            for (int k = 0; k < 8; ++k) v += red[(k * 9 + r) * 64 + cc];
            mod[(l * 9 + r) * 3072 + (it % 48) * 64 + cc] = v;
        }
    }
}

constexpr int WCONV_TILES = 16 * 27 + 16 * 8;
__device__ __forceinline__ void wconv_tile(const Params& p, int l, int id, char* smem, int oz) {
    const int tid = threadIdx.x + oz;
    float* tile = (float*)smem;
    const bool isin = id < 16 * 27;
    if (!isin) id -= 16 * 27;
    const int NN = isin ? INW : DM;
    const int ntn = isin ? 27 : 8;
    const int k0 = (id / ntn) * 64, n0 = (id % ntn) * 128;
    const float* W = (isin ? p.in[I_WIN] : p.in[I_WOUT]) + (size_t)l * 1024 * NN;
    bf16_t* Wt = (bf16_t*)(p.ws + (isin ? OFF_WINT : OFF_WOUTT + (size_t)(l & 1) * SZ_WOUTT));
    float4 v[4];
#pragma unroll
    for (int i = 0; i < 4; ++i) {
        const int pc = tid + 512 * i, r = pc >> 5, c4 = (pc & 31) * 4;
        const int n = n0 + c4;
        v[i] = (n < NN) ? *(const float4*)(W + (size_t)(k0 + r) * NN + n) : make_float4(0.f, 0.f, 0.f, 0.f);
    }
    __syncthreads();
#pragma unroll
    for (int i = 0; i < 4; ++i) {
        const int pc = tid + 512 * i, r = pc >> 5, c4 = (pc & 31) * 4;
        tile[r * 129 + c4] = v[i].x; tile[r * 129 + c4 + 1] = v[i].y; tile[r * 129 + c4 + 2] = v[i].z; tile[r * 129 + c4 + 3] = v[i].w;
    }
    __syncthreads();
    {
        const int nn = tid >> 2, q = tid & 3, n = n0 + nn;
        if (n < NN) {
            u32x4 o0, o1;
#pragma unroll
            for (int w = 0; w < 4; ++w) {
                o0[w] = cvt_pk(tile[(q * 16 + 2 * w) * 129 + nn], tile[(q * 16 + 2 * w + 1) * 129 + nn]);
                o1[w] = cvt_pk(tile[(q * 16 + 8 + 2 * w) * 129 + nn], tile[(q * 16 + 8 + 2 * w + 1) * 129 + nn]);
            }
            *(u32x4*)(Wt + (size_t)n * 1024 + k0 + q * 16) = o0;
            *(u32x4*)(Wt + (size_t)n * 1024 + k0 + q * 16 + 8) = o1;
        }
    }
}

__device__ void phase_prep(const Params& p, char* smem, int vb, int nvb, int oz) {
    if (vb < 192) phase_prep_mod(p, smem, vb, 192, oz);
    else for (int id = vb - 192; id < WCONV_TILES; id += nvb - 192) wconv_tile(p, 0, id, smem, oz);
}

__device__ void phase_E_rows(const Params& p, int l, char* smem, int vb, int nvb, int oz) {
    const int tid = threadIdx.x + oz, lane = tid & 63, wave = tid >> 6;
    const float* mod = (const float*)(p.ws + OFF_MOD);
    bf16_t* P = (bf16_t*)(p.ws + OFF_P);
    float* XC = (float*)(p.ws + OFF_XC);
    const int nrows = (l == 4) ? LAT : NROW;
    const int per = (nrows + nvb * 8 - 1) / (nvb * 8);
    const int rbeg = (vb * 8 + wave) * per, rend = (rbeg + per < nrows) ? rbeg + per : nrows;
    if (rbeg >= nrows) return;
    float4 gp[4], pa[4], sh[4];
    int cur_mr = -1;
    float4 nx[4];
    u32x2 ny[4];
#define E2_LOAD(row_)                                                                              \
    {                                                                                              \
        const int rr_ = (row_);                                                                    \
        const float* src_ = (l == 0) ? ((rr_ >= LAT) ? p.in[I_CTX] + (size_t)(rr_ - LAT) * DM : p.in[I_X] + (size_t)rr_ * DM) \
                                     : ((rr_ >= LAT) ? XC + (size_t)(rr_ - LAT) * DM : p.out + (size_t)rr_ * DM); \
        _Pragma("unroll") for (int k = 0; k < 4; ++k) {                                            \
            nx[k] = *(const float4*)(src_ + k * 256 + lane * 4);                                   \
            if (l > 0) ny[k] = *(const u32x2*)(P + (size_t)rr_ * DM + k * 256 + lane * 4);         \
        }                                                                                          \
    }
    E2_LOAD(rbeg)
    for (int row = rbeg; row < rend; ++row) {
        const bool isctx = row >= LAT;
        const int mr = isctx ? 8 : row / T;
        if (mr != cur_mr) {
            cur_mr = mr;
#pragma unroll
            for (int k = 0; k < 4; ++k) {
                const int col = k * 256 + lane * 4;
                if (l > 0) {
                    const float4 g = *(const float4*)(mod + ((l - 1) * 9 + mr) * 3072 + 2048 + col);
                    const float4 pg = *(const float4*)(p.in[I_POSTG] + (l - 1) * DM + col);
                    gp[k] = make_float4(g.x * pg.x, g.y * pg.y, g.z * pg.z, g.w * pg.w);
                }
                if (l < 4) {
                    const float4 pre = *(const float4*)(p.in[I_PREG] + l * DM + col);
                    const float4 sc = *(const float4*)(mod + (l * 9 + mr) * 3072 + 1024 + col);
                    sh[k] = *(const float4*)(mod + (l * 9 + mr) * 3072 + col);
                    pa[k] = make_float4(pre.x * (1.f + sc.x), pre.y * (1.f + sc.y), pre.z * (1.f + sc.z), pre.w * (1.f + sc.w));
                }
            }
        }
        float* xcur = isctx ? XC + (size_t)(row - LAT) * DM : p.out + (size_t)row * DM;
        float4 xv[4];
        u32x2 yr[4];
#pragma unroll
        for (int k = 0; k < 4; ++k) { xv[k] = nx[k]; yr[k] = ny[k]; }
        if (row + 1 < rend) E2_LOAD(row + 1)
        float y[4][4];
        float ss = 0.f;
#pragma unroll
        for (int k = 0; k < 4; ++k) {
            y[k][0] = lo16(yr[k][0]); y[k][1] = hi16(yr[k][0]); y[k][2] = lo16(yr[k][1]); y[k][3] = hi16(yr[k][1]);
            ss += y[k][0] * y[k][0] + y[k][1] * y[k][1] + y[k][2] * y[k][2] + y[k][3] * y[k][3];
        }
        float rs = 0.f;
        if (l > 0) {
            ss = wave_sum(ss);
            rs = rsqrtf(ss * (1.f / DM) + EPS);
        }
        float ss2 = 0.f;
#pragma unroll
        for (int k = 0; k < 4; ++k) {
            if (l > 0) {
                xv[k].x += gp[k].x * (y[k][0] * rs);
                xv[k].y += gp[k].y * (y[k][1] * rs);
                xv[k].z += gp[k].z * (y[k][2] * rs);
                xv[k].w += gp[k].w * (y[k][3] * rs);
            }
            *(float4*)(xcur + k * 256 + lane * 4) = xv[k];
            ss2 += xv[k].x * xv[k].x + xv[k].y * xv[k].y + xv[k].z * xv[k].z + xv[k].w * xv[k].w;
        }
        if (l < 4) {
            ss2 = wave_sum(ss2);
            const float rs2 = rsqrtf(ss2 * (1.f / DM) + EPS);
#pragma unroll
            for (int k = 0; k < 4; ++k) {
                u32x2 hv;
                hv[0] = cvt_pk(xv[k].x * rs2 * pa[k].x + sh[k].x, xv[k].y * rs2 * pa[k].y + sh[k].y);
                hv[1] = cvt_pk(xv[k].z * rs2 * pa[k].z + sh[k].z, xv[k].w * rs2 * pa[k].w + sh[k].w);
                *(u32x2*)(P + (size_t)row * DM + k * 256 + lane * 4) = hv;
            }
        }
    }
#undef E2_LOAD
}


namespace g8 {
#define G8_LAS __attribute__((address_space(3)))
constexpr int BM = 256, BK = 64, HALF = 128, HTB = HALF * BK * 2, STAGE_BYTES = 8 * HTB, NXCD = 8, WGM = 8;
__device__ __forceinline__ int lds_byte(int r, int c) { const int st = (r >> 4) * 2 + (c >> 5), rr = r & 15, cc = c & 31, ob = rr * 64 + cc * 2; return st * 1024 + (ob ^ (((ob >> 9) & 1) << 5)); }
__device__ __forceinline__ void stage_rc(int b, int& R, int& C) { const int st = b / 1024, sb = b % 1024, swz = sb ^ (((sb >> 9) & 1) << 5); R = (st >> 1) * 16 + swz / 64; C = (st & 1) * 32 + (swz % 64) / 2; }
__device__ __forceinline__ int perm32(int rho) { const int n = rho >> 4, i = rho & 15; return 8 * (i >> 2) + 4 * n + (i & 3); }
struct Unit { int pm, pn; };
struct Order {
    int nM, nN, nwg, G, c;
    __device__ __forceinline__ void init(int M, int N, int G_, int c_) { nM = M / BM; nN = N / BM; nwg = nM * nN; G = G_; c = c_; }
    __device__ __forceinline__ bool next(int i, Unit& u) const {
        const long L = (long)i * G + c; if (L >= nwg) return false;
        int wgid = (int)L; { const int q = nwg / NXCD, r = nwg % NXCD, xcd = wgid % NXCD, off = wgid / NXCD; wgid = (xcd < r ? xcd * (q + 1) : r * (q + 1) + (xcd - r) * q) + off; }
        const int nig = WGM * nN, gid = wgid / nig, fm = gid * WGM, gsz = (nM - fm) < WGM ? (nM - fm) : WGM;
        u.pm = fm + ((wgid % nig) % gsz); u.pn = (wgid % nig) / gsz; return true;
    }
};
template <bool OUTP>
__device__ __forceinline__ size_t colb(int t) {
    if (OUTP) {
        const int gsel = t >> 2;
        const int zoff = (gsel == 0) ? C_LRUZ : (gsel == 1) ? C_GZ : (gsel == 2) ? C_RZ : C_SZ;
        return (size_t)(zoff + (t & 3) * 64) * 2;
    }
    return (size_t)t * (BK * 2);
}
template <bool OUTP>
__device__ __forceinline__ void gemm_phase(const Params& p, int l, char* smem, int vb, int nvb) {
    G8_LAS unsigned char* lds = (G8_LAS unsigned char*)smem;
    const int tid = threadIdx.x, wid = __builtin_amdgcn_readfirstlane(tid >> 6), lane = tid & 63, wr = wid >> 2, wc = wid & 3, fr = lane & 15, fq = lane >> 4;
    constexpr int K = DM, nt = K / BK;
    const int M = OUTP ? ((l == 3) ? LAT : NROW) : NROW;
    const int N = OUTP ? DM : INW;
    const int NP = OUTP ? DM : NPAD;
    const int lda = OUTP ? INW : DM;
    const bf16_t* Aptr = OUTP ? (const bf16_t*)(p.ws + OFF_U) : (const bf16_t*)(p.ws + OFF_P);
    const bf16_t* Bptr = OUTP ? (const bf16_t*)(p.ws + OFF_WOUTT + (size_t)(l & 1) * SZ_WOUTT) : (const bf16_t*)(p.ws + OFF_WINT);
    bf16_t* Cptr = OUTP ? (bf16_t*)(p.ws + OFF_P) : (bf16_t*)(p.ws + OFF_U);
    const int ldc = OUTP ? DM : INW;
    Order S; S.init(M, NP, nvb, vb);
    unsigned voffA[2], voffB[2];
#pragma unroll
    for (int i = 0; i < 2; ++i) { int R, C; stage_rc(tid * 16 + i * 8192, R, C); const int Rb = (R & ~31) + perm32(R & 31);
        voffA[i] = (unsigned)(R * lda + C) * 2u; voffB[i] = (unsigned)(Rb * K + C) * 2u; }
    const size_t kstep = (size_t)(BK * 2);
    const size_t hstepA = (size_t)HALF * lda * 2, hstepB = (size_t)HALF * K * 2;
    const size_t tstepA = 2 * hstepA, tstepB = 2 * hstepB;
    const unsigned ldsw = (unsigned)wid * 1024u;
    const int aoff = lds_byte(wr * 64 + fr, fq * 8), boff = lds_byte(wc * 32 + fr, fq * 8);
#define G8_SA(b, h) (((b) * 2 + (h)) * HTB)
#define G8_SB(b, h) ((4 + (b) * 2 + (h)) * HTB)
#define G8_STAGE(bufoff, gbase, voff) do { _Pragma("unroll") for (int _i = 0; _i < 2; ++_i) \
        __builtin_amdgcn_global_load_lds((const unsigned*)((const char*)(gbase) + (voff)[_i]), (G8_LAS unsigned*)(lds + (bufoff) + ldsw + _i * 8192), 16, 0, 0); } while (0)
#define G8_LDA(dst, b, h) do { _Pragma("unroll") for (int m = 0; m < 4; ++m) _Pragma("unroll") for (int k = 0; k < 2; ++k) dst[m][k] = *(const G8_LAS bf16x8*)(lds + G8_SA(b, h) + aoff + m * 2048 + k * 1024); } while (0)
#define G8_LDB(dst, b, h) do { _Pragma("unroll") for (int n = 0; n < 2; ++n) _Pragma("unroll") for (int k = 0; k < 2; ++k) dst[n][k] = *(const G8_LAS bf16x8*)(lds + G8_SB(b, h) + boff + n * 2048 + k * 1024); } while (0)
#define G8_MMA(ai, bj, At, Bt) do { __builtin_amdgcn_s_setprio(1); _Pragma("unroll") for (int m = 0; m < 4; ++m) _Pragma("unroll") for (int n = 0; n < 2; ++n) _Pragma("unroll") for (int k = 0; k < 2; ++k) \
        acc[ai][bj][m][n] = __builtin_amdgcn_mfma_f32_16x16x32_bf16(Bt[n][k], At[m][k], acc[ai][bj][m][n], 0, 0, 0); __builtin_amdgcn_s_setprio(0); } while (0)
#define G8_WAIT_V(n) asm volatile("s_waitcnt vmcnt(" #n ")" ::: "memory")
#define G8_WAIT_L(n) asm volatile("s_waitcnt lgkmcnt(" #n ")" ::: "memory")
#define G8_BAR __builtin_amdgcn_s_barrier()
#define G8_SCHED __builtin_amdgcn_sched_barrier(0)
    Unit cur, nxt; int ui = 0;
    if (!S.next(0, cur)) return;
    f32x4 acc[2][2][4][2];
#pragma unroll
    for (int a = 0; a < 2; ++a)
#pragma unroll
        for (int b = 0; b < 2; ++b)
#pragma unroll
            for (int m = 0; m < 4; ++m)
#pragma unroll
                for (int n = 0; n < 2; ++n) acc[a][b][m][n] = (f32x4){0.f, 0.f, 0.f, 0.f};
    bf16x8 At[4][2], B0[2][2], B1[2][2];
    const char* cA = (const char*)Aptr + (size_t)cur.pm * tstepA; const char* cB = (const char*)Bptr + (size_t)cur.pn * tstepB;
    {
        const char* a0 = cA + colb<OUTP>(0);
        G8_STAGE(G8_SB(0, 0), cB, voffB); G8_STAGE(G8_SA(0, 0), a0, voffA); G8_STAGE(G8_SB(0, 1), cB + hstepB, voffB); G8_STAGE(G8_SA(0, 1), a0 + hstepA, voffA);
        if (wr == 1) G8_BAR;
        G8_WAIT_V(4); G8_BAR;
        G8_STAGE(G8_SB(1, 0), cB + kstep, voffB); G8_STAGE(G8_SA(1, 0), a0 + kstep, voffA); G8_STAGE(G8_SB(1, 1), cB + hstepB + kstep, voffB);
        G8_WAIT_V(6); G8_BAR;
    }
    for (;;) {
        const bool has_next = S.next(ui + 1, nxt);
        const char* nA = has_next ? (const char*)Aptr + (size_t)nxt.pm * tstepA : cA; const char* nB = has_next ? (const char*)Bptr + (size_t)nxt.pn * tstepB : cB;
#pragma clang loop unroll(disable)
        for (int t = 0; t < nt; t += 2) {
            const bool last = (t == nt - 2);
            const char* a1 = cA + colb<OUTP>(t) + kstep;
            const char* a2 = last ? nA + colb<OUTP>(0) : cA + colb<OUTP>(t + 2); const char* b2 = last ? nB : cB + (size_t)(t + 2) * kstep;
            const char* a3 = a2 + kstep; const char* b3 = b2 + kstep;
            G8_LDB(B0, 0, 0); G8_SCHED; G8_LDA(At, 0, 0); G8_STAGE(G8_SA(1, 1), a1 + hstepA, voffA);
            G8_WAIT_L(8); G8_BAR; G8_WAIT_L(0); G8_MMA(0, 0, At, B0); G8_BAR; G8_SCHED;
            G8_LDB(B1, 0, 1); G8_STAGE(G8_SB(0, 0), b2, voffB);
            G8_BAR; G8_WAIT_L(0); G8_MMA(0, 1, At, B1); G8_BAR;
            G8_LDA(At, 0, 1); G8_STAGE(G8_SA(0, 0), a2, voffA);
            G8_BAR; G8_WAIT_L(0); G8_MMA(1, 0, At, B0); G8_BAR; G8_SCHED;
            G8_STAGE(G8_SB(0, 1), b2 + hstepB, voffB);
            G8_WAIT_V(6); G8_BAR; G8_MMA(1, 1, At, B1); G8_BAR;
            G8_LDB(B0, 1, 0); G8_SCHED; G8_LDA(At, 1, 0); G8_STAGE(G8_SA(0, 1), a2 + hstepA, voffA);
            G8_WAIT_L(8); G8_BAR; G8_WAIT_L(0); G8_MMA(0, 0, At, B0); G8_BAR; G8_SCHED;
            G8_LDB(B1, 1, 1); G8_STAGE(G8_SB(1, 0), b3, voffB);
            G8_BAR; G8_WAIT_L(0); G8_MMA(0, 1, At, B1); G8_BAR;
            G8_LDA(At, 1, 1); G8_STAGE(G8_SA(1, 0), a3, voffA);
            G8_BAR; G8_WAIT_L(0); G8_MMA(1, 0, At, B0); G8_BAR; G8_SCHED;
            G8_STAGE(G8_SB(1, 1), b3 + hstepB, voffB);
            G8_WAIT_V(6); G8_BAR; G8_MMA(1, 1, At, B1); G8_BAR;
        }
        {
            const int row0 = cur.pm * BM + wr * 64 + fr, col0 = cur.pn * BM + wc * 32 + 8 * fq;
#pragma unroll
            for (int ai = 0; ai < 2; ++ai)
#pragma unroll
                for (int m = 0; m < 4; ++m) {
                    bf16_t* rowp = Cptr + (size_t)(row0 + ai * HALF + m * 16) * ldc + col0;
#pragma unroll
                    for (int bj = 0; bj < 2; ++bj) {
                        if (col0 + bj * HALF < N) {
                            const f32x4 v0 = acc[ai][bj][m][0], v1 = acc[ai][bj][m][1];
                            u32x4 w = {cvt_pk(v0[0], v0[1]), cvt_pk(v0[2], v0[3]), cvt_pk(v1[0], v1[1]), cvt_pk(v1[2], v1[3])};
                            *(u32x4*)(rowp + bj * HALF) = w;
                        }
                    }
                }
        }
        if (!has_next) break;
#pragma unroll
        for (int a = 0; a < 2; ++a)
#pragma unroll
            for (int b = 0; b < 2; ++b)
#pragma unroll
                for (int m = 0; m < 4; ++m)
#pragma unroll
                    for (int n = 0; n < 2; ++n) acc[a][b][m][n] = (f32x4){0.f, 0.f, 0.f, 0.f};
        cur = nxt; cA = nA; cB = nB; ++ui;
    }
    G8_WAIT_V(0);
    if (wr == 0) G8_BAR;
    G8_BAR;
#undef G8_SA
#undef G8_SB
#undef G8_STAGE
#undef G8_LDA
#undef G8_LDB
#undef G8_MMA
#undef G8_WAIT_V
#undef G8_WAIT_L
#undef G8_BAR
#undef G8_SCHED
}
}

struct ChunkInfo {
    bool isctx;
    int t0, Tseg;
    size_t rowbase;
};
template <int CH>
__device__ __forceinline__ ChunkInfo chunk_info(int ci, int dir, int b) {
    constexpr int NC = LC / CH, NL = T / CH;
    ChunkInfo c;
    c.isctx = ci < NC;
    const int cidx = c.isctx ? ci : ci - NC;
    const int nch = c.isctx ? NC : NL;
    const int chunk = dir ? (nch - 1 - cidx) : cidx;
    c.Tseg = c.isctx ? LC : T;
    c.rowbase = c.isctx ? (size_t)LAT + (size_t)b * LC : (size_t)b * T;
    c.t0 = chunk * CH;
    return c;
}

template <int DIR>
__device__ __forceinline__ void ret_step(const bf16_t* Q, const bf16_t* K, const bf16_t* V, f32x4 (&S)[4], f32x4 (&o)[4],
                                         int sl, int g, int li, float g64, bool need_o) {
    constexpr int LS = 72;
    const int q4 = li >> 2, p4 = li & 3;
    bf16x8 vf[2];
#pragma unroll
    for (int s = 0; s < 2; ++s)
        vf[s] = cat8(lds_tr(V + (32 * s + 4 * g + q4) * LS + 16 * sl + 4 * p4), lds_tr(V + (32 * s + 16 + 4 * g + q4) * LS + 16 * sl + 4 * p4));
    bf16x8 kr[4][2], qr[4][2];
    if (need_o) {
#pragma unroll
        for (int bi = 0; bi < 4; ++bi)
#pragma unroll
            for (int s2 = 0; s2 < 2; ++s2) {
                kr[bi][s2] = *(const bf16x8*)(K + (16 * bi + li) * LS + 32 * s2 + 8 * g);
                qr[bi][s2] = *(const bf16x8*)(Q + (16 * bi + li) * LS + 32 * s2 + 8 * g);
            }
    }
    __builtin_amdgcn_sched_barrier(0);
    bf16x8 af[4][2];
    if (need_o) {
#pragma unroll
        for (int ci = 0; ci < 4; ++ci) {
            u32x4 fr[2];
#pragma unroll
            for (int bi = 0; bi < 4; ++bi) {
                const bool needed = DIR ? (bi >= ci) : (bi <= ci);
                unsigned w0 = 0, w1 = 0;
                if (needed) {
                    f32x4 t = {0.f, 0.f, 0.f, 0.f};
#pragma unroll
                    for (int s2 = 0; s2 < 2; ++s2) t = MFMA32(kr[bi][s2], qr[ci][s2], t);
                    if (bi == ci) {
#pragma unroll
                        for (int r = 0; r < 4; ++r) {
                            const bool keep = DIR ? (4 * g + r >= li) : (4 * g + r <= li);
                            t[r] = keep ? t[r] : 0.f;
                        }
                    }
                    w0 = cvt_pk(t[0], t[1]);
                    w1 = cvt_pk(t[2], t[3]);
                }
                fr[bi >> 1][(bi & 1) * 2] = w0;
                fr[bi >> 1][(bi & 1) * 2 + 1] = w1;
            }
            af[ci][0] = __builtin_bit_cast(bf16x8, fr[0]);
            af[ci][1] = __builtin_bit_cast(bf16x8, fr[1]);
        }
    }
    bf16x8 ka[4][2], qa[4][2];
#pragma unroll
    for (int mt = 0; mt < 4; ++mt)
#pragma unroll
        for (int s = 0; s < 2; ++s) {
            ka[mt][s] = cat8(lds_tr(K + (32 * s + 4 * g + q4) * LS + 32 * (mt >> 1) + 8 * p4 + 4 * (mt & 1)),
                             lds_tr(K + (32 * s + 16 + 4 * g + q4) * LS + 32 * (mt >> 1) + 8 * p4 + 4 * (mt & 1)));
            if (need_o) qa[mt][s] = qr[mt][s];
        }
    __builtin_amdgcn_sched_barrier(0);
    if (need_o) {
        bf16x8 sf[2];
#pragma unroll
        for (int s = 0; s < 2; ++s) sf[s] = pack8(S[2 * s], S[2 * s + 1]);
#pragma unroll
        for (int ci = 0; ci < 4; ++ci) {
            f32x4 acc = {0.f, 0.f, 0.f, 0.f};
#pragma unroll
            for (int s = 0; s < 2; ++s) {
                acc = MFMA32(sf[s], qa[ci][s], acc);
                acc = MFMA32(vf[s], af[ci][s], acc);
            }
            o[ci] = acc;
        }
    }
#pragma unroll
    for (int mt = 0; mt < 4; ++mt) {
        f32x4 acc = S[mt];
#pragma unroll
        for (int s = 0; s < 2; ++s) acc = MFMA32(ka[mt][s], vf[s], acc);
        S[mt] = acc * g64;
    }
}

__device__ void phase_ret_chain(const Params& p, int l, char* smem, int vb, int nvb, int oz) {
    constexpr int LS = 72;
    constexpr int BUFE = 3 * 64 * LS;
    bf16_t* lds = (bf16_t*)smem;
    bf16_t* U = (bf16_t*)(p.ws + OFF_U);
    const int tid = threadIdx.x + oz, lane = tid & 63, wave = tid >> 6;
    const int sl = wave & 3, g = lane >> 4, li = lane & 15;
    const bool loader = wave >= 4;
    const int at = tid & 255, fr = at >> 2, fj = at & 3;
    const bool with_ctx = l < 3;
    for (int it = vb; it < 64; it += nvb) {
        const int b = it >> 3, h = (it >> 1) & 3, dir = it & 1;
        const float lg2 = log2f(sigmoidf_(p.in[I_RDEC][(l * 2 + dir) * 4 + h]));
        if (loader) {
            float invr[8];
#pragma unroll
            for (int ii = 0; ii < 8; ++ii) invr[ii] = expf(-(float)(8 * fj + ii) * (9.210340371976184f / 32.f)) * 0.15915494309189535f;
            const float pp1 = (float)((dir ? 63 - fr : fr) + 1);
            const float fq = exp2f(lg2 * pp1), fk = 0.125f * exp2f(-lg2 * pp1);
            u32x4 ra[6], rb[6], rc[6];
#define RET_LOAD(R, ci_)                                                                              \
    {                                                                                                 \
        const ChunkInfo cc = chunk_info<64>((ci_), dir, b);                                           \
        const bf16_t* base = U + (cc.rowbase + cc.t0 + fr) * INW + h * 64 + 8 * fj;                   \
        R[0] = *(const u32x4*)(base + C_RQ); R[1] = *(const u32x4*)(base + C_RQ + 32);                \
        R[2] = *(const u32x4*)(base + C_RK); R[3] = *(const u32x4*)(base + C_RK + 32);                \
        R[4] = *(const u32x4*)(base + C_RV); R[5] = *(const u32x4*)(base + C_RV + 32);                \
    }
#define RET_FILL(R, ci_, buf_)                                                                        \
    {                                                                                                 \
        const ChunkInfo cc = chunk_info<64>((ci_), dir, b);                                           \
        bf16_t* Q = lds + (buf_) * BUFE;                                                              \
        bf16_t* K = Q + 64 * LS;                                                                      \
        bf16_t* V = K + 64 * LS;                                                                      \
        float q1[8], q2[8], k1[8], k2[8];                                                             \
        _Pragma("unroll") for (int w = 0; w < 4; ++w) {                                               \
            q1[2 * w] = lo16(R[0][w]); q1[2 * w + 1] = hi16(R[0][w]);                                 \
            q2[2 * w] = lo16(R[1][w]); q2[2 * w + 1] = hi16(R[1][w]);                                 \
            k1[2 * w] = lo16(R[2][w]); k1[2 * w + 1] = hi16(R[2][w]);                                 \
            k2[2 * w] = lo16(R[3][w]); k2[2 * w + 1] = hi16(R[3][w]);                                 \
        }                                                                                             \
        if (!cc.isctx) {                                                                              \
            const float pos = (float)(cc.t0 + fr);                                                    \
            _Pragma("unroll") for (int ii = 0; ii < 8; ++ii) {                                        \
                float rev = pos * invr[ii];                                                           \
                rev -= floorf(rev);                                                                   \
                const float cs = __builtin_amdgcn_cosf(rev), sn = __builtin_amdgcn_sinf(rev);         \
                const float a1 = q1[ii], a2 = q2[ii];                                                 \
                q1[ii] = a1 * cs - a2 * sn;                                                           \
                q2[ii] = a1 * sn + a2 * cs;                                                           \
                const float b1 = k1[ii], b2 = k2[ii];                                                 \
                k1[ii] = b1 * cs - b2 * sn;                                                           \
                k2[ii] = b1 * sn + b2 * cs;                                                           \
            }                                                                                         \
        }                                                                                             \
        u32x4 o1, o2;                                                                                 \
        _Pragma("unroll") for (int w = 0; w < 4; ++w) { o1[w] = cvt_pk(q1[2 * w] * fq, q1[2 * w + 1] * fq); o2[w] = cvt_pk(q2[2 * w] * fq, q2[2 * w + 1] * fq); } \
        *(u32x2*)(Q + fr * LS + permcol(8 * fj)) = (u32x2){o1[0], o1[1]};                             \
        *(u32x2*)(Q + fr * LS + permcol(8 * fj + 4)) = (u32x2){o1[2], o1[3]};                         \
        *(u32x2*)(Q + fr * LS + permcol(32 + 8 * fj)) = (u32x2){o2[0], o2[1]};                        \
        *(u32x2*)(Q + fr * LS + permcol(36 + 8 * fj)) = (u32x2){o2[2], o2[3]};                        \
        _Pragma("unroll") for (int w = 0; w < 4; ++w) { o1[w] = cvt_pk(k1[2 * w] * fk, k1[2 * w + 1] * fk); o2[w] = cvt_pk(k2[2 * w] * fk, k2[2 * w + 1] * fk); } \
        *(u32x2*)(K + fr * LS + permcol(8 * fj)) = (u32x2){o1[0], o1[1]};                             \
        *(u32x2*)(K + fr * LS + permcol(8 * fj + 4)) = (u32x2){o1[2], o1[3]};                         \
        *(u32x2*)(K + fr * LS + permcol(32 + 8 * fj)) = (u32x2){o2[0], o2[1]};                        \
        *(u32x2*)(K + fr * LS + permcol(36 + 8 * fj)) = (u32x2){o2[2], o2[3]};                        \
        *(u32x4*)(V + fr * LS + 8 * fj) = R[4];                                                       \
        *(u32x4*)(V + fr * LS + 32 + 8 * fj) = R[5];                                                  \
    }
            RET_LOAD(ra, 0)
            RET_LOAD(rb, 1)
            RET_LOAD(rc, 2)
            RET_FILL(ra, 0, 0)
            RET_LOAD(ra, 3)
            LDS_BARRIER();
            for (int ci = 0; ci < 36; ci += 6) {
                RET_FILL(rb, ci + 1, 1)  if (ci + 4 < 36) RET_LOAD(rb, ci + 4)  LDS_BARRIER();
                RET_FILL(rc, ci + 2, 0)  if (ci + 5 < 36) RET_LOAD(rc, ci + 5)  LDS_BARRIER();
                RET_FILL(ra, ci + 3, 1)  if (ci + 6 < 36) RET_LOAD(ra, ci + 6)  LDS_BARRIER();
                RET_FILL(rb, ci + 4, 0)  if (ci + 7 < 36) RET_LOAD(rb, ci + 7)  LDS_BARRIER();
                RET_FILL(rc, ci + 5, 1)  if (ci + 8 < 36) RET_LOAD(rc, ci + 8)  LDS_BARRIER();
                if (ci + 6 < 36) RET_FILL(ra, ci + 6, 0)  if (ci + 9 < 36) RET_LOAD(ra, ci + 9)  LDS_BARRIER();
            }
#undef RET_LOAD
#undef RET_FILL
        } else {
            const float g64 = exp2f(lg2 * 64.f);
            bf16_t* OUTB = (bf16_t*)(p.ws + OFF_P + (size_t)(2 + dir) * SZ_T);
            f32x4 S[4];
#pragma unroll
            for (int mt = 0; mt < 4; ++mt) S[mt] = (f32x4){0.f, 0.f, 0.f, 0.f};
            bf16x4 ost[4];
            size_t orow = 0;
            bool ohave = false;
            if (__builtin_amdgcn_readfirstlane(wave) < 4) __builtin_amdgcn_s_setprio(3);
            LDS_BARRIER();
            for (int ci = 0; ci < 36; ++ci) {
                if (ohave) {
#pragma unroll
                    for (int mt = 0; mt < 4; ++mt) *(bf16x4*)(OUTB + (orow + 16 * mt + li) * 256 + h * 64 + 16 * sl + 4 * g) = ost[mt];
                }
                const ChunkInfo c = chunk_info<64>(ci, dir, b);
                const bool need_o = !c.isctx || with_ctx;
                const bf16_t* Q = lds + (ci & 1) * BUFE;
                const bf16_t* K = Q + 64 * LS;
                const bf16_t* V = K + 64 * LS;
                f32x4 o[4];
                if (dir == 0) ret_step<0>(Q, K, V, S, o, sl, g, li, g64, need_o);
                else          ret_step<1>(Q, K, V, S, o, sl, g, li, g64, need_o);
                ohave = need_o;
                if (need_o) {
                    orow = c.rowbase + c.t0;
#pragma unroll
                    for (int mt = 0; mt < 4; ++mt) ost[mt] = pack4(o[mt]);
                }
                LDS_BARRIER();
            }
            if (ohave) {
#pragma unroll
                for (int mt = 0; mt < 4; ++mt) *(bf16x4*)(OUTB + (orow + 16 * mt + li) * 256 + h * 64 + 16 * sl + 4 * g) = ost[mt];
            }
        }
        __builtin_amdgcn_s_setprio(0);
        LDS_BARRIER();
    }
}

template <int DIR>
__device__ __forceinline__ void lru_scan(const float (&av)[4][4], const float (&bv)[4][4], float (&hv)[4][4], float& hc, float& pc, int g, int li) {
#pragma unroll
    for (int mi = 0; mi < 4; ++mi) {
        const int mt = DIR ? 3 - mi : mi;
        const float a0 = av[mt][DIR ? 3 : 0], a1 = av[mt][DIR ? 2 : 1], a2 = av[mt][DIR ? 1 : 2], a3 = av[mt][DIR ? 0 : 3];
        const float b0 = bv[mt][DIR ? 3 : 0], b1 = bv[mt][DIR ? 2 : 1], b2 = bv[mt][DIR ? 1 : 2], b3 = bv[mt][DIR ? 0 : 3];
        const float A4 = a0 * a1 * a2 * a3;
        const float B4 = ((b0 * a1 + b1) * a2 + b2) * a3 + b3;
        float hs = hc, hend = hc, pend = pc;
#pragma unroll
        for (int gi = 0; gi < 4; ++gi) {
            const int gg = DIR ? 3 - gi : gi;
            const float Ag = __shfl(A4, gg * 16 + li), Bg = __shfl(B4, gg * 16 + li);
            hs = (gg == g) ? hend : hs;
            hend = Ag * hend + Bg;
            pend = Ag * pend;
        }
        hc = hend;
        pc = pend;
        const float h0 = a0 * hs + b0, h1 = a1 * h0 + b1, h2 = a2 * h1 + b2, h3 = a3 * h2 + b3;
        hv[mt][DIR ? 3 : 0] = h0;
        hv[mt][DIR ? 2 : 1] = h1;
        hv[mt][DIR ? 1 : 2] = h2;
        hv[mt][DIR ? 0 : 3] = h3;
    }
}

template <int PASS>
__device__ void lru_loop(const Params& p, int l, char* smem, int first, int end, int stride, bool skip_ctx, int oz) {
    constexpr int LS = 72;
    if (first >= end) return;
    bf16_t* ul = (bf16_t*)smem;
    float* pre = (float*)(smem + 64 * LS * 2);
    float* car = pre + 2 * 35 * 64 * 2;
    float* exc = car + 128;
    bf16_t* U = (bf16_t*)(p.ws + OFF_U);
    float* AGG = (float*)(p.ws + OFF_AGG);
    int oz2 = oz;
    asm volatile("" : "+v"(oz2));
    const int tid = threadIdx.x + oz2, lane = tid & 63, wave = tid >> 6;
    const int dir = wave >> 2, nt = wave & 3, g = lane >> 4, li = lane & 15;
    const int c8 = tid & 7, ft = tid >> 3;
    const int n = first & 3;
    const int d = 16 * nt + li, ch = n * 64 + d;
    bf16x8 wf[2][2];
#pragma unroll
    for (int m = 0; m < 2; ++m)
#pragma unroll
        for (int s = 0; s < 2; ++s) {
            const float* W = (m ? p.in[I_LWI] : p.in[I_LWR]) + (size_t)((l * 2 + dir) * 4 + n) * 4096 + d;
            float w[8];
#pragma unroll
            for (int jj = 0; jj < 8; ++jj) w[jj] = W[(32 * s + 8 * g + jj) * 64];
            u32x4 u = {cvt_pk(w[0], w[1]), cvt_pk(w[2], w[3]), cvt_pk(w[4], w[5]), cvt_pk(w[6], w[7])};
            wf[m][s] = __builtin_bit_cast(bf16x8, u);
        }
    const float br = p.in[I_LBR][(l * 2 + dir) * 256 + ch];
    const float bi = p.in[I_LBI][(l * 2 + dir) * 256 + ch];
    const float sp8 = -8.f * softplusf_(-p.in[I_LLAM][(l * 2 + dir) * 256 + ch]);
    float cbv[8], cwv[4][8];
#pragma unroll
    for (int e = 0; e < 8; ++e) {
        cbv[e] = p.in[I_LCB][l * 256 + n * 64 + 8 * c8 + e];
#pragma unroll
        for (int j = 0; j < 4; ++j) cwv[j][e] = p.in[I_LCW][(l * 4 + j) * 256 + n * 64 + 8 * c8 + e];
    }
    u32x4 nrx[4], nzv = {0u, 0u, 0u, 0u};
#define LRU_ITEM_OF(idx_) (skip_ctx ? ((idx_) >> 7) * 144 + 16 + ((idx_) & 127) : (idx_))
#define LRU_LOAD(idx_)                                                                                      \
    {                                                                                                       \
        const int it_ = LRU_ITEM_OF(idx_);                                                                  \
        const int b_ = it_ / 144, cid_ = (it_ >> 2) % 36;                                                   \
        const bool ic_ = cid_ < 4;                                                                          \
        const int t0_ = (ic_ ? cid_ : cid_ - 4) * 64, Ts_ = ic_ ? LC : T;                                   \
        const size_t rb_ = ic_ ? (size_t)LAT + (size_t)b_ * LC : (size_t)b_ * T;                            \
        _Pragma("unroll") for (int j = 0; j < 4; ++j) {                                                     \
            int tt = t0_ + ft + j - 2;                                                                      \
            tt = tt < 0 ? 0 : (tt > Ts_ - 1 ? Ts_ - 1 : tt);                                                \
            nrx[j] = *(const u32x4*)(U + (rb_ + tt) * INW + C_LRUX + n * 64 + 8 * c8);                      \
        }                                                                                                   \
        if (PASS == 1) nzv = *(const u32x4*)(U + (rb_ + t0_ + ft) * INW + C_LRUZ + n * 64 + 8 * c8);        \
    }
    LRU_LOAD(first)
  for (int idx = first; idx < end; idx += stride) {
    const int item = LRU_ITEM_OF(idx);
    const int b = item / 144, cid = (item >> 2) % 36;
    const bool isctx = cid < 4;
    const int t0 = (isctx ? cid : cid - 4) * 64, Tseg = isctx ? LC : T;
    const size_t rowbase = isctx ? (size_t)LAT + (size_t)b * LC : (size_t)b * T;
    u32x4 rx[4];
#pragma unroll
    for (int j = 0; j < 4; ++j) rx[j] = nrx[j];
    const u32x4 zv = nzv;
    const int posf = cid, posb = isctx ? 3 - cid : 39 - cid;
    f32x4 pr[5];
    if (PASS == 1) {
#pragma unroll
        for (int k = 0; k < 5; ++k) {
            const int pidx = tid + 512 * k;
            const int dd = pidx / (35 * 32), rem = pidx % (35 * 32), q = rem >> 5, pc16 = rem & 31;
            const bool need = (dd < 2) && (q < (dd ? posb : posf));
            const int j = dd ? (q < 4 ? 3 - q : 39 - q) : q;
            pr[k] = (f32x4){1.f, 0.f, 1.f, 0.f};
            if (need) pr[k] = *(const f32x4*)(AGG + ((size_t)((b * 2 + dd) * 36 + j) * 256 + n * 64) * 2 + pc16 * 4);
        }
    }
    if (idx + stride < end) LRU_LOAD(idx + stride)
    __syncthreads();
    {
        float acc[8];
#pragma unroll
        for (int e = 0; e < 8; ++e) acc[e] = cbv[e];
#pragma unroll
        for (int j = 0; j < 4; ++j) {
            const int tt = t0 + ft + j - 2;
            const bool ok = (tt >= 0) && (tt < Tseg);
#pragma unroll
            for (int w = 0; w < 4; ++w) {
                const unsigned xw = ok ? rx[j][w] : 0u;
                acc[2 * w] += cwv[j][2 * w] * lo16(xw);
                acc[2 * w + 1] += cwv[j][2 * w + 1] * hi16(xw);
            }
        }
        u32x4 o = {cvt_pk(acc[0], acc[1]), cvt_pk(acc[2], acc[3]), cvt_pk(acc[4], acc[5]), cvt_pk(acc[6], acc[7])};
        *(u32x4*)(ul + ft * LS + 8 * c8) = o;
    }
    if (PASS == 1) {
#pragma unroll
        for (int k = 0; k < 5; ++k) {
            const int pidx = tid + 512 * k;
            if (pidx < 2 * 35 * 32) *(f32x4*)(pre + pidx * 4) = pr[k];
        }
    }
    __syncthreads();
    if (PASS == 1 && tid < 128) {
        const int dd = tid >> 6, cc = tid & 63, np = dd ? posb : posf;
        float h = 0.f;
        for (int q = 0; q < np; ++q) {
            const f32x2 ah = *(const f32x2*)(pre + ((dd * 35 + q) * 64 + cc) * 2);
            h = ah[0] * h + ah[1];
        }
        car[tid] = h;
    }
    float av[4][4], bv[4][4], hv[4][4];
#pragma unroll
    for (int mt = 0; mt < 4; ++mt) {
        f32x4 racc = {0.f, 0.f, 0.f, 0.f}, iacc = {0.f, 0.f, 0.f, 0.f};
#pragma unroll
        for (int s = 0; s < 2; ++s) {
            const bf16x8 a = *(const bf16x8*)(ul + (16 * mt + li) * LS + 32 * s + 8 * g);
            racc = MFMA32(a, wf[0][s], racc);
            iacc = MFMA32(a, wf[1][s], iacc);
        }
#pragma unroll
        for (int r = 0; r < 4; ++r) {
            const float uval = bf2f(ul[(16 * mt + 4 * g + r) * LS + d]);
            const float rg = sigmoidf_(racc[r] + br), ig = sigmoidf_(iacc[r] + bi);
            const float a = fexp(sp8 * rg);
            av[mt][r] = a;
            bv[mt][r] = __builtin_amdgcn_sqrtf(fmaxf(0.f, 1.f - a * a)) * ig * uval;
        }
    }
    if (PASS == 0) {
        float hc = 0.f, pc = 1.f;
        if (dir == 0) lru_scan<0>(av, bv, hv, hc, pc, g, li);
        else          lru_scan<1>(av, bv, hv, hc, pc, g, li);
        if (g == 0) *(f32x2*)(AGG + ((size_t)((b * 2 + dir) * 36 + cid) * 256 + ch) * 2) = (f32x2){pc, hc};
    } else {
        __syncthreads();
        float hc = car[dir * 64 + d], pc = 1.f;
        if (dir == 0) lru_scan<0>(av, bv, hv, hc, pc, g, li);
        else          lru_scan<1>(av, bv, hv, hc, pc, g, li);
#pragma unroll
        for (int mt = 0; mt < 4; ++mt)
#pragma unroll
            for (int r = 0; r < 4; ++r) exc[dir * 4096 + (16 * mt + 4 * g + r) * 64 + d] = hv[mt][r];
        __syncthreads();
        const float* ef = exc + ft * 64 + 8 * c8;
        const f32x4 f0 = *(const f32x4*)ef, f1 = *(const f32x4*)(ef + 4), b0 = *(const f32x4*)(ef + 4096), b1 = *(const f32x4*)(ef + 4100);
        u32x4 y;
        y[0] = cvt_pk((f0[0] + b0[0]) * siluf_(lo16(zv[0])), (f0[1] + b0[1]) * siluf_(hi16(zv[0])));
        y[1] = cvt_pk((f0[2] + b0[2]) * siluf_(lo16(zv[1])), (f0[3] + b0[3]) * siluf_(hi16(zv[1])));
        y[2] = cvt_pk((f1[0] + b1[0]) * siluf_(lo16(zv[2])), (f1[1] + b1[1]) * siluf_(hi16(zv[2])));
        y[3] = cvt_pk((f1[2] + b1[2]) * siluf_(lo16(zv[3])), (f1[3] + b1[3]) * siluf_(hi16(zv[3])));
        *(u32x4*)(U + (rowbase + t0 + ft) * INW + C_LRUZ + n * 64 + 8 * c8) = y;
    }
  }
#undef LRU_LOAD
#undef LRU_ITEM_OF
}

template <int DIR>
__device__ __forceinline__ void gdn_prep_wave(const bf16_t* qs, const bf16_t* ks, const bf16_t* vs, const float* beta, const float* G,
                                              int half, int g, int li, int lane, bf16_t* gwd, bf16_t* guv, bf16_t* gatt) {
    constexpr int LS = 72;
    float bcol[4], Gcol[4];
    f32x4 Grow[4], brow[4];
#pragma unroll
    for (int i = 0; i < 4; ++i) {
        bcol[i] = beta[16 * i + li];
        Gcol[i] = G[16 * i + li];
        Grow[i] = *(const f32x4*)(G + 16 * i + 4 * g);
        brow[i] = *(const f32x4*)(beta + 16 * i + 4 * g);
    }
    bf16x4 LtF[4][4];
    f32x4 Ntile[4], NtT[4];
#pragma unroll
    for (int ib = 0; ib < 4; ++ib)
#pragma unroll
        for (int kb = 0; kb < 4; ++kb) {
            const bool needed = DIR ? (kb >= ib) : (kb <= ib);
            if (needed) {
                f32x4 t = {0.f, 0.f, 0.f, 0.f};
#pragma unroll
                for (int s2 = 0; s2 < 2; ++s2) {
                    const bf16x8 a = *(const bf16x8*)(ks + (16 * kb + li) * LS + 32 * s2 + 8 * g);
                    const bf16x8 bb = *(const bf16x8*)(ks + (16 * ib + li) * LS + 32 * s2 + 8 * g);
                    t = MFMA32(a, bb, t);
                }
                f32x4 lt;
#pragma unroll
                for (int r = 0; r < 4; ++r) lt[r] = -(bcol[ib] * t[r] * fexp(Gcol[ib] - Grow[kb][r]));
                if (kb == ib) {
                    f32x4 nn;
#pragma unroll
                    for (int r = 0; r < 4; ++r) {
                        const bool keepT = DIR ? (4 * g + r > li) : (4 * g + r < li);
                        lt[r] = keepT ? lt[r] : 0.f;
                        const bool keepN = DIR ? (li > 4 * g + r) : (li < 4 * g + r);
                        const float nv = -(brow[ib][r] * t[r] * fexp(Grow[ib][r] - Gcol[ib]));
                        nn[r] = keepN ? nv : 0.f;
                    }
                    NtT[ib] = lt;
                    Ntile[ib] = nn;
                } else {
                    LtF[ib][kb] = pack4(lt);
                }
            }
        }
    bf16x4 DtF[4];
#pragma unroll
    for (int i = 0; i < 4; ++i) {
        f32x4 M = Ntile[i], Mt = NtT[i], P = Ntile[i], Pt = NtT[i];
#pragma unroll
        for (int r = 0; r < 4; ++r) {
            const float one = (4 * g + r == li) ? 1.f : 0.f;
            P[r] += one;
            Pt[r] += one;
        }
#pragma unroll
        for (int k = 0; k < 3; ++k) {
            const bf16x4 fM = pack4(M), fMt = pack4(Mt);
            const f32x4 z = {0.f, 0.f, 0.f, 0.f};
            const f32x4 M2 = MFMA16(fMt, fM, z);
            const f32x4 Mt2 = MFMA16(fM, fMt, z);
            const bf16x4 fPt = pack4(Pt), fM2 = pack4(M2);
            P = MFMA16(fPt, fM2, P);
            Pt = MFMA16(fM2, fPt, Pt);
            M = M2;
            Mt = Mt2;
        }
        DtF[i] = pack4(Pt);
    }
    bf16x4 Xf[4][4];
#pragma unroll
    for (int si = 0; si < 4; ++si) {
        const int i = DIR ? 3 - si : si;
        f32x4 eg;
#pragma unroll
        for (int r = 0; r < 4; ++r) eg[r] = half ? brow[i][r] * fexp(Grow[i][r]) : brow[i][r];
        const bf16_t* src = half ? ks : vs;
#pragma unroll
        for (int ntl = 0; ntl < 4; ++ntl) {
            f32x4 Y;
#pragma unroll
            for (int r = 0; r < 4; ++r) Y[r] = eg[r] * bf2f(src[(16 * i + 4 * g + r) * LS + 16 * ntl + li]);
#pragma unroll
            for (int sk = 0; sk < si; ++sk) {
                const int k = DIR ? 3 - sk : sk;
                Y = MFMA16(LtF[i][k], Xf[k][ntl], Y);
            }
            const f32x4 z = {0.f, 0.f, 0.f, 0.f};
            const f32x4 X = MFMA16(DtF[i], pack4(Y), z);
            Xf[i][ntl] = pack4(X);
            if (half == 0) {
                *(bf16x4*)(guv + ((i * 4 + ntl) * 64 + lane) * 4) = Xf[i][ntl];
            } else {
#pragma unroll
                for (int r = 0; r < 4; ++r) gwd[(16 * i + 4 * g + r) * 64 + permcol(16 * ntl + li)] = f2bf(-X[r]);
            }
        }
    }
    for (int cix = 0; cix < 2; ++cix) {
        const int ci = 2 * half + cix;
        const float Gc = G[16 * ci + li];
#pragma unroll
        for (int bi = 0; bi < 4; ++bi) {
            const bool needed = DIR ? (bi >= ci) : (bi <= ci);
            f32x4 v = {0.f, 0.f, 0.f, 0.f};
            if (needed) {
                f32x4 t = {0.f, 0.f, 0.f, 0.f};
#pragma unroll
                for (int s2 = 0; s2 < 2; ++s2) {
                    const bf16x8 a = *(const bf16x8*)(ks + (16 * bi + li) * LS + 32 * s2 + 8 * g);
                    const bf16x8 bb = *(const bf16x8*)(qs + (16 * ci + li) * LS + 32 * s2 + 8 * g);
                    t = MFMA32(a, bb, t);
                }
#pragma unroll
                for (int r = 0; r < 4; ++r) {
                    const float x = t[r] * fexp(Gc - Grow[bi][r]);
                    const bool keep = (bi != ci) || (DIR ? (4 * g + r >= li) : (4 * g + r <= li));
                    v[r] = keep ? x : 0.f;
                }
            }
            *(bf16x4*)(gatt + (16 * ci + li) * 64 + permcol(16 * bi + 4 * g)) = pack4(v);
        }
    }
}

__device__ void phase_gdn_prep(const Params& p, int l, char* smem, int vb, int nvb, int pend, int oz) {
    constexpr int LS = 72;
    constexpr int HBYTES = 57984;
    const int hb = (int)((threadIdx.x + oz) >> 8);
    smem += hb * HBYTES;
    bf16_t* raw = (bf16_t*)smem;
    bf16_t* qs = (bf16_t*)(smem + 25728);
    bf16_t* ks = qs + 64 * LS;
    bf16_t* vs = ks + 64 * LS;
    float* cwl = (float*)(smem + 53376);
    float* gl = cwl + 768;
    float* bl = gl + 128;
    float* Gl = bl + 128;
    bf16_t* U = (bf16_t*)(p.ws + OFF_U);
    for (int pair = vb; pair < pend; pair += nvb) {
        int oz2 = oz;
        asm volatile("" : "+v"(oz2));
        const int tid = (threadIdx.x + oz2) & 255, lane = tid & 63, wave = tid >> 6, g = lane >> 4, li = lane & 15;
        const int it = 2 * pair + hb;
        const int b = it / 144, h = (it / 36) & 3, cid = it % 36;
        const bool isctx = cid < 4;
        const int t0 = (isctx ? cid : cid - 4) * 64;
        const int Tseg = isctx ? LC : T;
        const size_t rowbase = isctx ? (size_t)LAT + (size_t)b * LC : (size_t)b * T;
        __syncthreads();
        {
            u32x4 rv[7];
            float cv[3];
#pragma unroll
            for (int k = 0; k < 7; ++k) {
                const int idx = tid + 256 * k;
                const int r = idx / 24, c8 = idx % 24;
                int t = t0 - 2 + r;
                const bool ok = (idx < 67 * 24) && (t >= 0) && (t < Tseg);
                t = ok ? t : t0;
                rv[k] = *(const u32x4*)(U + (rowbase + t) * INW + C_GQ + (c8 >> 3) * 256 + h * 64 + (c8 & 7) * 8);
                if (!ok) rv[k] = (u32x4){0u, 0u, 0u, 0u};
            }
#pragma unroll
            for (int k = 0; k < 3; ++k) {
                const int idx = tid + 256 * k, j = idx / 192, cc = idx % 192;
                cv[k] = p.in[I_GCW][(l * 4 + j) * 768 + (cc >> 6) * 256 + h * 64 + (cc & 63)];
            }
#pragma unroll
            for (int k = 0; k < 7; ++k) {
                const int idx = tid + 256 * k;
                if (idx < 67 * 24) *(u32x4*)(raw + (idx / 24) * 192 + (idx % 24) * 8) = rv[k];
            }
#pragma unroll
            for (int k = 0; k < 3; ++k) cwl[tid + 256 * k] = cv[k];
        }
        if (tid < 128) {
            const int dd = tid >> 6, t = tid & 63;
            const size_t row = rowbase + t0 + t;
            const float alpha = bf2f(U[row * INW + C_GA + dd * 4 + h]);
            const float beta = bf2f(U[row * INW + C_GB + dd * 4 + h]);
            gl[tid] = -fexp(p.in[I_GALOG][(l * 2 + dd) * 4 + h]) * softplusf_(alpha + p.in[I_GDT][(l * 2 + dd) * 4 + h]);
            bl[tid] = sigmoidf_(beta);
        }
        __syncthreads();
        {
            const int t = tid >> 2, qt = tid & 3;
#pragma unroll
            for (int which = 0; which < 3; ++which) {
                float a[16];
#pragma unroll
                for (int i = 0; i < 16; ++i) a[i] = 0.f;
#pragma unroll
                for (int j = 0; j < 4; ++j) {
                    const u32x4 x0 = *(const u32x4*)(raw + (t + j) * 192 + which * 64 + qt * 16);
                    const u32x4 x1 = *(const u32x4*)(raw + (t + j) * 192 + which * 64 + qt * 16 + 8);
                    const float* cwp = cwl + j * 192 + which * 64 + qt * 16;
#pragma unroll
                    for (int w = 0; w < 4; ++w) {
                        a[2 * w] += cwp[2 * w] * lo16(x0[w]);
                        a[2 * w + 1] += cwp[2 * w + 1] * hi16(x0[w]);
                        a[8 + 2 * w] += cwp[8 + 2 * w] * lo16(x1[w]);
                        a[8 + 2 * w + 1] += cwp[8 + 2 * w + 1] * hi16(x1[w]);
                    }
                }
                float ss = 0.f;
#pragma unroll
                for (int i = 0; i < 16; ++i) {
                    a[i] = siluf_(a[i]);
                    ss += a[i] * a[i];
                }
                float sc = 1.f;
                if (which < 2) {
                    ss += __shfl_xor(ss, 1);
                    ss += __shfl_xor(ss, 2);
                    sc = rsqrtf(ss + EPS) * (which == 0 ? 0.125f : 1.f);
                }
                bf16_t* dst = (which == 0 ? qs : which == 1 ? ks : vs) + t * LS + qt * 16;
                u32x4 o0 = {cvt_pk(a[0] * sc, a[1] * sc), cvt_pk(a[2] * sc, a[3] * sc), cvt_pk(a[4] * sc, a[5] * sc), cvt_pk(a[6] * sc, a[7] * sc)};
                u32x4 o1 = {cvt_pk(a[8] * sc, a[9] * sc), cvt_pk(a[10] * sc, a[11] * sc), cvt_pk(a[12] * sc, a[13] * sc), cvt_pk(a[14] * sc, a[15] * sc)};
                *(u32x4*)dst = o0;
                *(u32x4*)(dst + 8) = o1;
            }
        }
        if (wave < 2) {
            float v = gl[wave * 64 + lane];
#pragma unroll
            for (int off = 1; off < 64; off <<= 1) {
                const float nb = wave == 0 ? __shfl_up(v, off) : __shfl_down(v, off);
                const bool ok = wave == 0 ? (lane >= off) : (lane + off < 64);
                v += ok ? nb : 0.f;
            }
            Gl[wave * 64 + lane] = v;
        }
        __syncthreads();
        bf16_t* gq = (bf16_t*)(p.ws + OFF_GQ) + (size_t)it * 4096;
        bf16_t* gkt = (bf16_t*)(p.ws + OFF_GKT) + (size_t)it * 4096;
#pragma unroll
        for (int k = 0; k < 2; ++k) {
            const int pc = tid + 256 * k, row = pc >> 3, c8 = pc & 7;
            {
                const u32x4 qv = *(const u32x4*)(qs + row * LS + 8 * c8);
                *(u32x2*)(gq + row * 64 + permcol(8 * c8)) = (u32x2){qv[0], qv[1]};
                *(u32x2*)(gq + row * 64 + permcol(8 * c8 + 4)) = (u32x2){qv[2], qv[3]};
            }
            const int d = pc >> 3, c0 = (pc & 7) * 8;
            float kv[8];
#pragma unroll
            for (int i = 0; i < 8; ++i) kv[i] = bf2f(ks[(c0 + i) * LS + d]);
            u32x4 o = {cvt_pk(kv[0], kv[1]), cvt_pk(kv[2], kv[3]), cvt_pk(kv[4], kv[5]), cvt_pk(kv[6], kv[7])};
            *(u32x2*)(gkt + d * 64 + permcol(c0)) = (u32x2){o[0], o[1]};
            *(u32x2*)(gkt + d * 64 + permcol(c0 + 4)) = (u32x2){o[2], o[3]};
        }
        if (tid < 128) {
            const int dd = tid >> 6, t = tid & 63;
            float* vec = (float*)(p.ws + OFF_GVEC) + ((size_t)dd * GI + it) * 256;
            const float Glast = dd ? Gl[64] : Gl[63];
            const float Gt = Gl[dd * 64 + t];
            vec[t] = fexp(Gt);
            vec[64 + t] = fexp(Glast - Gt);
            if (t == 0) vec[128] = fexp(Glast);
        }
        {
            const int dir = wave >> 1, half = wave & 1;
            bf16_t* gwd = (bf16_t*)(p.ws + OFF_GWD) + ((size_t)dir * GI + it) * 4096;
            bf16_t* guv = (bf16_t*)(p.ws + OFF_GUV) + ((size_t)dir * GI + it) * 4096;
            bf16_t* gatt = (bf16_t*)(p.ws + OFF_GATT) + ((size_t)dir * GI + it) * 4096;
            if (dir == 0) gdn_prep_wave<0>(qs, ks, vs, bl, Gl, half, g, li, lane, gwd, guv, gatt);
            else          gdn_prep_wave<1>(qs, ks, vs, bl + 64, Gl + 64, half, g, li, lane, gwd, guv, gatt);
        }
    }
}

__device__ void phase_gdn_chain(const Params& p, int l, char* smem, int vb, int nvb, int oz) {
    constexpr int LS = 72;
    constexpr int TILEB = 64 * LS * 2;
    constexpr int BUFB = 4 * TILEB + 8192 + 528;
    bf16_t* U = (bf16_t*)(p.ws + OFF_U);
    const int tid = threadIdx.x + oz, lane = tid & 63, wave = tid >> 6;
    const int sl = wave & 3, g = lane >> 4, li = lane & 15;
    const bool loader = wave >= 4;
    const int at = tid & 255;
    const bool with_ctx = l < 3;
    for (int it = vb; it < 64; it += nvb) {
        const int b = it >> 3, h = (it >> 1) & 3, dir = it & 1;
#define GDN_GI(ci_) ((b * 4 + h) * 36 + (dir ? ((ci_) < 4 ? 3 - (ci_) : 39 - (ci_)) : (ci_)))
        if (loader) {
            u32x4 ra[5][2], rb[5][2], rc[5][2];
            float va = 0.f, vb_ = 0.f, vc_ = 0.f, ga = 0.f, gb = 0.f, gc = 0.f;
#define GDN_LOAD(R, V, G, ci_)                                                                                   \
    {                                                                                                            \
        const size_t gi = GDN_GI(ci_);                                                                           \
        const bf16_t* tp[5] = {(const bf16_t*)(p.ws + OFF_GWD) + ((size_t)dir * GI + gi) * 4096,                 \
                               (const bf16_t*)(p.ws + OFF_GATT) + ((size_t)dir * GI + gi) * 4096,                \
                               (const bf16_t*)(p.ws + OFF_GKT) + gi * 4096,                                      \
                               (const bf16_t*)(p.ws + OFF_GQ) + gi * 4096,                                       \
                               (const bf16_t*)(p.ws + OFF_GUV) + ((size_t)dir * GI + gi) * 4096};                \
        _Pragma("unroll") for (int tl = 0; tl < 5; ++tl)                                                         \
            _Pragma("unroll") for (int k = 0; k < 2; ++k) R[tl][k] = *(const u32x4*)(tp[tl] + (at + 256 * k) * 8); \
        const float* vp = (const float*)(p.ws + OFF_GVEC) + ((size_t)dir * GI + gi) * 256;                       \
        if (at < 128) V = vp[at];                                                                                \
        if (at == 0) G = vp[128];                                                                                \
    }
#define GDN_FILL(R, V, G, buf_)                                                                                  \
    {                                                                                                            \
        char* bp = smem + (buf_) * BUFB;                                                                         \
        _Pragma("unroll") for (int tl = 0; tl < 4; ++tl)                                                         \
            _Pragma("unroll") for (int k = 0; k < 2; ++k) {                                                      \
                const int pc = at + 256 * k;                                                                     \
                *(u32x4*)(bp + tl * TILEB + ((pc >> 3) * LS + (pc & 7) * 8) * 2) = R[tl][k];                     \
            }                                                                                                    \
        _Pragma("unroll") for (int k = 0; k < 2; ++k) *(u32x4*)(bp + 4 * TILEB + (at + 256 * k) * 16) = R[4][k]; \
        float* vl = (float*)(bp + 4 * TILEB + 8192);                                                             \
        if (at < 128) vl[at] = V;                                                                                \
        if (at == 0) vl[128] = G;                                                                                \
    }
            GDN_LOAD(ra, va, ga, 0)
            GDN_LOAD(rb, vb_, gb, 1)
            GDN_LOAD(rc, vc_, gc, 2)
            GDN_FILL(ra, va, ga, 0)
            GDN_LOAD(ra, va, ga, 3)
            LDS_BARRIER();
            for (int ci = 0; ci < 36; ci += 6) {
                GDN_FILL(rb, vb_, gb, 1)  if (ci + 4 < 36) GDN_LOAD(rb, vb_, gb, ci + 4)  LDS_BARRIER();
                GDN_FILL(rc, vc_, gc, 0)  if (ci + 5 < 36) GDN_LOAD(rc, vc_, gc, ci + 5)  LDS_BARRIER();
                GDN_FILL(ra, va, ga, 1)  if (ci + 6 < 36) GDN_LOAD(ra, va, ga, ci + 6)  LDS_BARRIER();
                GDN_FILL(rb, vb_, gb, 0)  if (ci + 7 < 36) GDN_LOAD(rb, vb_, gb, ci + 7)  LDS_BARRIER();
                GDN_FILL(rc, vc_, gc, 1)  if (ci + 8 < 36) GDN_LOAD(rc, vc_, gc, ci + 8)  LDS_BARRIER();
                if (ci + 6 < 36) GDN_FILL(ra, va, ga, 0)  if (ci + 9 < 36) GDN_LOAD(ra, va, ga, ci + 9)  LDS_BARRIER();
            }
#undef GDN_LOAD
#undef GDN_FILL
        } else {
            f32x4 S[4];
#pragma unroll
            for (int mt = 0; mt < 4; ++mt) S[mt] = (f32x4){0.f, 0.f, 0.f, 0.f};
            bf16x4 ost[4], onew[4];
#pragma unroll
            for (int mt = 0; mt < 4; ++mt) { ost[mt] = (bf16x4){0, 0, 0, 0}; onew[mt] = (bf16x4){0, 0, 0, 0}; }
            size_t orow = 0;
            bool ohave = false;
            if (__builtin_amdgcn_readfirstlane(wave) < 4) __builtin_amdgcn_s_setprio(3);
            LDS_BARRIER();
            for (int ci = 0; ci < 36; ++ci) {
                if (ohave) {
#pragma unroll
                    for (int mt = 0; mt < 4; ++mt)
                        *(bf16x4*)(U + (orow + 16 * mt + li) * INW + C_GQ + dir * 256 + h * 64 + 16 * sl + 4 * g) = ost[mt];
                }
                const ChunkInfo c = chunk_info<64>(ci, dir, b);
                const bool need_o = !c.isctx || with_ctx;
                const char* bp = smem + (ci & 1) * BUFB;
                const bf16_t* WD = (const bf16_t*)bp;
                const bf16_t* AT = WD + 64 * LS;
                const bf16_t* KT = AT + 64 * LS;
                const bf16_t* QQ = KT + 64 * LS;
                const bf16_t* UVl = QQ + 64 * LS;
                const float* eG = (const float*)(bp + 4 * TILEB + 8192);
                const float* eT = eG + 64;
                const float gt = eG[128];
                u32x2 uvw[4];
                bf16x8 wa[4][2], ka[4][2];
                f32x4 e0[2], e1[2];
#pragma unroll
                for (int mt = 0; mt < 4; ++mt) {
                    uvw[mt] = *(const u32x2*)(UVl + ((mt * 4 + sl) * 64 + lane) * 4);
#pragma unroll
                    for (int s = 0; s < 2; ++s) {
                        wa[mt][s] = *(const bf16x8*)(WD + (16 * mt + li) * LS + 32 * s + 8 * g);
                    }
                }
#pragma unroll
                for (int s = 0; s < 2; ++s) { e0[s] = *(const f32x4*)(eT + 32 * s + 4 * g); e1[s] = *(const f32x4*)(eT + 32 * s + 16 + 4 * g); }
                bf16x8 sf[2];
#pragma unroll
                for (int s = 0; s < 2; ++s) sf[s] = pack8(S[2 * s], S[2 * s + 1]);
                __builtin_amdgcn_sched_barrier(0);
                f32x4 vn[4];
#pragma unroll
                for (int mt = 0; mt < 4; ++mt) {
                    vn[mt] = (f32x4){lo16(uvw[mt][0]), hi16(uvw[mt][0]), lo16(uvw[mt][1]), hi16(uvw[mt][1])};
#pragma unroll
                    for (int s = 0; s < 2; ++s) vn[mt] = MFMA32(wa[mt][s], sf[s], vn[mt]);
                }
#pragma unroll
                for (int mt = 0; mt < 4; ++mt)
#pragma unroll
                    for (int s = 0; s < 2; ++s)
                        ka[mt][s] = *(const bf16x8*)(KT + (16 * mt + li) * LS + 32 * s + 8 * g);
                bf16x8 qa[4][2], aa[4][2];
                float eGc[4];
                if (need_o) {
#pragma unroll
                    for (int mt = 0; mt < 4; ++mt) {
                        eGc[mt] = eG[16 * mt + li];
#pragma unroll
                        for (int s = 0; s < 2; ++s) {
                            qa[mt][s] = *(const bf16x8*)(QQ + (16 * mt + li) * LS + 32 * s + 8 * g);
                            aa[mt][s] = *(const bf16x8*)(AT + (16 * mt + li) * LS + 32 * s + 8 * g);
                        }
                    }
                }
                __builtin_amdgcn_sched_barrier(0);
                bf16x8 vf[2], vsf[2];
#pragma unroll
                for (int s = 0; s < 2; ++s) {
                    vf[s] = pack8(vn[2 * s], vn[2 * s + 1]);
                    vsf[s] = pack8(vn[2 * s] * e0[s], vn[2 * s + 1] * e1[s]);
                }
#pragma unroll
                for (int mt = 0; mt < 4; ++mt) {
                    f32x4 acc = S[mt] * gt;
#pragma unroll
                    for (int s = 0; s < 2; ++s) acc = MFMA32(ka[mt][s], vsf[s], acc);
                    S[mt] = acc;
                }
                ohave = need_o;
                if (need_o) {
                    orow = c.rowbase + c.t0;
#pragma unroll
                    for (int mt = 0; mt < 4; ++mt) {
                        f32x4 acc = {0.f, 0.f, 0.f, 0.f};
#pragma unroll
                        for (int s = 0; s < 2; ++s) acc = MFMA32(sf[s], qa[mt][s], acc);
                        acc = acc * eGc[mt];
#pragma unroll
                        for (int s = 0; s < 2; ++s) acc = MFMA32(vf[s], aa[mt][s], acc);
                        onew[mt] = pack4(acc);
                    }
                }
                asm volatile("" :: "v"(ost[0]), "v"(ost[1]), "v"(ost[2]), "v"(ost[3]));
#pragma unroll
                for (int mt = 0; mt < 4; ++mt) ost[mt] = onew[mt];
                LDS_BARRIER();
            }
            if (ohave) {
#pragma unroll
                for (int mt = 0; mt < 4; ++mt)
                    *(bf16x4*)(U + (orow + 16 * mt + li) * INW + C_GQ + dir * 256 + h * 64 + 16 * sl + 4 * g) = ost[mt];
            }
        }
#undef GDN_GI
        __builtin_amdgcn_s_setprio(0);
        LDS_BARRIER();
    }
}

__device__ void phase_swa_mfma(const Params& p, int l, char* smem, int vb, int nvb, int pend, int oz) {
    constexpr int LS = 72;
    const int hb = (int)((threadIdx.x + oz) >> 8);
    smem += hb * (2 * 64 * LS * 2);
    bf16_t* Kl = (bf16_t*)smem;
    bf16_t* Vl = Kl + 64 * LS;
    bf16_t* U = (bf16_t*)(p.ws + OFF_U);
    const int tid = (threadIdx.x + oz) & 255, lane = tid & 63, wave = tid >> 6, g = lane >> 4, li = lane & 15;
    const int q4 = li >> 2, p4 = li & 3;
    const int fr = tid >> 2, fj = tid & 3;
    const bool with_ctx = l < 3;
    const int nlat = 8 * 2 * 32, nctx = with_ctx ? 8 * 2 * 4 : 0;
    float invq[8], invk[8];
#pragma unroll
    for (int j = 0; j < 8; ++j) {
        invq[j] = expf(-(float)((8 * g + j) & 15) * (9.210340371976184f / 16.f)) * 0.15915494309189535f;
        invk[j] = expf(-(float)((8 * fj + j) & 15) * (9.210340371976184f / 16.f)) * 0.15915494309189535f;
    }
    for (int pair = vb; pair < pend; pair += nvb) {
        const int it = 2 * pair + hb;
        const bool cq = it >= nlat;
        const int id = cq ? it - nlat : it;
        int qt, kvh, b;
        if (!cq) { qt = id & 31; kvh = (id >> 5) & 1; b = id >> 6; }
        else     { qt = id & 3;  kvh = (id >> 2) & 1; b = id >> 3; }
        const int hq = kvh * 2 + (wave >> 1), qsub = wave & 1;
        const size_t qbase = cq ? (size_t)LAT + (size_t)b * LC : (size_t)b * T;
        bf16x8 qf[2][2];
#pragma unroll
        for (int qt2 = 0; qt2 < 2; ++qt2) {
            const int tq = qt * 64 + 32 * qsub + 16 * qt2 + li;
            const bf16_t* qp = U + (qbase + tq) * INW + C_SQ + hq * 64 + 8 * g;
            const u32x4 r0 = *(const u32x4*)qp, r1 = *(const u32x4*)(qp + 32);
            float x1[8], x2[8];
#pragma unroll
            for (int w = 0; w < 4; ++w) {
                x1[2 * w] = lo16(r0[w]); x1[2 * w + 1] = hi16(r0[w]);
                x2[2 * w] = lo16(r1[w]); x2[2 * w + 1] = hi16(r1[w]);
            }
            if (!cq) {
                const float pos = (g < 2) ? (float)(tq >> 6) : (float)(tq & 63);
#pragma unroll
                for (int j = 0; j < 8; ++j) {
                    float rev = pos * invq[j];
                    rev -= floorf(rev);
                    const float cs = __builtin_amdgcn_cosf(rev), sn = __builtin_amdgcn_sinf(rev);
                    const float a1 = x1[j], a2 = x2[j];
                    x1[j] = a1 * cs - a2 * sn;
                    x2[j] = a1 * sn + a2 * cs;
                }
            }
            u32x4 o1, o2;
#pragma unroll
            for (int w = 0; w < 4; ++w) {
                o1[w] = cvt_pk(x1[2 * w] * 0.125f, x1[2 * w + 1] * 0.125f);
                o2[w] = cvt_pk(x2[2 * w] * 0.125f, x2[2 * w + 1] * 0.125f);
            }
            qf[qt2][0] = __builtin_bit_cast(bf16x8, o1);
            qf[qt2][1] = __builtin_bit_cast(bf16x8, o2);
        }
        float m[2] = {-1e30f, -1e30f}, lsum[2] = {0.f, 0.f};
        f32x4 O[4][2];
#pragma unroll
        for (int dt = 0; dt < 4; ++dt)
#pragma unroll
            for (int qt2 = 0; qt2 < 2; ++qt2) O[dt][qt2] = (f32x4){0.f, 0.f, 0.f, 0.f};
        const int nloc = cq ? 0 : 5;
        u32x4 pk0, pk1, pv0, pv1;
#define SWA_TILE(ti_, kctx_, ktile_, oob_)                                                      \
        const bool kctx_ = (ti_) >= nloc;                                                       \
        int ktile_ = kctx_ ? (ti_) - nloc : qt + (((ti_) == 0) ? 0 : ((ti_) == 1) ? -1 : ((ti_) == 2) ? 1 : ((ti_) == 3) ? -2 : 2); \
        const bool oob_ = !kctx_ && (ktile_ < 0 || ktile_ >= 32);                               \
        ktile_ = oob_ ? qt : ktile_;
#define SWA_PREFETCH(ti_)                                                                       \
        {                                                                                       \
            SWA_TILE((ti_), kc_, kt_, ob_)                                                      \
            const int tk_ = kt_ * 64 + fr;                                                      \
            const size_t krow_ = kc_ ? (size_t)LAT + (size_t)b * LC + tk_ : (size_t)b * T + tk_; \
            const bf16_t* kp_ = U + krow_ * INW + C_SK + kvh * 64 + 8 * fj;                     \
            const bf16_t* vp_ = U + krow_ * INW + C_SV + kvh * 64 + 8 * fj;                     \
            pk0 = *(const u32x4*)kp_; pk1 = *(const u32x4*)(kp_ + 32);                          \
            pv0 = *(const u32x4*)vp_; pv1 = *(const u32x4*)(vp_ + 32);                          \
        }
        SWA_PREFETCH(0)
        for (int ti = 0; ti < nloc + 4; ++ti) {
            SWA_TILE(ti, kctx, ktile, oob)
            const bool edge = !kctx && (ti >= 3 || oob);
            __syncthreads();
            {
                const int tk = ktile * 64 + fr;
                const u32x4 k0 = pk0, k1 = pk1, v0 = pv0, v1 = pv1;
                u32x4 o1 = k0, o2 = k1;
                if (!kctx) {
                    const float pos = (fj < 2) ? (float)(tk >> 6) : (float)(tk & 63);
                    float x1[8], x2[8];
#pragma unroll
                    for (int w = 0; w < 4; ++w) {
                        x1[2 * w] = lo16(k0[w]); x1[2 * w + 1] = hi16(k0[w]);
                        x2[2 * w] = lo16(k1[w]); x2[2 * w + 1] = hi16(k1[w]);
                    }
#pragma unroll
                    for (int j = 0; j < 8; ++j) {
                        float rev = pos * invk[j];
                        rev -= floorf(rev);
                        const float cs = __builtin_amdgcn_cosf(rev), sn = __builtin_amdgcn_sinf(rev);
                        const float a1 = x1[j], a2 = x2[j];
                        x1[j] = a1 * cs - a2 * sn;
                        x2[j] = a1 * sn + a2 * cs;
                    }
#pragma unroll
                    for (int w = 0; w < 4; ++w) {
                        o1[w] = cvt_pk(x1[2 * w], x1[2 * w + 1]);
                        o2[w] = cvt_pk(x2[2 * w], x2[2 * w + 1]);
                    }
                }
                *(u32x4*)(Kl + fr * LS + 8 * fj) = o1;
                *(u32x4*)(Kl + fr * LS + 32 + 8 * fj) = o2;
                *(u32x4*)(Vl + fr * LS + 8 * fj) = v0;
                *(u32x4*)(Vl + fr * LS + 32 + 8 * fj) = v1;
            }
            __syncthreads();
            if (ti + 1 < nloc + 4) SWA_PREFETCH(ti + 1)
            f32x4 st[4][2];
#pragma unroll
            for (int km = 0; km < 4; ++km) {
                bf16x8 ka[2];
#pragma unroll
                for (int ks = 0; ks < 2; ++ks) ka[ks] = *(const bf16x8*)(Kl + (16 * km + li) * LS + 32 * ks + 8 * g);
#pragma unroll
                for (int qt2 = 0; qt2 < 2; ++qt2) {
                    f32x4 acc = {0.f, 0.f, 0.f, 0.f};
#pragma unroll
                    for (int ks = 0; ks < 2; ++ks) acc = MFMA32(ka[ks], qf[qt2][ks], acc);
                    st[km][qt2] = acc;
                }
            }
            if (edge) {
#pragma unroll
                for (int qt2 = 0; qt2 < 2; ++qt2) {
                    const int tq = qt * 64 + 32 * qsub + 16 * qt2 + li;
#pragma unroll
                    for (int km = 0; km < 4; ++km)
#pragma unroll
                        for (int r = 0; r < 4; ++r) {
                            int dlt = ktile * 64 + 16 * km + 4 * g + r - tq;
                            dlt = dlt < 0 ? -dlt : dlt;
                            st[km][qt2][r] = (dlt <= 128 && !oob) ? st[km][qt2][r] : -1e30f;
                        }
                }
            }
            bf16x8 pf[2][2];
#pragma unroll
            for (int qt2 = 0; qt2 < 2; ++qt2) {
                float mx = st[0][qt2][0];
#pragma unroll
                for (int km = 0; km < 4; ++km)
#pragma unroll
                    for (int r = 0; r < 4; ++r) mx = fmaxf(mx, st[km][qt2][r]);
                mx = fmaxf(mx, __shfl_xor(mx, 16));
                mx = fmaxf(mx, __shfl_xor(mx, 32));
                const float mn = fmaxf(m[qt2], mx);
                const float sc = fexp(m[qt2] - mn);
                m[qt2] = mn;
                float ps = 0.f;
#pragma unroll
                for (int km = 0; km < 4; ++km)
#pragma unroll
                    for (int r = 0; r < 4; ++r) {
                        const float pv = fexp(st[km][qt2][r] - mn);
                        st[km][qt2][r] = pv;
                        ps += pv;
                    }
                lsum[qt2] = lsum[qt2] * sc + ps;
#pragma unroll
                for (int dt = 0; dt < 4; ++dt) O[dt][qt2] = O[dt][qt2] * sc;
                pf[qt2][0] = pack8(st[0][qt2], st[1][qt2]);
                pf[qt2][1] = pack8(st[2][qt2], st[3][qt2]);
            }
#pragma unroll
            for (int dt = 0; dt < 4; ++dt)
#pragma unroll
                for (int ks = 0; ks < 2; ++ks) {
                    const bf16x8 va = cat8(lds_tr(Vl + (32 * ks + 4 * g + q4) * LS + 16 * dt + 4 * p4),
                                           lds_tr(Vl + (32 * ks + 16 + 4 * g + q4) * LS + 16 * dt + 4 * p4));
#pragma unroll
                    for (int qt2 = 0; qt2 < 2; ++qt2) O[dt][qt2] = MFMA32(va, pf[qt2][ks], O[dt][qt2]);
                }
        }
#undef SWA_TILE
#undef SWA_PREFETCH
        const float snk = p.in[I_SINK][l * 4 + hq];
#pragma unroll
        for (int qt2 = 0; qt2 < 2; ++qt2) {
            float ls = lsum[qt2];
            ls += __shfl_xor(ls, 16);
            ls += __shfl_xor(ls, 32);
            const float mn = fmaxf(m[qt2], snk);
            const float s1 = fexp(m[qt2] - mn);
            const float inv = s1 / (ls * s1 + fexp(snk - mn));
            const int tq = qt * 64 + 32 * qsub + 16 * qt2 + li;
            bf16_t* zp = U + (qbase + tq) * INW + C_SZ + hq * 64 + 4 * g;
#pragma unroll
            for (int dt = 0; dt < 4; ++dt) {
                const u32x2 zv = *(const u32x2*)(zp + 16 * dt);
                u32x2 yv;
                yv[0] = cvt_pk(O[dt][qt2][0] * inv * siluf_(lo16(zv[0])), O[dt][qt2][1] * inv * siluf_(hi16(zv[0])));
                yv[1] = cvt_pk(O[dt][qt2][2] * inv * siluf_(lo16(zv[1])), O[dt][qt2][3] * inv * siluf_(hi16(zv[1])));
                *(u32x2*)(zp + 16 * dt) = yv;
            }
        }
    }
}


__device__ void phase_finish(const Params& p, int l, char* smem, int vb, int nvb, int oz) {
    bf16_t* U = (bf16_t*)(p.ws + OFF_U);
    const bf16_t* PF = (const bf16_t*)(p.ws + OFF_P);
    const int tid = threadIdx.x + oz, lane = tid & 63, wave = tid >> 6;
    const int nrows = (l < 3) ? NROW : LAT;
    const int per = (nrows + nvb * 8 - 1) / (nvb * 8);
    const int rbeg = (vb * 8 + wave) * per, rend = (rbeg + per < nrows) ? rbeg + per : nrows;
    if (rbeg >= nrows) return;
    const float4 ng = *(const float4*)(p.in[I_GNG] + l * 64 + (lane & 15) * 4);
    u32x2 nl[6];
#define F_LOAD(row_)                                                               \
    {                                                                              \
        const size_t r_ = (size_t)(row_);                                          \
        const bf16_t* ur_ = U + r_ * INW;                                          \
        nl[0] = *(const u32x2*)(PF + SZ_T + r_ * 256 + lane * 4);                  \
        nl[1] = *(const u32x2*)(PF + SZ_T / 2 * 3 + r_ * 256 + lane * 4);          \
        nl[2] = *(const u32x2*)(ur_ + C_GQ + lane * 4);                            \
        nl[3] = *(const u32x2*)(ur_ + C_GQ + 256 + lane * 4);                      \
        nl[4] = *(const u32x2*)(ur_ + C_GZ + lane * 4);                            \
        nl[5] = *(const u32x2*)(ur_ + C_RZ + lane * 4);                            \
    }
    F_LOAD(rbeg)
    for (int row = rbeg; row < rend; ++row) {
        bf16_t* ur = U + (size_t)row * INW;
        const u32x2 rf = nl[0], rb = nl[1], gf = nl[2], gb = nl[3], zg = nl[4], zr = nl[5];
        if (row + 1 < rend) F_LOAD(row + 1)
        {
            const float o0 = lo16(gf[0]) + lo16(gb[0]), o1 = hi16(gf[0]) + hi16(gb[0]);
            const float o2 = lo16(gf[1]) + lo16(gb[1]), o3 = hi16(gf[1]) + hi16(gb[1]);
            float ss = o0 * o0 + o1 * o1 + o2 * o2 + o3 * o3;
            ss += __shfl_xor(ss, 1); ss += __shfl_xor(ss, 2); ss += __shfl_xor(ss, 4); ss += __shfl_xor(ss, 8);
            const float rs = rsqrtf(ss * (1.f / 64.f) + EPS);
            u32x2 y;
            y[0] = cvt_pk(o0 * rs * ng.x * siluf_(lo16(zg[0])), o1 * rs * ng.y * siluf_(hi16(zg[0])));
            y[1] = cvt_pk(o2 * rs * ng.z * siluf_(lo16(zg[1])), o3 * rs * ng.w * siluf_(hi16(zg[1])));
            *(u32x2*)(ur + C_GZ + lane * 4) = y;
        }
        {
            const float o0 = lo16(rf[0]) + lo16(rb[0]), o1 = hi16(rf[0]) + hi16(rb[0]);
            const float o2 = lo16(rf[1]) + lo16(rb[1]), o3 = hi16(rf[1]) + hi16(rb[1]);
            float s1 = o0 + o1 + o2 + o3;
            s1 += __shfl_xor(s1, 1); s1 += __shfl_xor(s1, 2); s1 += __shfl_xor(s1, 4); s1 += __shfl_xor(s1, 8);
            const float mu = s1 * (1.f / 64.f);
            const float d0 = o0 - mu, d1 = o1 - mu, d2 = o2 - mu, d3 = o3 - mu;
            float s2 = d0 * d0 + d1 * d1 + d2 * d2 + d3 * d3;
            s2 += __shfl_xor(s2, 1); s2 += __shfl_xor(s2, 2); s2 += __shfl_xor(s2, 4); s2 += __shfl_xor(s2, 8);
            const float rs = rsqrtf(s2 * (1.f / 64.f) + EPS);
            u32x2 y;
            y[0] = cvt_pk(d0 * rs * siluf_(lo16(zr[0])), d1 * rs * siluf_(hi16(zr[0])));
            y[1] = cvt_pk(d2 * rs * siluf_(lo16(zr[1])), d3 * rs * siluf_(hi16(zr[1])));
            *(u32x2*)(ur + C_RZ + lane * 4) = y;
        }
    }
#undef F_LOAD
}

#include <hip/hip_cooperative_groups.h>
namespace cg = cooperative_groups;


#define XB_TMO      128
#define XB_XCNT(j)  (256  + 64 * (j))
#define XB_XSUB(j)  (1280 + 64 * (j))
#define XB_XGEN(j)  (2304 + 64 * (j))
#define XB_TOP      3328
#define XB_TOPGEN   3392
#define XCD_BAR_WORDS 3456
#define XB_SPIN_CAP (1u << 18)
#define XB_LAS __attribute__((address_space(3)))
constexpr size_t OFF_BAR = 450560;
static_assert(OFF_BAR + XCD_BAR_WORDS * 4 <= OFF_WINT && OFF_BAR >= 4 * 9 * 3072 * 4, "barrier words placement");
__device__ __forceinline__ unsigned xb_ld(unsigned* p)              { return __hip_atomic_load(p, __ATOMIC_RELAXED, __HIP_MEMORY_SCOPE_AGENT); }
__device__ __forceinline__ unsigned xb_add(unsigned* p, unsigned v) { return __hip_atomic_fetch_add(p, v, __ATOMIC_RELAXED, __HIP_MEMORY_SCOPE_AGENT); }
__device__ __forceinline__ unsigned xb_xcc_id() { return (unsigned)__builtin_amdgcn_s_getreg((3 << 11) | 20) & 0xFu; }
#define XB_SPIN(cond, bar) do { unsigned _sp = 0; while (cond) { __builtin_amdgcn_s_sleep(1); \
    if ((++_sp & 255u) == 0u) { if (xb_ld(&(bar)[XB_TMO])) break; if (_sp > XB_SPIN_CAP) { atomicAdd(&(bar)[XB_TMO], 1u); break; } } } } while (0)
struct XcdBarrier { unsigned* bar; unsigned x; volatile XB_LAS unsigned* st; };
__device__ __forceinline__ XcdBarrier xcd_barrier_post(unsigned* bar, volatile XB_LAS unsigned* st) {
    XcdBarrier b; b.bar = bar; b.x = xb_xcc_id(); b.st = st;
    if (threadIdx.x == 0) (void)xb_add(&bar[XB_XCNT(b.x)], 1u);
    return b;
}
__device__ __forceinline__ void xcd_barrier_complete(unsigned* bar, unsigned x, unsigned& nloc, unsigned& nx) {
    const unsigned G = gridDim.x * gridDim.y * gridDim.z;
    unsigned sum, cnt, mine, sp = 0u;
    for (;;) {
        sum = 0u; cnt = 0u; mine = 0u;
#pragma unroll
        for (unsigned j = 0; j < 16; ++j) { const unsigned c = xb_ld(&bar[XB_XCNT(j)]); sum += c; cnt += (c > 0u) ? 1u : 0u; mine = (j == x) ? c : mine; }
        if (sum == G) break;
        __builtin_amdgcn_s_sleep(1);
        if ((++sp & 255u) == 0u) { if (xb_ld(&bar[XB_TMO])) break; if (sp > XB_SPIN_CAP) { atomicAdd(&bar[XB_TMO], 1u); break; } }
    }
    nloc = mine > 0u ? mine : 1u; nx = cnt > 0u ? cnt : 1u;
}
__device__ __forceinline__ void xcd_barrier(const XcdBarrier& b) {
    asm volatile("s_waitcnt vmcnt(0)" ::: "memory");
    __syncthreads();
    if (threadIdx.x == 0) {
        unsigned* bar = b.bar;
        __builtin_amdgcn_s_waitcnt(0);
        unsigned nloc = b.st[0], nx = b.st[1];
        if (nloc == 0u) { xcd_barrier_complete(bar, b.x, nloc, nx); b.st[0] = nloc; b.st[1] = nx; }
        const unsigned old = xb_add(&bar[XB_XSUB(b.x)], 1u);
        const unsigned gen = old / nloc;
        if (old + 1u == (gen + 1u) * nloc) {
            __builtin_amdgcn_fence(__ATOMIC_RELEASE, "agent");
            asm volatile("s_waitcnt vmcnt(0)" ::: "memory");
            const unsigned og = xb_add(&bar[XB_TOP], 1u);
            const unsigned tg = og / nx;
            if (og + 1u == (tg + 1u) * nx) xb_add(&bar[XB_TOPGEN], 1u);
            else XB_SPIN(xb_ld(&bar[XB_TOPGEN]) == tg, bar);
            __builtin_amdgcn_fence(__ATOMIC_ACQUIRE, "agent");
            xb_add(&bar[XB_XGEN(b.x)], 1u);
            asm volatile("s_waitcnt vmcnt(0)" ::: "memory");
        } else {
            XB_SPIN(xb_ld(&bar[XB_XGEN(b.x)]) == gen, bar);
            __builtin_amdgcn_fence(__ATOMIC_ACQUIRE, "agent");
            asm volatile("s_waitcnt vmcnt(0)" ::: "memory");
        }
    }
    __syncthreads();
}

constexpr int SMEM_BYTES = 128 * 1024 + 16;

__global__ void __launch_bounds__(NT) fwd_megakernel(Params p) {
    extern __shared__ __attribute__((aligned(16))) char smem[];
    cg::grid_group grid = cg::this_grid();
    const int nvb = gridDim.x;
    volatile XB_LAS unsigned* xst = (volatile XB_LAS unsigned*)(smem + 128 * 1024);
    if (threadIdx.x == 0) { xst[0] = 0u; xst[1] = 0u; }
    __syncthreads();
    const XcdBarrier xb = xcd_barrier_post((unsigned*)(p.ws + OFF_BAR), xst);
    phase_prep(p, smem, blockIdx.x, nvb, 0);
    grid.sync();
    for (int l = 0; l < 4; ++l) {
        int oz = 0, vb = blockIdx.x;
        asm volatile("" : "+v"(oz));
        asm volatile("" : "+s"(vb));
        phase_E_rows(p, l, smem, vb, nvb, oz);
        xcd_barrier(xb);
        g8::gemm_phase<false>(p, l, smem, vb, nvb);
        xcd_barrier(xb);
        {
            const int cls = (vb < 32) ? 0 : (vb < 128) ? 1 : 2;
            const int nsw = (l < 3) ? 288 : 256;
            const int s0 = (cls == 0) ? 2 * vb : 64 + (vb - 32), s1 = (cls == 0) ? s0 + 2 : s0 + 1;
            phase_swa_mfma(p, l, smem, s0, 1, (s1 < nsw) ? s1 : nsw, oz);
            __syncthreads();
            const int g0 = (cls == 0) ? vb : (cls == 1) ? 32 + 3 * (vb - 32) : 320 + 2 * (vb - 128);
            const int g1 = g0 + ((cls == 0) ? 1 : (cls == 1) ? 3 : 2);
            phase_gdn_prep(p, l, smem, g0, 1, g1, oz);
            __syncthreads();
            const int n = vb & 3, j = vb >> 2;
            int m0, mc;
            if (j < 8) { m0 = 4 * j; mc = 4; }
            else if (j < 32) { m0 = 32 + 2 * (j - 8); mc = 2; }
            else if (j < 48) { m0 = 80 + 7 * (j - 32); mc = 7; }
            else { m0 = 192 + 6 * (j - 48); mc = 6; }
            lru_loop<0>(p, l, smem, n + 4 * m0, n + 4 * (m0 + mc), 4, false, oz);
        }
        xcd_barrier(xb);
        if (vb < 64) phase_gdn_chain(p, l, smem, vb, 64, oz);
        else if (vb < 128) phase_ret_chain(p, l, smem, vb - 64, 64, oz);
        else {
            lru_loop<1>(p, l, smem, vb - 128, (l < 3) ? 1152 : 1024, nvb - 128, l == 3, oz);
            __syncthreads();
            if (l < 3) for (int id = vb - 128; id < WCONV_TILES; id += nvb - 128) wconv_tile(p, l + 1, id, smem, oz);
        }
        xcd_barrier(xb);
        phase_finish(p, l, smem, vb, nvb, oz);
        xcd_barrier(xb);
        g8::gemm_phase<true>(p, l, smem, vb, nvb);
        xcd_barrier(xb);
    }
    {
        int oz = 0, vb = blockIdx.x;
        asm volatile("" : "+v"(oz));
        asm volatile("" : "+s"(vb));
        phase_E_rows(p, 4, smem, vb, nvb, oz);
    }
}

extern "C" void kernel_launch(void* const* d_in, const int* in_sizes, int n_in, void* d_out, int out_size, void* d_ws,
                              size_t ws_size, hipStream_t stream) {
    static int grid_blocks = 0;
    if (grid_blocks == 0) {
        if (n_in != 23 || ws_size < WS_END) {
            fprintf(stderr, "kernel_launch: unexpected n_in %d or ws_size %zu (< %zu)\n", n_in, ws_size, (size_t)WS_END);
            grid_blocks = -1;
            return;
        }
        int dev = 0, cus = 0, per_cu = 0;
        (void)hipGetDevice(&dev);
        (void)hipDeviceGetAttribute(&cus, hipDeviceAttributeMultiprocessorCount, dev);
        (void)hipFuncSetAttribute((const void*)fwd_megakernel, hipFuncAttributeMaxDynamicSharedMemorySize, SMEM_BYTES);
        (void)hipOccupancyMaxActiveBlocksPerMultiprocessor(&per_cu, fwd_megakernel, NT, SMEM_BYTES);
        if (per_cu < 1) per_cu = 1;
        if (per_cu > 1) per_cu = 1;
        grid_blocks = cus * per_cu;
        fprintf(stderr, "kernel_launch: cus %d per_cu %d grid %d\n", cus, per_cu, grid_blocks);
    }
    if (grid_blocks < 0) return;
    Params p{};
    for (int i = 0; i < 23; ++i) p.in[i] = (const float*)d_in[i];
    p.out = (float*)d_out;
    p.ws = (unsigned char*)d_ws;
    (void)hipMemsetAsync((unsigned char*)d_ws + OFF_BAR, 0, XCD_BAR_WORDS * 4, stream);
    void* args[] = {&p};
    hipError_t e = hipLaunchCooperativeKernel((void*)fwd_megakernel, dim3(grid_blocks), dim3(NT), args, SMEM_BYTES, stream);
    if (e != hipSuccess) fprintf(stderr, "cooperative launch failed: %s (grid %d)\n", hipGetErrorString(e), grid_blocks);
}
```

```cpp
#include <hip/hip_runtime.h>
#include <hip/hip_bf16.h>
#include <cstdio>
#include <cstdint>

typedef unsigned short bf16_t;
typedef __attribute__((ext_vector_type(8))) short bf16x8;
typedef __attribute__((ext_vector_type(4))) float f32x4;
typedef __attribute__((ext_vector_type(4))) short bf16x4;
typedef __attribute__((ext_vector_type(4))) unsigned u32x4;
typedef __attribute__((ext_vector_type(2))) unsigned u32x2;
typedef __attribute__((ext_vector_type(2))) float f32x2;
typedef __attribute__((ext_vector_type(2))) __bf16 bf16v2;

#define NT 512
#define CTX_SPLIT 1
#define PROBE_K 4
constexpr int Bsz = 8, T = 2048, LC = 256, DM = 1024, INW = 3344, NPAD = 3584;
constexpr int LAT = Bsz * T, NROW = LAT + Bsz * LC;
constexpr int C_LRUX = 0, C_LRUZ = 256, C_GQ = 512, C_GZ = 1280, C_GA = 1536, C_GB = 1544;
constexpr int C_RQ = 1552, C_RK = 1808, C_RV = 2064, C_RZ = 2320, C_SQ = 2576, C_SK = 2832, C_SV = 2960, C_SZ = 3088;
constexpr float EPS = 1e-6f;

enum { I_X = 0, I_C, I_CTX, I_CCTX, I_WMOD, I_BMOD, I_PREG, I_POSTG, I_WIN, I_WOUT, I_LCW, I_LCB, I_LWR, I_LBR, I_LWI, I_LBI,
       I_LLAM, I_GCW, I_GALOG, I_GDT, I_GNG, I_RDEC, I_SINK };

constexpr int GI = 8 * 4 * 36;
constexpr size_t OFF_MOD = 0;
constexpr size_t OFF_WINT = 1u << 19;
constexpr size_t SZ_WINT = (size_t)NPAD * DM * 2;
constexpr size_t OFF_WOUTT = OFF_WINT + SZ_WINT;
constexpr size_t SZ_WOUTT = (size_t)DM * DM * 2;
constexpr size_t OFF_U = OFF_WOUTT + 2 * SZ_WOUTT;
constexpr size_t SZ_U = (size_t)NROW * INW * 2;
constexpr size_t OFF_P = OFF_U + SZ_U;
constexpr size_t SZ_P = (size_t)NROW * DM * 2;
constexpr size_t OFF_XC = OFF_P + SZ_P;
constexpr size_t SZ_XC = (size_t)Bsz * LC * DM * 4;
constexpr size_t SZ_GT = (size_t)GI * 4096 * 2;
constexpr size_t OFF_GQ = OFF_XC + SZ_XC;
constexpr size_t OFF_GKT = OFF_GQ + SZ_GT;
constexpr size_t OFF_GWD = OFF_GKT + SZ_GT;
constexpr size_t OFF_GUV = OFF_GWD + 2 * SZ_GT;
constexpr size_t OFF_GATT = OFF_GUV + 2 * SZ_GT;
constexpr size_t OFF_GVEC = OFF_GATT + 2 * SZ_GT;
constexpr size_t OFF_AGG = OFF_GVEC + (size_t)2 * GI * 256 * 4;
constexpr size_t WS_END = OFF_AGG + (size_t)8 * 2 * 36 * 256 * 8;
constexpr size_t SZ_T = (size_t)NROW * 256 * 2;
static_assert(4 * SZ_T <= SZ_P, "chain outputs must fit in P");

struct Params {
    const float* in[23];
    float* out;
    unsigned char* ws;
};

__device__ __forceinline__ float bf2f(bf16_t v) { return __uint_as_float(((unsigned)v) << 16); }
__device__ __forceinline__ bf16_t f2bf(float f) {
    unsigned u = __float_as_uint(f);
    u += 0x7fffu + ((u >> 16) & 1u);
    return (bf16_t)(u >> 16);
}
__device__ __forceinline__ float fexp(float x) { return __builtin_amdgcn_exp2f(x * 1.4426950408889634f); }
__device__ __forceinline__ float fexp2(float x) { return __builtin_amdgcn_exp2f(x); }
__device__ __forceinline__ float sigmoidf_(float x) { return __builtin_amdgcn_rcpf(1.f + fexp(-x)); }
__device__ __forceinline__ float siluf_(float x) { return x * __builtin_amdgcn_rcpf(1.f + fexp(-x)); }
__device__ __forceinline__ float softplusf_(float x) { return x > 20.f ? x : log1pf(fexp(x)); }
__device__ __forceinline__ float wave_sum(float v) {
#pragma unroll
    for (int o = 32; o >= 1; o >>= 1) v += __shfl_xor(v, o);
    return v;
}
#define LDS_BARRIER() asm volatile("s_waitcnt lgkmcnt(0)\n\ts_barrier" ::: "memory")
#define MFMA32(a, b, c) __builtin_amdgcn_mfma_f32_16x16x32_bf16((a), (b), (c), 0, 0, 0)
#define MFMA16(a, b, c) __builtin_amdgcn_mfma_f32_16x16x16bf16_1k((a), (b), (c), 0, 0, 0)
__device__ __forceinline__ unsigned cvt_pk(float lo, float hi) {
    const f32x2 v = {lo, hi};
    const bf16v2 b = __builtin_convertvector(v, bf16v2);
    return __builtin_bit_cast(unsigned, b);
}
__device__ __forceinline__ bf16x8 pack8(f32x4 a, f32x4 b) {
    u32x4 u = {cvt_pk(a[0], a[1]), cvt_pk(a[2], a[3]), cvt_pk(b[0], b[1]), cvt_pk(b[2], b[3])};
    return __builtin_bit_cast(bf16x8, u);
}
__device__ __forceinline__ bf16x4 pack4(f32x4 a) {
    u32x2 u = {cvt_pk(a[0], a[1]), cvt_pk(a[2], a[3])};
    return __builtin_bit_cast(bf16x4, u);
}
__device__ __forceinline__ bf16x8 cat8(bf16x4 a, bf16x4 b) { return __builtin_shufflevector(a, b, 0, 1, 2, 3, 4, 5, 6, 7); }
__device__ __forceinline__ bf16x4 lds_tr(const bf16_t* p) {
    return __builtin_amdgcn_ds_read_tr16_b64_v4i16((__attribute__((address_space(3))) bf16x4*)p);
}
__device__ __forceinline__ int permcol(int x) { return (x & ~31) | (((x >> 2) & 3) << 3) | (((x >> 4) & 1) << 2) | (x & 3); }
__device__ __forceinline__ float lo16(unsigned u) { return __uint_as_float(u << 16); }
__device__ __forceinline__ float hi16(unsigned u) { return __uint_as_float(u & 0xffff0000u); }

#define XB_TMO      128
#define XB_XCNT(j)  (256  + 64 * (j))
#define XB_XSUB(j)  (1280 + 64 * (j))
#define XB_XGEN(j)  (2304 + 64 * (j))
#define XB_TOP      3328
#define XB_TOPGEN   3392
#define XCD_BAR_WORDS 3456
#define XB_SPIN_CAP (1u << 18)
#define XB_LAS __attribute__((address_space(3)))
constexpr size_t OFF_BAR = 450560;
static_assert(OFF_BAR + XCD_BAR_WORDS * 4 <= OFF_WINT && OFF_BAR >= 4 * 9 * 3072 * 4, "barrier words placement");
__device__ __forceinline__ unsigned xb_ld(unsigned* p)              { return __hip_atomic_load(p, __ATOMIC_RELAXED, __HIP_MEMORY_SCOPE_AGENT); }
__device__ __forceinline__ unsigned xb_add(unsigned* p, unsigned v) { return __hip_atomic_fetch_add(p, v, __ATOMIC_RELAXED, __HIP_MEMORY_SCOPE_AGENT); }
__device__ __forceinline__ unsigned xb_xcc_id() { return (unsigned)__builtin_amdgcn_s_getreg((3 << 11) | 20) & 0xFu; }
#define XB_SPIN(cond, bar) do { unsigned _sp = 0; while (cond) { __builtin_amdgcn_s_sleep(1); \
    if ((++_sp & 255u) == 0u) { if (xb_ld(&(bar)[XB_TMO])) break; if (_sp > XB_SPIN_CAP) { atomicAdd(&(bar)[XB_TMO], 1u); break; } } } } while (0)

__device__ void phase_prep_mod(const Params& p, char* smem, int it, int oz) {
    const int tid = (threadIdx.x + oz) & 511;
    float* mod = (float*)(p.ws + OFF_MOD);
    float* s = (float*)smem;
    float* red = s + 9 * 1024;
    const int l = it / 48, cgp = it % 48;
    {
        float cv[18];
#pragma unroll
        for (int j = 0; j < 18; ++j) {
            const int r = j >> 1, k = (j & 1) * 512 + tid;
            cv[j] = (r < 8) ? p.in[I_C][r * 1024 + k] : p.in[I_CCTX][k];
        }
#pragma unroll
        for (int j = 0; j < 18; ++j) s[(j >> 1) * 1024 + (j & 1) * 512 + tid] = siluf_(cv[j]);
    }
    __syncthreads();
    const int c4 = tid & 15, ks = tid >> 4;
    const float* w = p.in[I_WMOD] + (size_t)l * 1024 * 3072 + (size_t)(ks * 32) * 3072 + cgp * 64 + 4 * c4;
    f32x4 acc[9];
#pragma unroll
    for (int r = 0; r < 9; ++r) acc[r] = (f32x4){0.f, 0.f, 0.f, 0.f};
#pragma unroll
    for (int kb = 0; kb < 32; kb += 16) {
        f32x4 wv[16];
#pragma unroll
        for (int u = 0; u < 16; ++u) wv[u] = *(const f32x4*)(w + (size_t)(kb + u) * 3072);
#pragma unroll
        for (int u4 = 0; u4 < 4; ++u4)
#pragma unroll
            for (int r = 0; r < 9; ++r) {
                const f32x4 sv = *(const f32x4*)(s + r * 1024 + ks * 32 + kb + 4 * u4);
#pragma unroll
                for (int uu = 0; uu < 4; ++uu) acc[r] += wv[4 * u4 + uu] * sv[uu];
            }
    }
#pragma unroll
    for (int r = 0; r < 9; ++r) *(f32x4*)(red + (ks * 9 + r) * 64 + 4 * c4) = acc[r];
    __syncthreads();
    for (int i = tid; i < 9 * 64; i += NT) {
        const int r = i >> 6, cc = i & 63;
        float v = p.in[I_BMOD][l * 3072 + cgp * 64 + cc];
#pragma unroll
        for (int k = 0; k < 32; ++k) v += red[(k * 9 + r) * 64 + cc];
        mod[(l * 9 + r) * 3072 + cgp * 64 + cc] = v;
    }
}

constexpr int WCONV_TILES = 16 * 27 + 16 * 8;
__device__ void wconv_loop(const Params& p, int l, int first, int end, int stride, char* smem, int oz) {
    if (first >= end) return;
    const int tid = (threadIdx.x + oz) & 511;
    float* tile = (float*)smem;
    float4 vn[4];
#define WC_LOAD(id_)                                                                                   \
    {                                                                                                  \
        int id2 = (id_);                                                                               \
        const bool isin_ = id2 < 16 * 27;                                                              \
        if (!isin_) id2 -= 16 * 27;                                                                    \
        const int NN_ = isin_ ? INW : DM, ntn_ = isin_ ? 27 : 8;                                       \
        const int k0_ = (id2 / ntn_) * 64, n0_ = (id2 % ntn_) * 128;                                   \
        const float* W_ = (isin_ ? p.in[I_WIN] : p.in[I_WOUT]) + (size_t)l * 1024 * NN_;               \
        _Pragma("unroll") for (int i = 0; i < 4; ++i) {                                                \
            const int pc = tid + 512 * i, r = pc >> 5, c4 = (pc & 31) * 4;                             \
            const int n = n0_ + c4;                                                                    \
            vn[i] = (n < NN_) ? *(const float4*)(W_ + (size_t)(k0_ + r) * NN_ + n) : make_float4(0.f, 0.f, 0.f, 0.f); \
        }                                                                                              \
    }
    WC_LOAD(first)
    for (int idt = first; idt < end; idt += stride) {
        int id = idt;
        const bool isin = id < 16 * 27;
        if (!isin) id -= 16 * 27;
        const int NN = isin ? INW : DM;
        const int ntn = isin ? 27 : 8;
        const int k0 = (id / ntn) * 64, n0 = (id % ntn) * 128;
        bf16_t* Wt = (bf16_t*)(p.ws + (isin ? OFF_WINT : OFF_WOUTT + (size_t)(l & 1) * SZ_WOUTT));
        float4 v[4];
#pragma unroll
        for (int i = 0; i < 4; ++i) v[i] = vn[i];
        if (idt + stride < end) WC_LOAD(idt + stride)
        __syncthreads();
#pragma unroll
        for (int i = 0; i < 4; ++i) {
            const int pc = tid + 512 * i, r = pc >> 5, c4 = (pc & 31) * 4;
            tile[r * 129 + c4] = v[i].x; tile[r * 129 + c4 + 1] = v[i].y; tile[r * 129 + c4 + 2] = v[i].z; tile[r * 129 + c4 + 3] = v[i].w;
        }
        __syncthreads();
        {
            const int nn = tid >> 2, q = tid & 3, n = n0 + nn;
            if (n < NN) {
                u32x4 o0, o1;
#pragma unroll
                for (int w = 0; w < 4; ++w) {
                    o0[w] = cvt_pk(tile[(q * 16 + 2 * w) * 129 + nn], tile[(q * 16 + 2 * w + 1) * 129 + nn]);
                    o1[w] = cvt_pk(tile[(q * 16 + 8 + 2 * w) * 129 + nn], tile[(q * 16 + 8 + 2 * w + 1) * 129 + nn]);
                }
                *(u32x4*)(Wt + (size_t)n * 1024 + k0 + q * 16) = o0;
                *(u32x4*)(Wt + (size_t)n * 1024 + k0 + q * 16 + 8) = o1;
            }
        }
    }
#undef WC_LOAD
}

__device__ void phase_prep(const Params& p, char* smem, int vb, int nvb, int oz) {
    if (vb < 192) phase_prep_mod(p, smem, vb, oz);
    __syncthreads();
    const bool wb = vb >= 192;
    wconv_loop(p, 0, wb ? vb - 192 : 320 + vb, wb ? 320 : WCONV_TILES, wb ? nvb - 192 : 192, smem, oz);
}

__device__ void phase_E_rows(const Params& p, int l, char* smem, int vb, int nvb, bool split, int nrows, int oz) {
    const int tid = threadIdx.x + oz, lane = tid & 63, wave = __builtin_amdgcn_readfirstlane(tid >> 6);
    const float* mod = (const float*)(p.ws + OFF_MOD);
    bf16_t* P = (bf16_t*)(p.ws + OFF_P);
    float* XC = (float*)(p.ws + OFF_XC);
    const int gw = vb * 8 + wave;
#pragma clang loop unroll(disable)
  for (int seg = 0; seg < (split ? 2 : 1); ++seg) {
    int rbeg, rend;
    if (!split) {
        const int per = (nrows + nvb * 8 - 1) / (nvb * 8);
        rbeg = gw * per;
        rend = (rbeg + per < nrows) ? rbeg + per : nrows;
    } else if (seg == 0) {
        const int nw0 = (nvb - 32) * 8;
        rbeg = (gw < nw0) ? gw * 9 : nw0 * 9 + (gw - nw0);
        rend = (gw < nw0) ? rbeg + 9 : rbeg + 1;
        rend = rend < LAT ? rend : LAT;
    } else {
        unsigned* bar = (unsigned*)(p.ws + OFF_BAR);
        __syncthreads();
        if (threadIdx.x == 0) {
            XB_SPIN(xb_ld(&bar[192]) < 32u * (unsigned)l, bar);
            __builtin_amdgcn_fence(__ATOMIC_ACQUIRE, "agent");
            asm volatile("s_waitcnt vmcnt(0)" ::: "memory");
        }
        __syncthreads();
        rbeg = LAT + gw;
        rend = rbeg + 1;
    }
    if (rbeg < rend) {
    float4 gp[4], pa[4], sh[4];
    int cur_mr = -1;
    float4 nx[4];
    u32x2 ny[4];
#define E2_LOAD(row_)                                                                              \
    {                                                                                              \
        const int rr_ = (row_);                                                                    \
        const float* src_ = (l == 0) ? ((rr_ >= LAT) ? p.in[I_CTX] + (size_t)(rr_ - LAT) * DM : p.in[I_X] + (size_t)rr_ * DM) \
                                     : ((rr_ >= LAT) ? XC + (size_t)(rr_ - LAT) * DM : p.out + (size_t)rr_ * DM); \
        _Pragma("unroll") for (int k = 0; k < 4; ++k) {                                            \
            nx[k] = *(const float4*)(src_ + k * 256 + lane * 4);                                   \
            if (l > 0) ny[k] = *(const u32x2*)(P + (size_t)rr_ * DM + k * 256 + lane * 4);         \
        }                                                                                          \
    }
    E2_LOAD(rbeg)
    for (int row = rbeg; row < rend; ++row) {
        const bool isctx = row >= LAT;
        const int mr = isctx ? 8 : row / T;
        if (mr != cur_mr) {
            cur_mr = mr;
#pragma unroll
            for (int k = 0; k < 4; ++k) {
                const int col = k * 256 + lane * 4;
                if (l > 0) {
                    const float4 g = *(const float4*)(mod + ((l - 1) * 9 + mr) * 3072 + 2048 + col);
                    const float4 pg = *(const float4*)(p.in[I_POSTG] + (l - 1) * DM + col);
                    gp[k] = make_float4(g.x * pg.x, g.y * pg.y, g.z * pg.z, g.w * pg.w);
                }
                if (l < 4) {
                    const float4 pre = *(const float4*)(p.in[I_PREG] + l * DM + col);
                    const float4 sc = *(const float4*)(mod + (l * 9 + mr) * 3072 + 1024 + col);
                    sh[k] = *(const float4*)(mod + (l * 9 + mr) * 3072 + col);
                    pa[k] = make_float4(pre.x * (1.f + sc.x), pre.y * (1.f + sc.y), pre.z * (1.f + sc.z), pre.w * (1.f + sc.w));
                }
            }
        }
        float* xcur = isctx ? XC + (size_t)(row - LAT) * DM : p.out + (size_t)row * DM;
        float4 xv[4];
        u32x2 yr[4];
#pragma unroll
        for (int k = 0; k < 4; ++k) { xv[k] = nx[k]; yr[k] = ny[k]; }
        if (row + 1 < rend) E2_LOAD(row + 1)
        float y[4][4];
        float ss = 0.f;
#pragma unroll
        for (int k = 0; k < 4; ++k) {
            y[k][0] = lo16(yr[k][0]); y[k][1] = hi16(yr[k][0]); y[k][2] = lo16(yr[k][1]); y[k][3] = hi16(yr[k][1]);
            ss += y[k][0] * y[k][0] + y[k][1] * y[k][1] + y[k][2] * y[k][2] + y[k][3] * y[k][3];
        }
        float rs = 0.f;
        if (l > 0) {
            ss = wave_sum(ss);
            rs = rsqrtf(ss * (1.f / DM) + EPS);
        }
        float ss2 = 0.f;
#pragma unroll
        for (int k = 0; k < 4; ++k) {
            if (l > 0) {
                xv[k].x += gp[k].x * (y[k][0] * rs);
                xv[k].y += gp[k].y * (y[k][1] * rs);
                xv[k].z += gp[k].z * (y[k][2] * rs);
                xv[k].w += gp[k].w * (y[k][3] * rs);
            }
            *(float4*)(xcur + k * 256 + lane * 4) = xv[k];
            ss2 += xv[k].x * xv[k].x + xv[k].y * xv[k].y + xv[k].z * xv[k].z + xv[k].w * xv[k].w;
        }
        if (l < 4) {
            ss2 = wave_sum(ss2);
            const float rs2 = rsqrtf(ss2 * (1.f / DM) + EPS);
#pragma unroll
            for (int k = 0; k < 4; ++k) {
                u32x2 hv;
                hv[0] = cvt_pk(xv[k].x * rs2 * pa[k].x + sh[k].x, xv[k].y * rs2 * pa[k].y + sh[k].y);
                hv[1] = cvt_pk(xv[k].z * rs2 * pa[k].z + sh[k].z, xv[k].w * rs2 * pa[k].w + sh[k].w);
                *(u32x2*)(P + (size_t)row * DM + k * 256 + lane * 4) = hv;
            }
        }
    }
    }
  }
#undef E2_LOAD
}


namespace g8 {
#define G8_LAS __attribute__((address_space(3)))
constexpr int BM = 256, BK = 64, HALF = 128, HTB = HALF * BK * 2, STAGE_BYTES = 8 * HTB, NXCD = 8, WGM = 8;
__device__ __forceinline__ int lds_byte(int r, int c) { const int st = (r >> 4) * 2 + (c >> 5), rr = r & 15, cc = c & 31, ob = rr * 64 + cc * 2; return st * 1024 + (ob ^ (((ob >> 9) & 1) << 5)); }
__device__ __forceinline__ void stage_rc(int b, int& R, int& C) { const int st = b / 1024, sb = b % 1024, swz = sb ^ (((sb >> 9) & 1) << 5); R = (st >> 1) * 16 + swz / 64; C = (st & 1) * 32 + (swz % 64) / 2; }
__device__ __forceinline__ int perm32(int rho) { const int n = rho >> 4, i = rho & 15; return 8 * (i >> 2) + 4 * n + (i & 3); }
struct Unit { int pm, pn; };
struct Order {
    int nM, nN, nwg, G, c;
    __device__ __forceinline__ void init(int M, int N, int G_, int c_) { nM = M / BM; nN = N / BM; nwg = nM * nN; G = G_; c = c_; }
    __device__ __forceinline__ bool next(int i, Unit& u) const {
        const long L = (long)i * G + c; if (L >= nwg) return false;
        int wgid = (int)L; { const int q = nwg / NXCD, r = nwg % NXCD, xcd = wgid % NXCD, off = wgid / NXCD; wgid = (xcd < r ? xcd * (q + 1) : r * (q + 1) + (xcd - r) * q) + off; }
        const int nig = WGM * nN, gid = wgid / nig, fm = gid * WGM, gsz = (nM - fm) < WGM ? (nM - fm) : WGM;
        u.pm = fm + ((wgid % nig) % gsz); u.pn = (wgid % nig) / gsz; return true;
    }
};
template <bool OUTP>
__device__ __forceinline__ size_t colb(int t) {
    if (OUTP) {
        const int gsel = t >> 2;
        const int zoff = (gsel == 0) ? C_LRUZ : (gsel == 1) ? C_GZ : (gsel == 2) ? C_RZ : C_SZ;
        return (size_t)(zoff + (t & 3) * 64) * 2;
    }
    return (size_t)t * (BK * 2);
}
template <bool OUTP>
__device__ __forceinline__ void gemm_phase(const Params& p, int l, char* smem, int vb, int nvb, int pm0, int M) {
    G8_LAS unsigned char* lds = (G8_LAS unsigned char*)smem;
    const int tid = threadIdx.x, wid = __builtin_amdgcn_readfirstlane(tid >> 6), lane = tid & 63, wr = wid >> 2, wc = wid & 3, fr = lane & 15, fq = lane >> 4;
    constexpr int K = DM, nt = K / BK;
    const int N = OUTP ? DM : INW;
    const int NP = OUTP ? DM : NPAD;
    const int lda = OUTP ? INW : DM;
    const bf16_t* Aptr = OUTP ? (const bf16_t*)(p.ws + OFF_U) : (const bf16_t*)(p.ws + OFF_P);
    const bf16_t* Bptr = OUTP ? (const bf16_t*)(p.ws + OFF_WOUTT + (size_t)(l & 1) * SZ_WOUTT) : (const bf16_t*)(p.ws + OFF_WINT);
    bf16_t* Cptr = OUTP ? (bf16_t*)(p.ws + OFF_P) : (bf16_t*)(p.ws + OFF_U);
    const int ldc = OUTP ? DM : INW;
    Order S; S.init(M, NP, nvb, vb);
    unsigned voffA[2], voffB[2];
#pragma unroll
    for (int i = 0; i < 2; ++i) { int R, C; stage_rc(tid * 16 + i * 8192, R, C); const int Rb = (R & ~31) + perm32(R & 31);
        voffA[i] = (unsigned)(R * lda + C) * 2u; voffB[i] = (unsigned)(Rb * K + C) * 2u; }
    const size_t kstep = (size_t)(BK * 2);
    const size_t hstepA = (size_t)HALF * lda * 2, hstepB = (size_t)HALF * K * 2;
    const size_t tstepA = 2 * hstepA, tstepB = 2 * hstepB;
    const unsigned ldsw = (unsigned)wid * 1024u;
    const int aoff = lds_byte(wr * 64 + fr, fq * 8), boff = lds_byte(wc * 32 + fr, fq * 8);
#define G8_SA(b, h) (((b) * 2 + (h)) * HTB)
#define G8_SB(b, h) ((4 + (b) * 2 + (h)) * HTB)
#define G8_STAGE(bufoff, gbase, voff) do { _Pragma("unroll") for (int _i = 0; _i < 2; ++_i) \
        __builtin_amdgcn_global_load_lds((const unsigned*)((const char*)(gbase) + (voff)[_i]), (G8_LAS unsigned*)(lds + (bufoff) + ldsw + _i * 8192), 16, 0, 0); } while (0)
#define G8_LDA(dst, b, h) do { _Pragma("unroll") for (int m = 0; m < 4; ++m) _Pragma("unroll") for (int k = 0; k < 2; ++k) dst[m][k] = *(const G8_LAS bf16x8*)(lds + G8_SA(b, h) + aoff + m * 2048 + k * 1024); } while (0)
#define G8_LDB(dst, b, h) do { _Pragma("unroll") for (int n = 0; n < 2; ++n) _Pragma("unroll") for (int k = 0; k < 2; ++k) dst[n][k] = *(const G8_LAS bf16x8*)(lds + G8_SB(b, h) + boff + n * 2048 + k * 1024); } while (0)
#define G8_MMA(ai, bj, At, Bt) do { __builtin_amdgcn_s_setprio(1); _Pragma("unroll") for (int m = 0; m < 4; ++m) _Pragma("unroll") for (int n = 0; n < 2; ++n) _Pragma("unroll") for (int k = 0; k < 2; ++k) \
        acc[ai][bj][m][n] = __builtin_amdgcn_mfma_f32_16x16x32_bf16(Bt[n][k], At[m][k], acc[ai][bj][m][n], 0, 0, 0); __builtin_amdgcn_s_setprio(0); } while (0)
#define G8_WAIT_V(n) asm volatile("s_waitcnt vmcnt(" #n ")" ::: "memory")
#define G8_WAIT_L(n) asm volatile("s_waitcnt lgkmcnt(" #n ")" ::: "memory")
#define G8_BAR __builtin_amdgcn_s_barrier()
#define G8_SCHED __builtin_amdgcn_sched_barrier(0)
    Unit cur, nxt; int ui = 0;
    if (!S.next(0, cur)) return;
    cur.pm += pm0;
    f32x4 acc[2][2][4][2];
#pragma unroll
    for (int a = 0; a < 2; ++a)
#pragma unroll
        for (int b = 0; b < 2; ++b)
#pragma unroll
            for (int m = 0; m < 4; ++m)
#pragma unroll
                for (int n = 0; n < 2; ++n) acc[a][b][m][n] = (f32x4){0.f, 0.f, 0.f, 0.f};
    bf16x8 At[4][2], B0[2][2], B1[2][2];
    const char* cA = (const char*)Aptr + (size_t)cur.pm * tstepA; const char* cB = (const char*)Bptr + (size_t)cur.pn * tstepB;
    {
        const char* a0 = cA + colb<OUTP>(0);
        G8_STAGE(G8_SB(0, 0), cB, voffB); G8_STAGE(G8_SA(0, 0), a0, voffA); G8_STAGE(G8_SB(0, 1), cB + hstepB, voffB); G8_STAGE(G8_SA(0, 1), a0 + hstepA, voffA);
        if (wr == 1) G8_BAR;
        G8_WAIT_V(4); G8_BAR;
        G8_STAGE(G8_SB(1, 0), cB + kstep, voffB); G8_STAGE(G8_SA(1, 0), a0 + kstep, voffA); G8_STAGE(G8_SB(1, 1), cB + hstepB + kstep, voffB);
        G8_WAIT_V(6); G8_BAR;
    }
    for (;;) {
        const bool has_next = S.next(ui + 1, nxt);
        nxt.pm += pm0;
        const char* nA = has_next ? (const char*)Aptr + (size_t)nxt.pm * tstepA : cA; const char* nB = has_next ? (const char*)Bptr + (size_t)nxt.pn * tstepB : cB;
#pragma clang loop unroll(disable)
        for (int t = 0; t < nt; t += 2) {
            const bool last = (t == nt - 2);
            const char* a1 = cA + colb<OUTP>(t) + kstep;
            const char* a2 = last ? nA + colb<OUTP>(0) : cA + colb<OUTP>(t + 2); const char* b2 = last ? nB : cB + (size_t)(t + 2) * kstep;
            const char* a3 = a2 + kstep; const char* b3 = b2 + kstep;
            G8_LDB(B0, 0, 0); G8_SCHED; G8_LDA(At, 0, 0); G8_STAGE(G8_SA(1, 1), a1 + hstepA, voffA);
            G8_WAIT_L(8); G8_BAR; G8_WAIT_L(0); G8_MMA(0, 0, At, B0); G8_BAR; G8_SCHED;
            G8_LDB(B1, 0, 1); G8_STAGE(G8_SB(0, 0), b2, voffB);
            G8_BAR; G8_WAIT_L(0); G8_MMA(0, 1, At, B1); G8_BAR;
            G8_LDA(At, 0, 1); G8_STAGE(G8_SA(0, 0), a2, voffA);
            G8_BAR; G8_WAIT_L(0); G8_MMA(1, 0, At, B0); G8_BAR; G8_SCHED;
            G8_STAGE(G8_SB(0, 1), b2 + hstepB, voffB);
            G8_WAIT_V(6); G8_BAR; G8_MMA(1, 1, At, B1); G8_BAR;
            G8_LDB(B0, 1, 0); G8_SCHED; G8_LDA(At, 1, 0); G8_STAGE(G8_SA(0, 1), a2 + hstepA, voffA);
            G8_WAIT_L(8); G8_BAR; G8_WAIT_L(0); G8_MMA(0, 0, At, B0); G8_BAR; G8_SCHED;
            G8_LDB(B1, 1, 1); G8_STAGE(G8_SB(1, 0), b3, voffB);
            G8_BAR; G8_WAIT_L(0); G8_MMA(0, 1, At, B1); G8_BAR;
            G8_LDA(At, 1, 1); G8_STAGE(G8_SA(1, 0), a3, voffA);
            G8_BAR; G8_WAIT_L(0); G8_MMA(1, 0, At, B0); G8_BAR; G8_SCHED;
            G8_STAGE(G8_SB(1, 1), b3 + hstepB, voffB);
            G8_WAIT_V(6); G8_BAR; G8_MMA(1, 1, At, B1); G8_BAR;
        }
        {
            const int row0 = cur.pm * BM + wr * 64 + fr, col0 = cur.pn * BM + wc * 32 + 8 * fq;
#pragma unroll
            for (int ai = 0; ai < 2; ++ai)
#pragma unroll
                for (int m = 0; m < 4; ++m) {
                    bf16_t* rowp = Cptr + (size_t)(row0 + ai * HALF + m * 16) * ldc + col0;
#pragma unroll
                    for (int bj = 0; bj < 2; ++bj) {
                        if (col0 + bj * HALF < N) {
                            const f32x4 v0 = acc[ai][bj][m][0], v1 = acc[ai][bj][m][1];
                            u32x4 w = {cvt_pk(v0[0], v0[1]), cvt_pk(v0[2], v0[3]), cvt_pk(v1[0], v1[1]), cvt_pk(v1[2], v1[3])};
                            *(u32x4*)(rowp + bj * HALF) = w;
                        }
                    }
                }
        }
        if (!has_next) break;
#pragma unroll
        for (int a = 0; a < 2; ++a)
#pragma unroll
            for (int b = 0; b < 2; ++b)
#pragma unroll
                for (int m = 0; m < 4; ++m)
#pragma unroll
                    for (int n = 0; n < 2; ++n) acc[a][b][m][n] = (f32x4){0.f, 0.f, 0.f, 0.f};
        cur = nxt; cA = nA; cB = nB; ++ui;
    }
    G8_WAIT_V(0);
    if (wr == 0) G8_BAR;
    G8_BAR;
#undef G8_SA
#undef G8_SB
#undef G8_STAGE
#undef G8_LDA
#undef G8_LDB
#undef G8_MMA
#undef G8_WAIT_V
#undef G8_WAIT_L
#undef G8_BAR
#undef G8_SCHED
}
}

struct ChunkInfo {
    bool isctx;
    int t0, Tseg;
    size_t rowbase;
};
template <int CH>
__device__ __forceinline__ ChunkInfo chunk_info(int ci, int dir, int b) {
    constexpr int NC = LC / CH, NL = T / CH;
    ChunkInfo c;
    c.isctx = ci < NC;
    const int cidx = c.isctx ? ci : ci - NC;
    const int nch = c.isctx ? NC : NL;
    const int chunk = dir ? (nch - 1 - cidx) : cidx;
    c.Tseg = c.isctx ? LC : T;
    c.rowbase = c.isctx ? (size_t)LAT + (size_t)b * LC : (size_t)b * T;
    c.t0 = chunk * CH;
    return c;
}

template <int DIR>
__device__ __forceinline__ void ret_step(const bf16_t* Q, const bf16_t* K, const bf16_t* V, f32x4 (&S)[4], f32x4 (&o)[4],
                                         int sl, int g, int li, float g64, bool need_o) {
    constexpr int LS = 72;
    const int q4 = li >> 2, p4 = li & 3;
    bf16x8 vf[2];
#pragma unroll
    for (int s = 0; s < 2; ++s)
        vf[s] = cat8(lds_tr(V + (32 * s + 4 * g + q4) * LS + 16 * sl + 4 * p4), lds_tr(V + (32 * s + 16 + 4 * g + q4) * LS + 16 * sl + 4 * p4));
    bf16x8 kr[4][2], qr[4][2];
    if (need_o) {
#pragma unroll
        for (int bi = 0; bi < 4; ++bi)
#pragma unroll
            for (int s2 = 0; s2 < 2; ++s2) {
                kr[bi][s2] = *(const bf16x8*)(K + (16 * bi + li) * LS + 32 * s2 + 8 * g);
                qr[bi][s2] = *(const bf16x8*)(Q + (16 * bi + li) * LS + 32 * s2 + 8 * g);
            }
    }
    __builtin_amdgcn_sched_barrier(0);
    bf16x8 af[4][2];
    if (need_o) {
#pragma unroll
        for (int ci = 0; ci < 4; ++ci) {
            u32x4 fr[2];
#pragma unroll
            for (int bi = 0; bi < 4; ++bi) {
                const bool needed = DIR ? (bi >= ci) : (bi <= ci);
                unsigned w0 = 0, w1 = 0;
                if (needed) {
                    f32x4 t = {0.f, 0.f, 0.f, 0.f};
#pragma unroll
                    for (int s2 = 0; s2 < 2; ++s2) t = MFMA32(kr[bi][s2], qr[ci][s2], t);
                    if (bi == ci) {
#pragma unroll
                        for (int r = 0; r < 4; ++r) {
                            const bool keep = DIR ? (4 * g + r >= li) : (4 * g + r <= li);
                            t[r] = keep ? t[r] : 0.f;
                        }
                    }
                    w0 = cvt_pk(t[0], t[1]);
                    w1 = cvt_pk(t[2], t[3]);
                }
                fr[bi >> 1][(bi & 1) * 2] = w0;
                fr[bi >> 1][(bi & 1) * 2 + 1] = w1;
            }
            af[ci][0] = __builtin_bit_cast(bf16x8, fr[0]);
            af[ci][1] = __builtin_bit_cast(bf16x8, fr[1]);
        }
    }
    bf16x8 ka[4][2], qa[4][2];
#pragma unroll
    for (int mt = 0; mt < 4; ++mt)
#pragma unroll
        for (int s = 0; s < 2; ++s) {
            ka[mt][s] = cat8(lds_tr(K + (32 * s + 4 * g + q4) * LS + 32 * (mt >> 1) + 8 * p4 + 4 * (mt & 1)),
                             lds_tr(K + (32 * s + 16 + 4 * g + q4) * LS + 32 * (mt >> 1) + 8 * p4 + 4 * (mt & 1)));
            if (need_o) qa[mt][s] = qr[mt][s];
        }
    __builtin_amdgcn_sched_barrier(0);
    if (need_o) {
        bf16x8 sf[2];
#pragma unroll
        for (int s = 0; s < 2; ++s) sf[s] = pack8(S[2 * s], S[2 * s + 1]);
#pragma unroll
        for (int ci = 0; ci < 4; ++ci) {
            f32x4 acc = {0.f, 0.f, 0.f, 0.f};
#pragma unroll
            for (int s = 0; s < 2; ++s) {
                acc = MFMA32(sf[s], qa[ci][s], acc);
                if (!(DIR ? (s == 0 && ci >= 2) : (s == 1 && ci < 2))) acc = MFMA32(vf[s], af[ci][s], acc);
            }
            o[ci] = acc;
        }
    }
#pragma unroll
    for (int mt = 0; mt < 4; ++mt) {
        f32x4 acc = S[mt];
#pragma unroll
        for (int s = 0; s < 2; ++s) acc = MFMA32(ka[mt][s], vf[s], acc);
        S[mt] = acc * g64;
    }
}

__device__ void phase_ret_chain(const Params& p, int l, char* smem, int vb, int nvb, int oz) {
    constexpr int LS = 72;
    constexpr int BUFE = 3 * 64 * LS;
    bf16_t* lds = (bf16_t*)smem;
    bf16_t* U = (bf16_t*)(p.ws + OFF_U);
    const int tid = threadIdx.x + oz, lane = tid & 63, wave = __builtin_amdgcn_readfirstlane(tid >> 6);
    const int sl = wave & 3, g = lane >> 4, li = lane & 15;
    const bool loader = wave >= 4;
    const int at = tid & 255, fr = at >> 2, fj = at & 3;
    const bool with_ctx = l < 3;
    for (int it = vb; it < 64; it += nvb) {
        const int b = it >> 3, h = (it >> 1) & 3, dir = it & 1;
        const float lg2 = log2f(sigmoidf_(p.in[I_RDEC][(l * 2 + dir) * 4 + h]));
        if (loader) {
            float invr[8];
#pragma unroll
            for (int ii = 0; ii < 8; ++ii) invr[ii] = expf(-(float)(8 * fj + ii) * (9.210340371976184f / 32.f)) * 0.15915494309189535f;
            const float pp1 = (float)((dir ? 63 - fr : fr) + 1);
            const float fq = exp2f(lg2 * pp1), fk = 0.125f * exp2f(-lg2 * pp1);
            u32x4 ra[6], rb[6], rc[6];
#define RET_LOAD(R, ci_)                                                                              \
    {                                                                                                 \
        const ChunkInfo cc = chunk_info<64>((ci_), dir, b);                                           \
        const bf16_t* base = U + (cc.rowbase + cc.t0 + fr) * INW + h * 64 + 8 * fj;                   \
        R[0] = *(const u32x4*)(base + C_RQ); R[1] = *(const u32x4*)(base + C_RQ + 32);                \
        R[2] = *(const u32x4*)(base + C_RK); R[3] = *(const u32x4*)(base + C_RK + 32);                \
        R[4] = *(const u32x4*)(base + C_RV); R[5] = *(const u32x4*)(base + C_RV + 32);                \
    }
#define RET_FILL(R, ci_, buf_)                                                                        \
    {                                                                                                 \
        const ChunkInfo cc = chunk_info<64>((ci_), dir, b);                                           \
        bf16_t* Q = lds + (buf_) * BUFE;                                                              \
        bf16_t* K = Q + 64 * LS;                                                                      \
        bf16_t* V = K + 64 * LS;                                                                      \
        float q1[8], q2[8], k1[8], k2[8];                                                             \
        _Pragma("unroll") for (int w = 0; w < 4; ++w) {                                               \
            q1[2 * w] = lo16(R[0][w]); q1[2 * w + 1] = hi16(R[0][w]);                                 \
            q2[2 * w] = lo16(R[1][w]); q2[2 * w + 1] = hi16(R[1][w]);                                 \
            k1[2 * w] = lo16(R[2][w]); k1[2 * w + 1] = hi16(R[2][w]);                                 \
            k2[2 * w] = lo16(R[3][w]); k2[2 * w + 1] = hi16(R[3][w]);                                 \
        }                                                                                             \
        if (!cc.isctx) {                                                                              \
            const float pos = (float)(cc.t0 + fr);                                                    \
            _Pragma("unroll") for (int ii = 0; ii < 8; ++ii) {                                        \
                float rev = pos * invr[ii];                                                           \
                rev -= floorf(rev);                                                                   \
                const float cs = __builtin_amdgcn_cosf(rev), sn = __builtin_amdgcn_sinf(rev);         \
                const float a1 = q1[ii], a2 = q2[ii];                                                 \
                q1[ii] = a1 * cs - a2 * sn;                                                           \
                q2[ii] = a1 * sn + a2 * cs;                                                           \
                const float b1 = k1[ii], b2 = k2[ii];                                                 \
                k1[ii] = b1 * cs - b2 * sn;                                                           \
                k2[ii] = b1 * sn + b2 * cs;                                                           \
            }                                                                                         \
        }                                                                                             \
        u32x4 o1, o2;                                                                                 \
        _Pragma("unroll") for (int w = 0; w < 4; ++w) { o1[w] = cvt_pk(q1[2 * w] * fq, q1[2 * w + 1] * fq); o2[w] = cvt_pk(q2[2 * w] * fq, q2[2 * w + 1] * fq); } \
        *(u32x2*)(Q + fr * LS + permcol(8 * fj)) = (u32x2){o1[0], o1[1]};                             \
        *(u32x2*)(Q + fr * LS + permcol(8 * fj + 4)) = (u32x2){o1[2], o1[3]};                         \
        *(u32x2*)(Q + fr * LS + permcol(32 + 8 * fj)) = (u32x2){o2[0], o2[1]};                        \
        *(u32x2*)(Q + fr * LS + permcol(36 + 8 * fj)) = (u32x2){o2[2], o2[3]};                        \
        _Pragma("unroll") for (int w = 0; w < 4; ++w) { o1[w] = cvt_pk(k1[2 * w] * fk, k1[2 * w + 1] * fk); o2[w] = cvt_pk(k2[2 * w] * fk, k2[2 * w + 1] * fk); } \
        *(u32x2*)(K + fr * LS + permcol(8 * fj)) = (u32x2){o1[0], o1[1]};                             \
        *(u32x2*)(K + fr * LS + permcol(8 * fj + 4)) = (u32x2){o1[2], o1[3]};                         \
        *(u32x2*)(K + fr * LS + permcol(32 + 8 * fj)) = (u32x2){o2[0], o2[1]};                        \
        *(u32x2*)(K + fr * LS + permcol(36 + 8 * fj)) = (u32x2){o2[2], o2[3]};                        \
        *(u32x4*)(V + fr * LS + 8 * fj) = R[4];                                                       \
        *(u32x4*)(V + fr * LS + 32 + 8 * fj) = R[5];                                                  \
    }
            RET_LOAD(ra, 0)
            RET_LOAD(rb, 1)
            RET_LOAD(rc, 2)
            RET_FILL(ra, 0, 0)
            RET_LOAD(ra, 3)
            LDS_BARRIER();
            for (int ci = 0; ci < 36; ci += 6) {
                RET_FILL(rb, ci + 1, 1)  if (ci + 4 < 36) RET_LOAD(rb, ci + 4)  LDS_BARRIER();
                RET_FILL(rc, ci + 2, 0)  if (ci + 5 < 36) RET_LOAD(rc, ci + 5)  LDS_BARRIER();
                RET_FILL(ra, ci + 3, 1)  if (ci + 6 < 36) RET_LOAD(ra, ci + 6)  LDS_BARRIER();
                RET_FILL(rb, ci + 4, 0)  if (ci + 7 < 36) RET_LOAD(rb, ci + 7)  LDS_BARRIER();
                RET_FILL(rc, ci + 5, 1)  if (ci + 8 < 36) RET_LOAD(rc, ci + 8)  LDS_BARRIER();
                if (ci + 6 < 36) RET_FILL(ra, ci + 6, 0)  if (ci + 9 < 36) RET_LOAD(ra, ci + 9)  LDS_BARRIER();
            }
#undef RET_LOAD
#undef RET_FILL
        } else {
            const float g64 = exp2f(lg2 * 64.f);
            bf16_t* OUTB = U + (dir ? C_GQ + 512 : C_LRUX);
            f32x4 S[4];
#pragma unroll
            for (int mt = 0; mt < 4; ++mt) S[mt] = (f32x4){0.f, 0.f, 0.f, 0.f};
            bf16x4 ost[4];
            size_t orow = 0;
            bool ohave = false;
            if (__builtin_amdgcn_readfirstlane(wave) < 4) __builtin_amdgcn_s_setprio(3);
            LDS_BARRIER();
            for (int ci = 0; ci < 36; ++ci) {
                if (ohave) {
#pragma unroll
                    for (int mt = 0; mt < 4; ++mt) *(bf16x4*)(OUTB + (orow + 16 * mt + li) * INW + h * 64 + 16 * sl + 4 * g) = ost[mt];
                }
                const ChunkInfo c = chunk_info<64>(ci, dir, b);
                const bool need_o = !c.isctx || with_ctx;
                const bf16_t* Q = lds + (ci & 1) * BUFE;
                const bf16_t* K = Q + 64 * LS;
                const bf16_t* V = K + 64 * LS;
                f32x4 o[4];
                if (dir == 0) ret_step<0>(Q, K, V, S, o, sl, g, li, g64, need_o);
                else          ret_step<1>(Q, K, V, S, o, sl, g, li, g64, need_o);
                ohave = need_o;
                if (need_o) {
                    orow = c.rowbase + c.t0;
#pragma unroll
                    for (int mt = 0; mt < 4; ++mt) ost[mt] = pack4(o[mt]);
                }
                LDS_BARRIER();
            }
            if (ohave) {
#pragma unroll
                for (int mt = 0; mt < 4; ++mt) *(bf16x4*)(OUTB + (orow + 16 * mt + li) * INW + h * 64 + 16 * sl + 4 * g) = ost[mt];
            }
        }
        __builtin_amdgcn_s_setprio(0);
        LDS_BARRIER();
    }
}

template <int DIR>
__device__ __forceinline__ void lru_scan(const float (&av)[4][4], const float (&bv)[4][4], float (&hv)[4][4], float (&pv)[4][4], float& hc, float& pc, int g, int li) {
#pragma unroll
    for (int mi = 0; mi < 4; ++mi) {
        const int mt = DIR ? 3 - mi : mi;
        const float a0 = av[mt][DIR ? 3 : 0], a1 = av[mt][DIR ? 2 : 1], a2 = av[mt][DIR ? 1 : 2], a3 = av[mt][DIR ? 0 : 3];
        const float b0 = bv[mt][DIR ? 3 : 0], b1 = bv[mt][DIR ? 2 : 1], b2 = bv[mt][DIR ? 1 : 2], b3 = bv[mt][DIR ? 0 : 3];
        const float A4 = a0 * a1 * a2 * a3;
        const float B4 = ((b0 * a1 + b1) * a2 + b2) * a3 + b3;
        float hs = hc, hend = hc, pend = pc, ps = pc;
#pragma unroll
        for (int gi = 0; gi < 4; ++gi) {
            const int gg = DIR ? 3 - gi : gi;
            const float Ag = __shfl(A4, gg * 16 + li), Bg = __shfl(B4, gg * 16 + li);
            hs = (gg == g) ? hend : hs;
            ps = (gg == g) ? pend : ps;
            hend = Ag * hend + Bg;
            pend = Ag * pend;
        }
        hc = hend;
        pc = pend;
        const float h0 = a0 * hs + b0, h1 = a1 * h0 + b1, h2 = a2 * h1 + b2, h3 = a3 * h2 + b3;
        hv[mt][DIR ? 3 : 0] = h0;
        hv[mt][DIR ? 2 : 1] = h1;
        hv[mt][DIR ? 1 : 2] = h2;
        hv[mt][DIR ? 0 : 3] = h3;
        const float p0 = a0 * ps, p1 = a1 * p0, p2 = a2 * p1, p3 = a3 * p2;
        pv[mt][DIR ? 3 : 0] = p0;
        pv[mt][DIR ? 2 : 1] = p1;
        pv[mt][DIR ? 1 : 2] = p2;
        pv[mt][DIR ? 0 : 3] = p3;
    }
}

template <int PASS>
__device__ void lru_loop(const Params& p, int l, char* smem, int first, int end, int stride, bool skip_ctx, int oz) {
    constexpr int LS = 72;
    if (first >= end) return;
    bf16_t* ul = (bf16_t*)smem;
    float* pre = (float*)(smem + 64 * LS * 2);
    float* car = pre + 2 * 35 * 64 * 2;
    float* exc = car + 128;
    bf16_t* U = (bf16_t*)(p.ws + OFF_U);
    float* AGG = (float*)(p.ws + OFF_AGG);
    int oz2 = oz;
    asm volatile("" : "+v"(oz2));
    const int tid = threadIdx.x + oz2, lane = tid & 63, wave = __builtin_amdgcn_readfirstlane(tid >> 6);
    const int dir = wave >> 2, nt = wave & 3, g = lane >> 4, li = lane & 15;
    const int c8 = tid & 7, ft = tid >> 3;
    const int n = first & 3;
    const int d = 16 * nt + li, ch = n * 64 + d;
    bf16x8 wf[2][2];
#pragma unroll
    for (int m = 0; m < 2; ++m)
#pragma unroll
        for (int s = 0; s < 2; ++s) {
            const float* W = (m ? p.in[I_LWI] : p.in[I_LWR]) + (size_t)((l * 2 + dir) * 4 + n) * 4096 + d;
            float w[8];
#pragma unroll
            for (int jj = 0; jj < 8; ++jj) w[jj] = W[(32 * s + 8 * g + jj) * 64];
            u32x4 u = {cvt_pk(w[0], w[1]), cvt_pk(w[2], w[3]), cvt_pk(w[4], w[5]), cvt_pk(w[6], w[7])};
            wf[m][s] = __builtin_bit_cast(bf16x8, u);
        }
    const float br = p.in[I_LBR][(l * 2 + dir) * 256 + ch];
    const float bi = p.in[I_LBI][(l * 2 + dir) * 256 + ch];
    const float sp8 = -8.f * 1.4426950408889634f * softplusf_(-p.in[I_LLAM][(l * 2 + dir) * 256 + ch]);
    float cbv[8], cwv[4][8];
#pragma unroll
    for (int e = 0; e < 8; ++e) {
        cbv[e] = p.in[I_LCB][l * 256 + n * 64 + 8 * c8 + e];
#pragma unroll
        for (int j = 0; j < 4; ++j) cwv[j][e] = p.in[I_LCW][(l * 4 + j) * 256 + n * 64 + 8 * c8 + e];
    }
    u32x4 nrx[4], nzv = {0u, 0u, 0u, 0u};
#define LRU_ITEM_OF(idx_) (skip_ctx ? ((idx_) >> 7) * 144 + 16 + ((idx_) & 127) : (idx_))
#define LRU_LOAD(idx_)                                                                                      \
    {                                                                                                       \
        const int it_ = LRU_ITEM_OF(idx_);                                                                  \
        const int b_ = it_ / 144, cid_ = (it_ >> 2) % 36;                                                   \
        const bool ic_ = cid_ < 4;                                                                          \
        const int t0_ = (ic_ ? cid_ : cid_ - 4) * 64, Ts_ = ic_ ? LC : T;                                   \
        const size_t rb_ = ic_ ? (size_t)LAT + (size_t)b_ * LC : (size_t)b_ * T;                            \
        _Pragma("unroll") for (int j = 0; j < 4; ++j) {                                                     \
            int tt = t0_ + ft + j - 2;                                                                      \
            tt = tt < 0 ? 0 : (tt > Ts_ - 1 ? Ts_ - 1 : tt);                                                \
            nrx[j] = *(const u32x4*)(U + (rb_ + tt) * INW + C_LRUX + n * 64 + 8 * c8);                      \
        }                                                                                                   \
        if (PASS == 1) nzv = *(const u32x4*)(U + (rb_ + t0_ + ft) * INW + C_LRUZ + n * 64 + 8 * c8);        \
    }
    LRU_LOAD(first)
  for (int idx = first; idx < end; idx += stride) {
    const int item = LRU_ITEM_OF(idx);
    const int b = item / 144, cid = (item >> 2) % 36;
    const bool isctx = cid < 4;
    const int t0 = (isctx ? cid : cid - 4) * 64, Tseg = isctx ? LC : T;
    const size_t rowbase = isctx ? (size_t)LAT + (size_t)b * LC : (size_t)b * T;
    u32x4 rx[4];
#pragma unroll
    for (int j = 0; j < 4; ++j) rx[j] = nrx[j];
    const u32x4 zv = nzv;
    const int posf = cid, posb = isctx ? 3 - cid : 39 - cid;
    f32x4 pr[5];
    if (PASS == 1) {
#pragma unroll
        for (int k = 0; k < 5; ++k) {
            const int pidx = tid + 512 * k;
            const int dd = pidx / (35 * 32), rem = pidx % (35 * 32), q = rem >> 5, pc16 = rem & 31;
            const bool need = (dd < 2) && (q < (dd ? posb : posf));
            const int j = dd ? (q < 4 ? 3 - q : 39 - q) : q;
            pr[k] = (f32x4){1.f, 0.f, 1.f, 0.f};
            if (need) pr[k] = *(const f32x4*)(AGG + ((size_t)((b * 2 + dd) * 36 + j) * 256 + n * 64) * 2 + pc16 * 4);
        }
    }
    if (idx + stride < end) LRU_LOAD(idx + stride)
    __syncthreads();
    {
        float acc[8];
#pragma unroll
        for (int e = 0; e < 8; ++e) acc[e] = cbv[e];
#pragma unroll
        for (int j = 0; j < 4; ++j) {
            const int tt = t0 + ft + j - 2;
            const bool ok = (tt >= 0) && (tt < Tseg);
#pragma unroll
            for (int w = 0; w < 4; ++w) {
                const unsigned xw = ok ? rx[j][w] : 0u;
                acc[2 * w] += cwv[j][2 * w] * lo16(xw);
                acc[2 * w + 1] += cwv[j][2 * w + 1] * hi16(xw);
            }
        }
        u32x4 o = {cvt_pk(acc[0], acc[1]), cvt_pk(acc[2], acc[3]), cvt_pk(acc[4], acc[5]), cvt_pk(acc[6], acc[7])};
        *(u32x4*)(ul + ft * LS + 8 * c8) = o;
    }
    if (PASS == 1) {
#pragma unroll
        for (int k = 0; k < 5; ++k) {
            const int pidx = tid + 512 * k;
            if (pidx < 2 * 35 * 32) *(f32x4*)(pre + pidx * 4) = pr[k];
        }
    }
    __syncthreads();
    if (PASS == 1 && tid < 128) {
        const int dd = tid >> 6, cc = tid & 63, np = dd ? posb : posf;
        float h = 0.f;
        for (int q = 0; q < np; ++q) {
            const f32x2 ah = *(const f32x2*)(pre + ((dd * 35 + q) * 64 + cc) * 2);
            h = ah[0] * h + ah[1];
        }
        car[tid] = h;
    }
    float av[4][4], bv[4][4], hv[4][4];
#pragma unroll
    for (int mt = 0; mt < 4; ++mt) {
        f32x4 racc = {0.f, 0.f, 0.f, 0.f}, iacc = {0.f, 0.f, 0.f, 0.f};
#pragma unroll
        for (int s = 0; s < 2; ++s) {
            const bf16x8 a = *(const bf16x8*)(ul + (16 * mt + li) * LS + 32 * s + 8 * g);
            racc = MFMA32(a, wf[0][s], racc);
            iacc = MFMA32(a, wf[1][s], iacc);
        }
#pragma unroll
        for (int r = 0; r < 4; ++r) {
            const float uval = bf2f(ul[(16 * mt + 4 * g + r) * LS + d]);
            const float rg = sigmoidf_(racc[r] + br), ig = sigmoidf_(iacc[r] + bi);
            const float a = fexp2(sp8 * rg);
            av[mt][r] = a;
            bv[mt][r] = __builtin_amdgcn_sqrtf(fmaxf(0.f, 1.f - a * a)) * ig * uval;
        }
    }
    if (PASS == 0) {
        float hc = 0.f, pc = 1.f;
        float pv[4][4];
        if (dir == 0) lru_scan<0>(av, bv, hv, pv, hc, pc, g, li);
        else          lru_scan<1>(av, bv, hv, pv, hc, pc, g, li);
        if (g == 0) *(f32x2*)(AGG + ((size_t)((b * 2 + dir) * 36 + cid) * 256 + ch) * 2) = (f32x2){pc, hc};
        bf16_t* stp = (bf16_t*)(p.ws + OFF_P) + (size_t)item * 16384 + (size_t)(wave * 4) * 512 + lane * 4;
#pragma unroll
        for (int mt = 0; mt < 4; ++mt) {
            *(u32x2*)(stp + mt * 512) = (u32x2){cvt_pk(hv[mt][0], hv[mt][1]), cvt_pk(hv[mt][2], hv[mt][3])};
            *(u32x2*)(stp + mt * 512 + 256) = (u32x2){cvt_pk(pv[mt][0], pv[mt][1]), cvt_pk(pv[mt][2], pv[mt][3])};
        }
    } else {
        __syncthreads();
        float hc = car[dir * 64 + d], pc = 1.f;
        float pv[4][4];
        if (dir == 0) lru_scan<0>(av, bv, hv, pv, hc, pc, g, li);
        else          lru_scan<1>(av, bv, hv, pv, hc, pc, g, li);
#pragma unroll
        for (int mt = 0; mt < 4; ++mt)
#pragma unroll
            for (int r = 0; r < 4; ++r) exc[dir * 4096 + (16 * mt + 4 * g + r) * 64 + d] = hv[mt][r];
        __syncthreads();
        const float* ef = exc + ft * 64 + 8 * c8;
        const f32x4 f0 = *(const f32x4*)ef, f1 = *(const f32x4*)(ef + 4), b0 = *(const f32x4*)(ef + 4096), b1 = *(const f32x4*)(ef + 4100);
        u32x4 y;
        y[0] = cvt_pk((f0[0] + b0[0]) * siluf_(lo16(zv[0])), (f0[1] + b0[1]) * siluf_(hi16(zv[0])));
        y[1] = cvt_pk((f0[2] + b0[2]) * siluf_(lo16(zv[1])), (f0[3] + b0[3]) * siluf_(hi16(zv[1])));
        y[2] = cvt_pk((f1[0] + b1[0]) * siluf_(lo16(zv[2])), (f1[1] + b1[1]) * siluf_(hi16(zv[2])));
        y[3] = cvt_pk((f1[2] + b1[2]) * siluf_(lo16(zv[3])), (f1[3] + b1[3]) * siluf_(hi16(zv[3])));
        *(u32x4*)(U + (rowbase + t0 + ft) * INW + C_LRUZ + n * 64 + 8 * c8) = y;
    }
  }
#undef LRU_LOAD
#undef LRU_ITEM_OF
}

__device__ void lru_passC(const Params& p, int l, char* smem, int first, int end, int stride, bool skip_ctx, int oz) {
    if (first >= end) return;
    float* pre = (float*)smem;
    float* parts = pre + 2 * 35 * 64 * 2;
    float* exc = parts + 2 * 4 * 64 * 2;
    bf16_t* U = (bf16_t*)(p.ws + OFF_U);
    const bf16_t* ST = (const bf16_t*)(p.ws + OFF_P);
    const float* AGG = (const float*)(p.ws + OFF_AGG);
    int oz2 = oz;
    asm volatile("" : "+v"(oz2));
    const int tid = threadIdx.x + oz2, lane = tid & 63, wave = __builtin_amdgcn_readfirstlane(tid >> 6);
    const int dir = wave >> 2, nt = wave & 3, g = lane >> 4, li = lane & 15;
    const int c8 = tid & 7, ft = tid >> 3;
    const int n = first & 3;
    const int d = 16 * nt + li;
    u32x2 nst[8];
    u32x4 nzv;
    f32x4 npr[5];
#define LC_ITEM_OF(idx_) (skip_ctx ? ((idx_) >> 7) * 144 + 16 + ((idx_) & 127) : (idx_))
#define LC_LOAD(idx_)                                                                                       \
    {                                                                                                       \
        const int it_ = LC_ITEM_OF(idx_);                                                                   \
        const int b_ = it_ / 144, cid_ = (it_ >> 2) % 36;                                                   \
        const bool ic_ = cid_ < 4;                                                                          \
        const int t0_ = (ic_ ? cid_ : cid_ - 4) * 64;                                                       \
        const size_t rb_ = ic_ ? (size_t)LAT + (size_t)b_ * LC : (size_t)b_ * T;                            \
        const int pf_ = cid_, pb_ = ic_ ? 3 - cid_ : 39 - cid_;                                             \
        const bf16_t* sp_ = ST + (size_t)it_ * 16384 + (size_t)(wave * 4) * 512 + lane * 4;                 \
        _Pragma("unroll") for (int k = 0; k < 8; ++k) nst[k] = *(const u32x2*)(sp_ + k * 256);              \
        nzv = *(const u32x4*)(U + (rb_ + t0_ + ft) * INW + C_LRUZ + n * 64 + 8 * c8);                       \
        _Pragma("unroll") for (int k = 0; k < 5; ++k) {                                                     \
            const int pidx = tid + 512 * k;                       \
            const int dd = pidx / (35 * 32), rem = pidx % (35 * 32), q = rem >> 5, pc16 = rem & 31;        \
            const bool need = (dd < 2) && (q < (dd ? pb_ : pf_));                                           \
            const int j = dd ? (q < 4 ? 3 - q : 39 - q) : q;                                                \
            npr[k] = (f32x4){1.f, 0.f, 1.f, 0.f};                                                           \
            if (need) npr[k] = *(const f32x4*)(AGG + ((size_t)((b_ * 2 + dd) * 36 + j) * 256 + n * 64) * 2 + pc16 * 4); \
        }                                                                                                   \
    }
    LC_LOAD(first)
    for (int idx = first; idx < end; idx += stride) {
        const int item = LC_ITEM_OF(idx);
        const int b = item / 144, cid = (item >> 2) % 36;
        const bool isctx = cid < 4;
        const int t0 = (isctx ? cid : cid - 4) * 64;
        const size_t rowbase = isctx ? (size_t)LAT + (size_t)b * LC : (size_t)b * T;
        const int posf = cid, posb = isctx ? 3 - cid : 39 - cid;
        u32x2 st[8];
        f32x4 pr[5];
#pragma unroll
        for (int k = 0; k < 8; ++k) st[k] = nst[k];
#pragma unroll
        for (int k = 0; k < 5; ++k) pr[k] = npr[k];
        const u32x4 zv = nzv;
        if (idx + stride < end) LC_LOAD(idx + stride)
        __syncthreads();
#pragma unroll
        for (int k = 0; k < 5; ++k) {
            const int pidx = tid + 512 * k;
            if (pidx < 2 * 35 * 32) *(f32x4*)(pre + pidx * 4) = pr[k];
        }
        __syncthreads();
        {
            const int dd = wave >> 2, part = wave & 3, np = dd ? posb : posf;
            const int q1 = (np < 9 * part + 9) ? np : 9 * part + 9;
            float A = 1.f, B = 0.f;
            for (int q = 9 * part; q < q1; ++q) {
                const f32x2 ah = *(const f32x2*)(pre + ((dd * 35 + q) * 64 + lane) * 2);
                A = ah[0] * A;
                B = ah[0] * B + ah[1];
            }
            *(f32x2*)(parts + ((dd * 4 + part) * 64 + lane) * 2) = (f32x2){A, B};
        }
        __syncthreads();
        float hc = 0.f;
#pragma unroll
        for (int pt = 0; pt < 4; ++pt) {
            const f32x2 ab = *(const f32x2*)(parts + ((dir * 4 + pt) * 64 + d) * 2);
            hc = ab[0] * hc + ab[1];
        }
#pragma unroll
        for (int mt = 0; mt < 4; ++mt) {
            const u32x2 h0 = st[2 * mt], pp = st[2 * mt + 1];
            float* e = exc + dir * 4096 + (16 * mt + 4 * g) * 64 + d;
            e[0] = lo16(h0[0]) + lo16(pp[0]) * hc;
            e[64] = hi16(h0[0]) + hi16(pp[0]) * hc;
            e[128] = lo16(h0[1]) + lo16(pp[1]) * hc;
            e[192] = hi16(h0[1]) + hi16(pp[1]) * hc;
        }
        __syncthreads();
        const float* ef = exc + ft * 64 + 8 * c8;
        const f32x4 f0 = *(const f32x4*)ef, f1 = *(const f32x4*)(ef + 4), b0 = *(const f32x4*)(ef + 4096), b1 = *(const f32x4*)(ef + 4100);
        u32x4 y;
        y[0] = cvt_pk((f0[0] + b0[0]) * siluf_(lo16(zv[0])), (f0[1] + b0[1]) * siluf_(hi16(zv[0])));
        y[1] = cvt_pk((f0[2] + b0[2]) * siluf_(lo16(zv[1])), (f0[3] + b0[3]) * siluf_(hi16(zv[1])));
        y[2] = cvt_pk((f1[0] + b1[0]) * siluf_(lo16(zv[2])), (f1[1] + b1[1]) * siluf_(hi16(zv[2])));
        y[3] = cvt_pk((f1[2] + b1[2]) * siluf_(lo16(zv[3])), (f1[3] + b1[3]) * siluf_(hi16(zv[3])));
        *(u32x4*)(U + (rowbase + t0 + ft) * INW + C_LRUZ + n * 64 + 8 * c8) = y;
    }
#undef LC_LOAD
#undef LC_ITEM_OF
}

template <int DIR>
__device__ __forceinline__ void gdn_prep_wave(const bf16_t* qs, const bf16_t* ks, const bf16_t* vs, const float* beta, const float* G,
                                              int half, int g, int li, int lane, bf16_t* gwd, bf16_t* guv, bf16_t* gatt) {
    constexpr int LS = 72;
    float bcol[4], Gcol[4];
    f32x4 Grow[4], brow[4];
#pragma unroll
    for (int i = 0; i < 4; ++i) {
        bcol[i] = beta[16 * i + li];
        Gcol[i] = G[16 * i + li];
        Grow[i] = *(const f32x4*)(G + 16 * i + 4 * g);
        brow[i] = *(const f32x4*)(beta + 16 * i + 4 * g);
    }
    bf16x4 LtF[4][4];
    f32x4 Ntile[4], NtT[4];
#pragma unroll
    for (int ib = 0; ib < 4; ++ib)
#pragma unroll
        for (int kb = 0; kb < 4; ++kb) {
            const bool needed = DIR ? (kb >= ib) : (kb <= ib);
            if (needed) {
                f32x4 t = {0.f, 0.f, 0.f, 0.f};
#pragma unroll
                for (int s2 = 0; s2 < 2; ++s2) {
                    const bf16x8 a = *(const bf16x8*)(ks + (16 * kb + li) * LS + 32 * s2 + 8 * g);
                    const bf16x8 bb = *(const bf16x8*)(ks + (16 * ib + li) * LS + 32 * s2 + 8 * g);
                    t = MFMA32(a, bb, t);
                }
                f32x4 lt;
#pragma unroll
                for (int r = 0; r < 4; ++r) lt[r] = -(bcol[ib] * t[r] * fexp2(Gcol[ib] - Grow[kb][r]));
                if (kb == ib) {
                    f32x4 nn;
#pragma unroll
                    for (int r = 0; r < 4; ++r) {
                        const bool keepT = DIR ? (4 * g + r > li) : (4 * g + r < li);
                        lt[r] = keepT ? lt[r] : 0.f;
                        const bool keepN = DIR ? (li > 4 * g + r) : (li < 4 * g + r);
                        const float nv = -(brow[ib][r] * t[r] * fexp2(Grow[ib][r] - Gcol[ib]));
                        nn[r] = keepN ? nv : 0.f;
                    }
                    NtT[ib] = lt;
                    Ntile[ib] = nn;
                } else {
                    LtF[ib][kb] = pack4(lt);
                }
            }
        }
    bf16x4 DtF[4];
#pragma unroll
    for (int i = 0; i < 4; ++i) {
        f32x4 M = Ntile[i], Mt = NtT[i], P = Ntile[i], Pt = NtT[i];
#pragma unroll
        for (int r = 0; r < 4; ++r) {
            const float one = (4 * g + r == li) ? 1.f : 0.f;
            P[r] += one;
            Pt[r] += one;
        }
#pragma unroll
        for (int k = 0; k < 3; ++k) {
            const bf16x4 fM = pack4(M), fMt = pack4(Mt);
            const f32x4 z = {0.f, 0.f, 0.f, 0.f};
            const f32x4 M2 = MFMA16(fMt, fM, z);
            const f32x4 Mt2 = MFMA16(fM, fMt, z);
            const bf16x4 fPt = pack4(Pt), fM2 = pack4(M2);
            P = MFMA16(fPt, fM2, P);
            Pt = MFMA16(fM2, fPt, Pt);
            M = M2;
            Mt = Mt2;
        }
        DtF[i] = pack4(Pt);
    }
    bf16x4 Xf[4][4];
#pragma unroll
    for (int si = 0; si < 4; ++si) {
        const int i = DIR ? 3 - si : si;
        f32x4 eg;
#pragma unroll
        for (int r = 0; r < 4; ++r) eg[r] = half ? brow[i][r] * fexp2(Grow[i][r]) : brow[i][r];
        const bf16_t* src = half ? ks : vs;
#pragma unroll
        for (int ntl = 0; ntl < 4; ++ntl) {
            f32x4 Y;
            {
                const u32x2 sv = __builtin_bit_cast(u32x2, lds_tr(src + (16 * i + 4 * g + (li >> 2)) * LS + 16 * ntl + 4 * (li & 3)));
                Y[0] = eg[0] * lo16(sv[0]); Y[1] = eg[1] * hi16(sv[0]); Y[2] = eg[2] * lo16(sv[1]); Y[3] = eg[3] * hi16(sv[1]);
            }
#pragma unroll
            for (int sk = 0; sk < si; ++sk) {
                const int k = DIR ? 3 - sk : sk;
                Y = MFMA16(LtF[i][k], Xf[k][ntl], Y);
            }
            const f32x4 z = {0.f, 0.f, 0.f, 0.f};
            const bf16x4 Yf = pack4(Y);
            const f32x4 X = MFMA16(DtF[i], Yf, z);
            Xf[i][ntl] = pack4(X);
            if (half == 0) {
                *(bf16x4*)(guv + ((i * 4 + ntl) * 64 + lane) * 4) = Xf[i][ntl];
            } else {
                const f32x4 XT = MFMA16(Yf, DtF[i], z);
                *(bf16x4*)(gwd + (16 * i + li) * 64 + permcol(16 * ntl + 4 * g)) = pack4(-XT);
            }
        }
    }
    for (int cix = 0; cix < 2; ++cix) {
        const int ci = 2 * half + cix;
        const float Gc = G[16 * ci + li];
#pragma unroll
        for (int bi = 0; bi < 4; ++bi) {
            const bool needed = DIR ? (bi >= ci) : (bi <= ci);
            f32x4 v = {0.f, 0.f, 0.f, 0.f};
            if (needed) {
                f32x4 t = {0.f, 0.f, 0.f, 0.f};
#pragma unroll
                for (int s2 = 0; s2 < 2; ++s2) {
                    const bf16x8 a = *(const bf16x8*)(ks + (16 * bi + li) * LS + 32 * s2 + 8 * g);
                    const bf16x8 bb = *(const bf16x8*)(qs + (16 * ci + li) * LS + 32 * s2 + 8 * g);
                    t = MFMA32(a, bb, t);
                }
#pragma unroll
                for (int r = 0; r < 4; ++r) {
                    const float x = t[r] * fexp2(Gc - Grow[bi][r]);
                    const bool keep = (bi != ci) || (DIR ? (4 * g + r >= li) : (4 * g + r <= li));
                    v[r] = keep ? x : 0.f;
                }
            }
            *(bf16x4*)(gatt + (16 * ci + li) * 64 + permcol(16 * bi + 4 * g)) = pack4(v);
        }
    }
}

__device__ void phase_gdn_prep(const Params& p, int l, char* smem, int vb, int nvb, int pend, int oz) {
    constexpr int LS = 72;
    constexpr int HBYTES = 57984;
    const int hb = __builtin_amdgcn_readfirstlane((int)((threadIdx.x + oz) >> 8));
    smem += hb * HBYTES;
    bf16_t* raw = (bf16_t*)smem;
    bf16_t* qs = (bf16_t*)(smem + 25728);
    bf16_t* ks = qs + 64 * LS;
    bf16_t* vs = ks + 64 * LS;
    float* cwl = (float*)(smem + 53376);
    float* gl = cwl + 768;
    float* bl = gl + 128;
    float* Gl = bl + 128;
    bf16_t* U = (bf16_t*)(p.ws + OFF_U);
#define GP_DMA(pair_)                                                                                    \
    {                                                                                                    \
        const int tid_ = (threadIdx.x + oz) & 255, wv_ = __builtin_amdgcn_readfirstlane(tid_ >> 6);      \
        const int it_ = __builtin_amdgcn_readfirstlane(2 * (pair_) + hb);                                \
        const int b_ = it_ / 144, h_ = (it_ / 36) & 3, cid_ = it_ % 36;                                  \
        const bool ic_ = cid_ < 4;                                                                       \
        const int t0_ = (ic_ ? cid_ : cid_ - 4) * 64, Ts_ = ic_ ? LC : T;                                \
        const size_t rb_ = ic_ ? (size_t)LAT + (size_t)b_ * LC : (size_t)b_ * T;                         \
        _Pragma("unroll") for (int k = 0; k < 7; ++k) {                                                  \
            const int idx = tid_ + 256 * k;                                                              \
            const int r = idx / 24, c8 = idx % 24;                                                       \
            int t = t0_ - 2 + r;                                                                         \
            t = (t >= 0 && t < Ts_) ? t : t0_;     \
            if (idx < 67 * 24)                                                                           \
                __builtin_amdgcn_global_load_lds((const unsigned*)(U + (rb_ + t) * INW + C_GQ + (c8 >> 3) * 256 + h_ * 64 + (c8 & 7) * 8), \
                    (__attribute__((address_space(3))) unsigned*)(raw + (size_t)(wv_ * 64 + 256 * k) * 8), 16, 0, 0); \
        }                                                                                                \
    }
    for (int pair = vb - nvb; pair < pend; pair += nvb) {
      const bool live = pair >= vb;
      if (live) {
        int oz2 = oz;
        asm volatile("" : "+v"(oz2));
        const int tid = (threadIdx.x + oz2) & 255, lane = tid & 63, wave = __builtin_amdgcn_readfirstlane(tid >> 6), g = lane >> 4, li = lane & 15;
        const int it = __builtin_amdgcn_readfirstlane(2 * pair + hb);
        const int b = it / 144, h = (it / 36) & 3, cid = it % 36;
        const bool isctx = cid < 4;
        const int t0 = (isctx ? cid : cid - 4) * 64;
        const int Tseg = isctx ? LC : T;
        const size_t rowbase = isctx ? (size_t)LAT + (size_t)b * LC : (size_t)b * T;
        {
            float cv[3];
#pragma unroll
            for (int k = 0; k < 3; ++k) {
                const int idx = tid + 256 * k, j = idx / 192, cc = idx % 192;
                cv[k] = p.in[I_GCW][(l * 4 + j) * 768 + (cc >> 6) * 256 + h * 64 + (cc & 63)];
            }
            asm volatile("s_waitcnt vmcnt(0)" ::: "memory");
            __syncthreads();
#pragma unroll
            for (int k = 0; k < 3; ++k) cwl[tid + 256 * k] = cv[k];
            if (tid < 24) {
                const unsigned z0 = (unsigned)oz2;
                const u32x4 zz = {z0, z0, z0, z0};
                if (t0 == 0) { *(u32x4*)(raw + tid * 8) = zz; *(u32x4*)(raw + 192 + tid * 8) = zz; }
                if (t0 + 64 >= Tseg) *(u32x4*)(raw + 66 * 192 + tid * 8) = zz;
            }
        }
        if (tid < 128) {
            const int dd = tid >> 6, t = tid & 63;
            const size_t row = rowbase + t0 + t;
            const float alpha = bf2f(U[row * INW + C_GA + dd * 4 + h]);
            const float beta = bf2f(U[row * INW + C_GB + dd * 4 + h]);
            gl[tid] = -1.4426950408889634f * fexp(p.in[I_GALOG][(l * 2 + dd) * 4 + h]) * softplusf_(alpha + p.in[I_GDT][(l * 2 + dd) * 4 + h]);
            bl[tid] = sigmoidf_(beta);
        }
        __syncthreads();
        {
            const int t = tid >> 2, qt = tid & 3;
#pragma unroll
            for (int which = 0; which < 3; ++which) {
                float a[16];
#pragma unroll
                for (int i = 0; i < 16; ++i) a[i] = 0.f;
#pragma unroll
                for (int j = 0; j < 4; ++j) {
                    const u32x4 x0 = *(const u32x4*)(raw + (t + j) * 192 + which * 64 + qt * 16);
                    const u32x4 x1 = *(const u32x4*)(raw + (t + j) * 192 + which * 64 + qt * 16 + 8);
                    const float* cwp = cwl + j * 192 + which * 64 + qt * 16;
#pragma unroll
                    for (int w = 0; w < 4; ++w) {
                        a[2 * w] += cwp[2 * w] * lo16(x0[w]);
                        a[2 * w + 1] += cwp[2 * w + 1] * hi16(x0[w]);
                        a[8 + 2 * w] += cwp[8 + 2 * w] * lo16(x1[w]);
                        a[8 + 2 * w + 1] += cwp[8 + 2 * w + 1] * hi16(x1[w]);
                    }
                }
                float ss = 0.f;
#pragma unroll
                for (int i = 0; i < 16; ++i) {
                    a[i] = siluf_(a[i]);
                    ss += a[i] * a[i];
                }
                float sc = 1.f;
                if (which < 2) {
                    ss += __shfl_xor(ss, 1);
                    ss += __shfl_xor(ss, 2);
                    sc = rsqrtf(ss + EPS) * (which == 0 ? 0.125f : 1.f);
                }
                bf16_t* dst = (which == 0 ? qs : which == 1 ? ks : vs) + t * LS + qt * 16;
                u32x4 o0 = {cvt_pk(a[0] * sc, a[1] * sc), cvt_pk(a[2] * sc, a[3] * sc), cvt_pk(a[4] * sc, a[5] * sc), cvt_pk(a[6] * sc, a[7] * sc)};
                u32x4 o1 = {cvt_pk(a[8] * sc, a[9] * sc), cvt_pk(a[10] * sc, a[11] * sc), cvt_pk(a[12] * sc, a[13] * sc), cvt_pk(a[14] * sc, a[15] * sc)};
                *(u32x4*)dst = o0;
                *(u32x4*)(dst + 8) = o1;
            }
        }
        if (wave < 2) {
            float v = gl[wave * 64 + lane];
#pragma unroll
            for (int off = 1; off < 64; off <<= 1) {
                const float nb = wave == 0 ? __shfl_up(v, off) : __shfl_down(v, off);
                const bool ok = wave == 0 ? (lane >= off) : (lane + off < 64);
                v += ok ? nb : 0.f;
            }
            Gl[wave * 64 + lane] = v;
        }
        __syncthreads();
      }
      if (pair + nvb < pend) GP_DMA(pair + nvb)
      if (live) {
        int oz2 = oz;
        asm volatile("" : "+v"(oz2));
        const int tid = (threadIdx.x + oz2) & 255, lane = tid & 63, wave = __builtin_amdgcn_readfirstlane(tid >> 6), g = lane >> 4, li = lane & 15;
        const int it = __builtin_amdgcn_readfirstlane(2 * pair + hb);
        bf16_t* gq = (bf16_t*)(p.ws + OFF_GQ) + (size_t)it * 4096;
        bf16_t* gkt = (bf16_t*)(p.ws + OFF_GKT) + (size_t)it * 4096;
#pragma unroll
        for (int k = 0; k < 2; ++k) {
            const int pc = tid + 256 * k, row = pc >> 3, c8 = pc & 7;
            {
                const u32x4 qv = *(const u32x4*)(qs + row * LS + 8 * c8);
                *(u32x2*)(gq + row * 64 + permcol(8 * c8)) = (u32x2){qv[0], qv[1]};
                *(u32x2*)(gq + row * 64 + permcol(8 * c8 + 4)) = (u32x2){qv[2], qv[3]};
            }
            const int d = pc >> 3, c0 = (pc & 7) * 8;
            float kv[8];
#pragma unroll
            for (int i = 0; i < 8; ++i) kv[i] = bf2f(ks[(c0 + i) * LS + d]);
            u32x4 o = {cvt_pk(kv[0], kv[1]), cvt_pk(kv[2], kv[3]), cvt_pk(kv[4], kv[5]), cvt_pk(kv[6], kv[7])};
            *(u32x2*)(gkt + d * 64 + permcol(c0)) = (u32x2){o[0], o[1]};
            *(u32x2*)(gkt + d * 64 + permcol(c0 + 4)) = (u32x2){o[2], o[3]};
        }
        if (tid < 128) {
            const int dd = tid >> 6, t = tid & 63;
            float* vec = (float*)(p.ws + OFF_GVEC) + ((size_t)dd * GI + it) * 256;
            const float Glast = dd ? Gl[64] : Gl[63];
            const float Gt = Gl[dd * 64 + t];
            vec[t] = fexp2(Gt);
            vec[64 + t] = fexp2(Glast - Gt);
            if (t == 0) vec[128] = fexp2(Glast);
        }
        {
            const int dir = __builtin_amdgcn_readfirstlane(wave >> 1), half = __builtin_amdgcn_readfirstlane(wave & 1);
            bf16_t* gwd = (bf16_t*)(p.ws + OFF_GWD) + ((size_t)dir * GI + it) * 4096;
            bf16_t* guv = (bf16_t*)(p.ws + OFF_GUV) + ((size_t)dir * GI + it) * 4096;
            bf16_t* gatt = (bf16_t*)(p.ws + OFF_GATT) + ((size_t)dir * GI + it) * 4096;
            if (dir == 0) gdn_prep_wave<0>(qs, ks, vs, bl, Gl, half, g, li, lane, gwd, guv, gatt);
            else          gdn_prep_wave<1>(qs, ks, vs, bl + 64, Gl + 64, half, g, li, lane, gwd, guv, gatt);
        }
      }
    }
}

#undef GP_DMA
__device__ void phase_gdn_chain(const Params& p, int l, char* smem, int vb, int nvb, int oz) {
    constexpr int LS = 72;
    constexpr int TILEB = 64 * LS * 2;
    constexpr int BUFB = 4 * TILEB + 8192 + 528;
    bf16_t* U = (bf16_t*)(p.ws + OFF_U);
    const int tid = threadIdx.x + oz, lane = tid & 63, wave = tid >> 6;
    const int sl = wave & 3, g = lane >> 4, li = lane & 15;
    const bool loader = wave >= 4;
    const int at = tid & 255;
    const bool with_ctx = l < 3;
    for (int it = vb; it < 64; it += nvb) {
        const int b = it >> 3, h = (it >> 1) & 3, dir = it & 1;
#define GDN_GI(ci_) ((b * 4 + h) * 36 + (dir ? ((ci_) < 4 ? 3 - (ci_) : 39 - (ci_)) : (ci_)))
        if (loader) {
            u32x4 ra[5][2], rb[5][2], rc[5][2];
            float va = 0.f, vb_ = 0.f, vc_ = 0.f, ga = 0.f, gb = 0.f, gc = 0.f;
#define GDN_LOAD(R, V, G, ci_)                                                                                   \
    {                                                                                                            \
        const size_t gi = GDN_GI(ci_);                                                                           \
        const bf16_t* tp[5] = {(const bf16_t*)(p.ws + OFF_GWD) + ((size_t)dir * GI + gi) * 4096,                 \
                               (const bf16_t*)(p.ws + OFF_GATT) + ((size_t)dir * GI + gi) * 4096,                \
                               (const bf16_t*)(p.ws + OFF_GKT) + gi * 4096,                                      \
                               (const bf16_t*)(p.ws + OFF_GQ) + gi * 4096,                                       \
                               (const bf16_t*)(p.ws + OFF_GUV) + ((size_t)dir * GI + gi) * 4096};                \
        _Pragma("unroll") for (int tl = 0; tl < 5; ++tl)                                                         \
            _Pragma("unroll") for (int k = 0; k < 2; ++k) R[tl][k] = *(const u32x4*)(tp[tl] + (at + 256 * k) * 8); \
        const float* vp = (const float*)(p.ws + OFF_GVEC) + ((size_t)dir * GI + gi) * 256;                       \
        if (at < 128) V = vp[at];                                                                                \
        if (at == 0) G = vp[128];                                                                                \
    }
#define GDN_FILL(R, V, G, buf_)                                                                                  \
    {                                                                                                            \
        char* bp = smem + (buf_) * BUFB;                                                                         \
        _Pragma("unroll") for (int tl = 0; tl < 4; ++tl)                                                         \
            _Pragma("unroll") for (int k = 0; k < 2; ++k) {                                                      \
                const int pc = at + 256 * k;                                                                     \
                *(u32x4*)(bp + tl * TILEB + ((pc >> 3) * LS + (pc & 7) * 8) * 2) = R[tl][k];                     \
            }                                                                                                    \
        _Pragma("unroll") for (int k = 0; k < 2; ++k) *(u32x4*)(bp + 4 * TILEB + (at + 256 * k) * 16) = R[4][k]; \
        float* vl = (float*)(bp + 4 * TILEB + 8192);                                                             \
        if (at < 128) vl[at] = V;                                                                                \
        if (at == 0) vl[128] = G;                                                                                \
    }
            GDN_LOAD(ra, va, ga, 0)
            GDN_LOAD(rb, vb_, gb, 1)
            GDN_LOAD(rc, vc_, gc, 2)
            GDN_FILL(ra, va, ga, 0)
            GDN_LOAD(ra, va, ga, 3)
            LDS_BARRIER();
            for (int ci = 0; ci < 36; ci += 6) {
                GDN_FILL(rb, vb_, gb, 1)  if (ci + 4 < 36) GDN_LOAD(rb, vb_, gb, ci + 4)  LDS_BARRIER();
                GDN_FILL(rc, vc_, gc, 0)  if (ci + 5 < 36) GDN_LOAD(rc, vc_, gc, ci + 5)  LDS_BARRIER();
                GDN_FILL(ra, va, ga, 1)  if (ci + 6 < 36) GDN_LOAD(ra, va, ga, ci + 6)  LDS_BARRIER();
                GDN_FILL(rb, vb_, gb, 0)  if (ci + 7 < 36) GDN_LOAD(rb, vb_, gb, ci + 7)  LDS_BARRIER();
                GDN_FILL(rc, vc_, gc, 1)  if (ci + 8 < 36) GDN_LOAD(rc, vc_, gc, ci + 8)  LDS_BARRIER();
                if (ci + 6 < 36) GDN_FILL(ra, va, ga, 0)  if (ci + 9 < 36) GDN_LOAD(ra, va, ga, ci + 9)  LDS_BARRIER();
            }
#undef GDN_LOAD
#undef GDN_FILL
        } else {
            f32x4 S[4];
#pragma unroll
            for (int mt = 0; mt < 4; ++mt) S[mt] = (f32x4){0.f, 0.f, 0.f, 0.f};
            bf16x4 ost[4], onew[4];
#pragma unroll
            for (int mt = 0; mt < 4; ++mt) { ost[mt] = (bf16x4){0, 0, 0, 0}; onew[mt] = (bf16x4){0, 0, 0, 0}; }
            size_t orow = 0;
            bool ohave = false;
            if (__builtin_amdgcn_readfirstlane(wave) < 4) __builtin_amdgcn_s_setprio(3);
            LDS_BARRIER();
            for (int ci = 0; ci < 36; ++ci) {
                if (ohave) {
#pragma unroll
                    for (int mt = 0; mt < 4; ++mt)
                        *(bf16x4*)(U + (orow + 16 * mt + li) * INW + C_GQ + dir * 256 + h * 64 + 16 * sl + 4 * g) = ost[mt];
                }
                const ChunkInfo c = chunk_info<64>(ci, dir, b);
                const bool need_o = !c.isctx || with_ctx;
                const char* bp = smem + (ci & 1) * BUFB;
                const bf16_t* WD = (const bf16_t*)bp;
                const bf16_t* AT = WD + 64 * LS;
                const bf16_t* KT = AT + 64 * LS;
                const bf16_t* QQ = KT + 64 * LS;
                const bf16_t* UVl = QQ + 64 * LS;
                const float* eG = (const float*)(bp + 4 * TILEB + 8192);
                const float* eT = eG + 64;
                const float gt = eG[128];
                u32x2 uvw[4];
                bf16x8 wa[4][2], ka[4][2];
                f32x4 e0[2], e1[2];
#pragma unroll
                for (int mt = 0; mt < 4; ++mt) {
                    uvw[mt] = *(const u32x2*)(UVl + ((mt * 4 + sl) * 64 + lane) * 4);
#pragma unroll
                    for (int s = 0; s < 2; ++s) {
                        wa[mt][s] = *(const bf16x8*)(WD + (16 * mt + li) * LS + 32 * s + 8 * g);
                    }
                }
#pragma unroll
                for (int s = 0; s < 2; ++s) { e0[s] = *(const f32x4*)(eT + 32 * s + 4 * g); e1[s] = *(const f32x4*)(eT + 32 * s + 16 + 4 * g); }
                bf16x8 sf[2];
#pragma unroll
                for (int s = 0; s < 2; ++s) sf[s] = pack8(S[2 * s], S[2 * s + 1]);
                __builtin_amdgcn_sched_barrier(0);
                f32x4 vn[4];
#pragma unroll
                for (int mt = 0; mt < 4; ++mt) {
                    vn[mt] = (f32x4){lo16(uvw[mt][0]), hi16(uvw[mt][0]), lo16(uvw[mt][1]), hi16(uvw[mt][1])};
#pragma unroll
                    for (int s = 0; s < 2; ++s) vn[mt] = MFMA32(wa[mt][s], sf[s], vn[mt]);
                }
#pragma unroll
                for (int mt = 0; mt < 4; ++mt)
#pragma unroll
                    for (int s = 0; s < 2; ++s)
                        ka[mt][s] = *(const bf16x8*)(KT + (16 * mt + li) * LS + 32 * s + 8 * g);
                bf16x8 qa[4][2], aa[4][2];
                float eGc[4];
                if (need_o) {
#pragma unroll
                    for (int mt = 0; mt < 4; ++mt) {
                        eGc[mt] = eG[16 * mt + li];
#pragma unroll
                        for (int s = 0; s < 2; ++s) {
                            qa[mt][s] = *(const bf16x8*)(QQ + (16 * mt + li) * LS + 32 * s + 8 * g);
                            if (!(dir ? (s == 0 && mt >= 2) : (s == 1 && mt < 2)))
                                aa[mt][s] = *(const bf16x8*)(AT + (16 * mt + li) * LS + 32 * s + 8 * g);
                        }
                    }
                }
                __builtin_amdgcn_sched_barrier(0);
                bf16x8 vf[2], vsf[2];
#pragma unroll
                for (int s = 0; s < 2; ++s) {
                    vf[s] = pack8(vn[2 * s], vn[2 * s + 1]);
                    vsf[s] = pack8(vn[2 * s] * e0[s], vn[2 * s + 1] * e1[s]);
                }
#pragma unroll
                for (int mt = 0; mt < 4; ++mt) {
                    f32x4 acc = S[mt] * gt;
#pragma unroll
                    for (int s = 0; s < 2; ++s) acc = MFMA32(ka[mt][s], vsf[s], acc);
                    S[mt] = acc;
                }
                ohave = need_o;
                if (need_o) {
                    orow = c.rowbase + c.t0;
#pragma unroll
                    for (int mt = 0; mt < 4; ++mt) {
                        f32x4 acc = {0.f, 0.f, 0.f, 0.f};
#pragma unroll
                        for (int s = 0; s < 2; ++s) acc = MFMA32(sf[s], qa[mt][s], acc);
                        acc = acc * eGc[mt];
#pragma unroll
                        for (int s = 0; s < 2; ++s)
                            if (!(dir ? (s == 0 && mt >= 2) : (s == 1 && mt < 2))) acc = MFMA32(vf[s], aa[mt][s], acc);
                        onew[mt] = pack4(acc);
                    }
                }
                asm volatile("" :: "v"(ost[0]), "v"(ost[1]), "v"(ost[2]), "v"(ost[3]));
#pragma unroll
                for (int mt = 0; mt < 4; ++mt) ost[mt] = onew[mt];
                LDS_BARRIER();
            }
            if (ohave) {
#pragma unroll
                for (int mt = 0; mt < 4; ++mt)
                    *(bf16x4*)(U + (orow + 16 * mt + li) * INW + C_GQ + dir * 256 + h * 64 + 16 * sl + 4 * g) = ost[mt];
            }
        }
#undef GDN_GI
        __builtin_amdgcn_s_setprio(0);
        LDS_BARRIER();
    }
}

__device__ void phase_swa_mfma(const Params& p, int l, char* smem, int vb, int nvb, int pend, int oz) {
    constexpr int LS = 72;
    constexpr float QSC = 0.125f * 1.4426950408889634f;
    const int hb = __builtin_amdgcn_readfirstlane((int)((threadIdx.x + oz) >> 8));
    smem += hb * (2 * 64 * LS * 2);
    bf16_t* Kl = (bf16_t*)smem;
    bf16_t* Vl = Kl + 64 * LS;
    bf16_t* U = (bf16_t*)(p.ws + OFF_U);
    const int tid = (threadIdx.x + oz) & 255, lane = tid & 63, wave = __builtin_amdgcn_readfirstlane(tid >> 6), g = lane >> 4, li = lane & 15;
    const int q4 = li >> 2, p4 = li & 3;
    const int fr = tid >> 2, fj = tid & 3;
    const bool with_ctx = l < 3;
    const int nlat = 8 * 2 * 32, nctx = with_ctx ? 8 * 2 * 4 : 0;
    float invq[8], invk[8];
#pragma unroll
    for (int j = 0; j < 8; ++j) {
        invq[j] = expf(-(float)((8 * g + j) & 15) * (9.210340371976184f / 16.f)) * 0.15915494309189535f;
        invk[j] = expf(-(float)((8 * fj + j) & 15) * (9.210340371976184f / 16.f)) * 0.15915494309189535f;
    }
    for (int pair = vb; pair < pend; pair += nvb) {
        const int it = 2 * pair + hb;
        const bool cq = it >= nlat;
        const int id = cq ? it - nlat : it;
        int qt, kvh, b;
        if (!cq) { qt = id & 31; kvh = (id >> 5) & 1; b = id >> 6; }
        else     { qt = id & 3;  kvh = (id >> 2) & 1; b = id >> 3; }
        const int hq = kvh * 2 + (wave >> 1), qsub = wave & 1;
        const size_t qbase = cq ? (size_t)LAT + (size_t)b * LC : (size_t)b * T;
        bf16x8 qf[2][2];
#pragma unroll
        for (int qt2 = 0; qt2 < 2; ++qt2) {
            const int tq = qt * 64 + 32 * qsub + 16 * qt2 + li;
            const bf16_t* qp = U + (qbase + tq) * INW + C_SQ + hq * 64 + 8 * g;
            const u32x4 r0 = *(const u32x4*)qp, r1 = *(const u32x4*)(qp + 32);
            float x1[8], x2[8];
#pragma unroll
            for (int w = 0; w < 4; ++w) {
                x1[2 * w] = lo16(r0[w]); x1[2 * w + 1] = hi16(r0[w]);
                x2[2 * w] = lo16(r1[w]); x2[2 * w + 1] = hi16(r1[w]);
            }
            if (!cq) {
                const float pos = (g < 2) ? (float)(tq >> 6) : (float)(tq & 63);
#pragma unroll
                for (int j = 0; j < 8; ++j) {
                    float rev = pos * invq[j];
                    rev -= floorf(rev);
                    const float cs = __builtin_amdgcn_cosf(rev), sn = __builtin_amdgcn_sinf(rev);
                    const float a1 = x1[j], a2 = x2[j];
                    x1[j] = a1 * cs - a2 * sn;
                    x2[j] = a1 * sn + a2 * cs;
                }
            }
            u32x4 o1, o2;
#pragma unroll
            for (int w = 0; w < 4; ++w) {
                o1[w] = cvt_pk(x1[2 * w] * QSC, x1[2 * w + 1] * QSC);
                o2[w] = cvt_pk(x2[2 * w] * QSC, x2[2 * w + 1] * QSC);
            }
            qf[qt2][0] = __builtin_bit_cast(bf16x8, o1);
            qf[qt2][1] = __builtin_bit_cast(bf16x8, o2);
        }
        float m[2] = {-1e30f, -1e30f}, lsum[2] = {0.f, 0.f};
        f32x4 O[4][2];
#pragma unroll
        for (int dt = 0; dt < 4; ++dt)
#pragma unroll
            for (int qt2 = 0; qt2 < 2; ++qt2) O[dt][qt2] = (f32x4){0.f, 0.f, 0.f, 0.f};
        const int nloc = cq ? 0 : 5;
        u32x4 pk0, pk1, pv0, pv1;
#define SWA_TILE(ti_, kctx_, ktile_, oob_)                                                      \
        const bool kctx_ = (ti_) >= nloc;                                                       \
        int ktile_ = kctx_ ? (ti_) - nloc : qt + (((ti_) == 0) ? 0 : ((ti_) == 1) ? -1 : ((ti_) == 2) ? 1 : ((ti_) == 3) ? -2 : 2); \
        const bool oob_ = !kctx_ && (ktile_ < 0 || ktile_ >= 32);                               \
        ktile_ = oob_ ? qt : ktile_;
#define SWA_PREFETCH(ti_)                                                                       \
        {                                                                                       \
            SWA_TILE((ti_), kc_, kt_, ob_)                                                      \
            const int tk_ = kt_ * 64 + fr;                                                      \
            const size_t krow_ = kc_ ? (size_t)LAT + (size_t)b * LC + tk_ : (size_t)b * T + tk_; \
            const bf16_t* kp_ = U + krow_ * INW + C_SK + kvh * 64 + 8 * fj;                     \
            const bf16_t* vp_ = U + krow_ * INW + C_SV + kvh * 64 + 8 * fj;                     \
            pk0 = *(const u32x4*)kp_; pk1 = *(const u32x4*)(kp_ + 32);                          \
            pv0 = *(const u32x4*)vp_; pv1 = *(const u32x4*)(vp_ + 32);                          \
        }
        SWA_PREFETCH(0)
        for (int ti = 0; ti < nloc + 4; ++ti) {
            SWA_TILE(ti, kctx, ktile, oob)
            const bool edge = !kctx && (ti >= 3 || oob);
            __syncthreads();
            {
                const int tk = ktile * 64 + fr;
                const u32x4 k0 = pk0, k1 = pk1, v0 = pv0, v1 = pv1;
                u32x4 o1 = k0, o2 = k1;
                if (!kctx) {
                    const float pos = (fj < 2) ? (float)(tk >> 6) : (float)(tk & 63);
                    float x1[8], x2[8];
#pragma unroll
                    for (int w = 0; w < 4; ++w) {
                        x1[2 * w] = lo16(k0[w]); x1[2 * w + 1] = hi16(k0[w]);
                        x2[2 * w] = lo16(k1[w]); x2[2 * w + 1] = hi16(k1[w]);
                    }
#pragma unroll
                    for (int j = 0; j < 8; ++j) {
                        float rev = pos * invk[j];
                        rev -= floorf(rev);
                        const float cs = __builtin_amdgcn_cosf(rev), sn = __builtin_amdgcn_sinf(rev);
                        const float a1 = x1[j], a2 = x2[j];
                        x1[j] = a1 * cs - a2 * sn;
                        x2[j] = a1 * sn + a2 * cs;
                    }
#pragma unroll
                    for (int w = 0; w < 4; ++w) {
                        o1[w] = cvt_pk(x1[2 * w], x1[2 * w + 1]);
                        o2[w] = cvt_pk(x2[2 * w], x2[2 * w + 1]);
                    }
                }
                *(u32x4*)(Kl + fr * LS + 8 * fj) = o1;
                *(u32x4*)(Kl + fr * LS + 32 + 8 * fj) = o2;
                *(u32x4*)(Vl + fr * LS + 8 * fj) = v0;
                *(u32x4*)(Vl + fr * LS + 32 + 8 * fj) = v1;
            }
            __syncthreads();
            if (ti + 1 < nloc + 4) SWA_PREFETCH(ti + 1)
            f32x4 st[4][2];
#pragma unroll
            for (int km = 0; km < 4; ++km) {
                bf16x8 ka[2];
#pragma unroll
                for (int ks = 0; ks < 2; ++ks) ka[ks] = *(const bf16x8*)(Kl + (16 * km + li) * LS + 32 * ks + 8 * g);
#pragma unroll
                for (int qt2 = 0; qt2 < 2; ++qt2) {
                    f32x4 acc = {0.f, 0.f, 0.f, 0.f};
#pragma unroll
                    for (int ks = 0; ks < 2; ++ks) acc = MFMA32(ka[ks], qf[qt2][ks], acc);
                    st[km][qt2] = acc;
                }
            }
            if (edge) {
#pragma unroll
                for (int qt2 = 0; qt2 < 2; ++qt2) {
                    const int tq = qt * 64 + 32 * qsub + 16 * qt2 + li;
#pragma unroll
                    for (int km = 0; km < 4; ++km)
#pragma unroll
                        for (int r = 0; r < 4; ++r) {
                            int dlt = ktile * 64 + 16 * km + 4 * g + r - tq;
                            dlt = dlt < 0 ? -dlt : dlt;
                            st[km][qt2][r] = (dlt <= 128 && !oob) ? st[km][qt2][r] : -1e30f;
                        }
                }
            }
            bf16x8 pf[2][2];
#pragma unroll
            for (int qt2 = 0; qt2 < 2; ++qt2) {
                float mx = st[0][qt2][0];
#pragma unroll
                for (int km = 0; km < 4; ++km)
#pragma unroll
                    for (int r = 0; r < 4; ++r) mx = fmaxf(mx, st[km][qt2][r]);
                mx = fmaxf(mx, __shfl_xor(mx, 16));
                mx = fmaxf(mx, __shfl_xor(mx, 32));
                const float mn = fmaxf(m[qt2], mx);
                const float sc = fexp2(m[qt2] - mn);
                m[qt2] = mn;
                float ps = 0.f;
#pragma unroll
                for (int km = 0; km < 4; ++km)
#pragma unroll
                    for (int r = 0; r < 4; ++r) {
                        const float pv = fexp2(st[km][qt2][r] - mn);
                        st[km][qt2][r] = pv;
                        ps += pv;
                    }
                lsum[qt2] = lsum[qt2] * sc + ps;
#pragma unroll
                for (int dt = 0; dt < 4; ++dt) O[dt][qt2] = O[dt][qt2] * sc;
                pf[qt2][0] = pack8(st[0][qt2], st[1][qt2]);
                pf[qt2][1] = pack8(st[2][qt2], st[3][qt2]);
            }
#pragma unroll
            for (int dt = 0; dt < 4; ++dt)
#pragma unroll
                for (int ks = 0; ks < 2; ++ks) {
                    const bf16x8 va = cat8(lds_tr(Vl + (32 * ks + 4 * g + q4) * LS + 16 * dt + 4 * p4),
                                           lds_tr(Vl + (32 * ks + 16 + 4 * g + q4) * LS + 16 * dt + 4 * p4));
#pragma unroll
                    for (int qt2 = 0; qt2 < 2; ++qt2) O[dt][qt2] = MFMA32(va, pf[qt2][ks], O[dt][qt2]);
                }
        }
#undef SWA_TILE
#undef SWA_PREFETCH
        const float snk = p.in[I_SINK][l * 4 + hq] * 1.4426950408889634f;
#pragma unroll
        for (int qt2 = 0; qt2 < 2; ++qt2) {
            float ls = lsum[qt2];
            ls += __shfl_xor(ls, 16);
            ls += __shfl_xor(ls, 32);
            const float mn = fmaxf(m[qt2], snk);
            const float s1 = fexp2(m[qt2] - mn);
            const float inv = s1 / (ls * s1 + fexp2(snk - mn));
            const int tq = qt * 64 + 32 * qsub + 16 * qt2 + li;
            bf16_t* zp = U + (qbase + tq) * INW + C_SZ + hq * 64 + 4 * g;
#pragma unroll
            for (int dt = 0; dt < 4; ++dt) {
                const u32x2 zv = *(const u32x2*)(zp + 16 * dt);
                u32x2 yv;
                yv[0] = cvt_pk(O[dt][qt2][0] * inv * siluf_(lo16(zv[0])), O[dt][qt2][1] * inv * siluf_(hi16(zv[0])));
                yv[1] = cvt_pk(O[dt][qt2][2] * inv * siluf_(lo16(zv[1])), O[dt][qt2][3] * inv * siluf_(hi16(zv[1])));
                *(u32x2*)(zp + 16 * dt) = yv;
            }
        }
    }
}


__device__ void phase_finish(const Params& p, int l, char* smem, int vb, int nvb, int oz) {
    bf16_t* U = (bf16_t*)(p.ws + OFF_U);
    const bf16_t* PF = (const bf16_t*)(p.ws + OFF_P);
    const int tid = threadIdx.x + oz, lane = tid & 63, wave = __builtin_amdgcn_readfirstlane(tid >> 6);
    const int nrows = (l < 3) ? NROW : LAT;
    const int per = (nrows + nvb * 8 - 1) / (nvb * 8);
    const int rbeg = (vb * 8 + wave) * per, rend = (rbeg + per < nrows) ? rbeg + per : nrows;
    if (rbeg >= nrows) return;
    const float4 ng = *(const float4*)(p.in[I_GNG] + l * 64 + (lane & 15) * 4);
    u32x2 nl[6];
#define F_LOAD(row_)                                                               \
    {                                                                              \
        const size_t r_ = (size_t)(row_);                                          \
        const bf16_t* ur_ = U + r_ * INW;                                          \
        nl[0] = *(const u32x2*)(ur_ + C_LRUX + lane * 4);                          \
        nl[1] = *(const u32x2*)(ur_ + C_GQ + 512 + lane * 4);                      \
        nl[2] = *(const u32x2*)(ur_ + C_GQ + lane * 4);                            \
        nl[3] = *(const u32x2*)(ur_ + C_GQ + 256 + lane * 4);                      \
        nl[4] = *(const u32x2*)(ur_ + C_GZ + lane * 4);                            \
        nl[5] = *(const u32x2*)(ur_ + C_RZ + lane * 4);                            \
    }
    F_LOAD(rbeg)
    for (int row = rbeg; row < rend; ++row) {
        bf16_t* ur = U + (size_t)row * INW;
        const u32x2 rf = nl[0], rb = nl[1], gf = nl[2], gb = nl[3], zg = nl[4], zr = nl[5];
        if (row + 1 < rend) F_LOAD(row + 1)
        {
            const float o0 = lo16(gf[0]) + lo16(gb[0]), o1 = hi16(gf[0]) + hi16(gb[0]);
            const float o2 = lo16(gf[1]) + lo16(gb[1]), o3 = hi16(gf[1]) + hi16(gb[1]);
            float ss = o0 * o0 + o1 * o1 + o2 * o2 + o3 * o3;
            ss += __shfl_xor(ss, 1); ss += __shfl_xor(ss, 2); ss += __shfl_xor(ss, 4); ss += __shfl_xor(ss, 8);
            const float rs = rsqrtf(ss * (1.f / 64.f) + EPS);
            u32x2 y;
            y[0] = cvt_pk(o0 * rs * ng.x * siluf_(lo16(zg[0])), o1 * rs * ng.y * siluf_(hi16(zg[0])));
            y[1] = cvt_pk(o2 * rs * ng.z * siluf_(lo16(zg[1])), o3 * rs * ng.w * siluf_(hi16(zg[1])));
            *(u32x2*)(ur + C_GZ + lane * 4) = y;
        }
        {
            const float o0 = lo16(rf[0]) + lo16(rb[0]), o1 = hi16(rf[0]) + hi16(rb[0]);
            const float o2 = lo16(rf[1]) + lo16(rb[1]), o3 = hi16(rf[1]) + hi16(rb[1]);
            float s1 = o0 + o1 + o2 + o3;
            s1 += __shfl_xor(s1, 1); s1 += __shfl_xor(s1, 2); s1 += __shfl_xor(s1, 4); s1 += __shfl_xor(s1, 8);
            const float mu = s1 * (1.f / 64.f);
            const float d0 = o0 - mu, d1 = o1 - mu, d2 = o2 - mu, d3 = o3 - mu;
            float s2 = d0 * d0 + d1 * d1 + d2 * d2 + d3 * d3;
            s2 += __shfl_xor(s2, 1); s2 += __shfl_xor(s2, 2); s2 += __shfl_xor(s2, 4); s2 += __shfl_xor(s2, 8);
            const float rs = rsqrtf(s2 * (1.f / 64.f) + EPS);
            u32x2 y;
            y[0] = cvt_pk(d0 * rs * siluf_(lo16(zr[0])), d1 * rs * siluf_(hi16(zr[0])));
            y[1] = cvt_pk(d2 * rs * siluf_(lo16(zr[1])), d3 * rs * siluf_(hi16(zr[1])));
            *(u32x2*)(ur + C_RZ + lane * 4) = y;
        }
    }
#undef F_LOAD
}

#include <hip/hip_cooperative_groups.h>
namespace cg = cooperative_groups;


struct XcdBarrier { unsigned* bar; unsigned x; volatile XB_LAS unsigned* st; };
__device__ __forceinline__ XcdBarrier xcd_barrier_post(unsigned* bar, volatile XB_LAS unsigned* st) {
    XcdBarrier b; b.bar = bar; b.x = xb_xcc_id(); b.st = st;
    if (threadIdx.x == 0) (void)xb_add(&bar[XB_XCNT(b.x)], 1u);
    return b;
}
__device__ __forceinline__ void xcd_barrier_complete(unsigned* bar, unsigned x, unsigned& nloc, unsigned& nx) {
    const unsigned G = gridDim.x * gridDim.y * gridDim.z;
    unsigned sum, cnt, mine, sp = 0u;
    for (;;) {
        sum = 0u; cnt = 0u; mine = 0u;
#pragma unroll
        for (unsigned j = 0; j < 16; ++j) { const unsigned c = xb_ld(&bar[XB_XCNT(j)]); sum += c; cnt += (c > 0u) ? 1u : 0u; mine = (j == x) ? c : mine; }
        if (sum == G) break;
        __builtin_amdgcn_s_sleep(1);
        if ((++sp & 255u) == 0u) { if (xb_ld(&bar[XB_TMO])) break; if (sp > XB_SPIN_CAP) { atomicAdd(&bar[XB_TMO], 1u); break; } }
    }
    nloc = mine > 0u ? mine : 1u; nx = cnt > 0u ? cnt : 1u;
}
__device__ __forceinline__ void xcd_barrier(const XcdBarrier& b) {
    asm volatile("s_waitcnt vmcnt(0)" ::: "memory");
    __syncthreads();
    if (threadIdx.x == 0) {
        unsigned* bar = b.bar;
        __builtin_amdgcn_s_waitcnt(0);
        unsigned nloc = b.st[0], nx = b.st[1];
        if (nloc == 0u) { xcd_barrier_complete(bar, b.x, nloc, nx); b.st[0] = nloc; b.st[1] = nx; }
        const unsigned old = xb_add(&bar[XB_XSUB(b.x)], 1u);
        const unsigned gen = old / nloc;
        if (old + 1u == (gen + 1u) * nloc) {
            __builtin_amdgcn_fence(__ATOMIC_RELEASE, "agent");
            asm volatile("s_waitcnt vmcnt(0)" ::: "memory");
            const unsigned og = xb_add(&bar[XB_TOP], 1u);
            const unsigned tg = og / nx;
            if (og + 1u == (tg + 1u) * nx) xb_add(&bar[XB_TOPGEN], 1u);
            else XB_SPIN(xb_ld(&bar[XB_TOPGEN]) == tg, bar);
            __builtin_amdgcn_fence(__ATOMIC_ACQUIRE, "agent");
            xb_add(&bar[XB_XGEN(b.x)], 1u);
            asm volatile("s_waitcnt vmcnt(0)" ::: "memory");
        } else {
            XB_SPIN(xb_ld(&bar[XB_XGEN(b.x)]) == gen, bar);
            __builtin_amdgcn_fence(__ATOMIC_ACQUIRE, "agent");
            asm volatile("s_waitcnt vmcnt(0)" ::: "memory");
        }
    }
    __syncthreads();
}

constexpr int SMEM_BYTES = 128 * 1024 + 16;

__global__ void __launch_bounds__(NT) fwd_megakernel(Params p) {
    extern __shared__ __attribute__((aligned(16))) char smem[];
    cg::grid_group grid = cg::this_grid();
    const int nvb = gridDim.x;
    volatile XB_LAS unsigned* xst = (volatile XB_LAS unsigned*)(smem + 128 * 1024);
    if (threadIdx.x == 0) { xst[0] = 0u; xst[1] = 0u; }
    __syncthreads();
    const XcdBarrier xb = xcd_barrier_post((unsigned*)(p.ws + OFF_BAR), xst);
    if (p.ws == nullptr) grid.sync();
    const int cgrp = nvb - 32;
#pragma clang loop unroll(disable)
    for (int ph = -1; ph <= 24; ++ph) {
        int oz = 0, vb = blockIdx.x, l = (ph < 0) ? 0 : ph / 6, q = (ph < 0) ? 6 : ph % 6;
        asm volatile("" : "+v"(oz));
        asm volatile("" : "+s"(vb));
        asm volatile("" : "+s"(l));
        asm volatile("" : "+s"(q));
        const bool split = CTX_SPLIT && (l >= 1) && (l <= 3);
        const bool cblk = split && (vb >= cgrp);
#if defined(PROBE_Q) || defined(PROBE_CLS) || defined(PROBE_M2)
        const unsigned long long t_in = __builtin_amdgcn_s_memrealtime();
#endif
        if ((q == 0 && cblk) || q == 5) {
            const bool cg_ = (q == 0);
            g8::gemm_phase<true>(p, cg_ ? l - 1 : l, smem, cg_ ? vb - cgrp : vb, cg_ ? 32 : nvb, cg_ ? LAT / 256 : 0, cg_ ? Bsz * LC : (CTX_SPLIT || l == 3) ? LAT : NROW);
        }
        if (q == 2 || (q == 3 && vb >= 128)) {
            const int nsw = (l < 3) ? 288 : 256, nsw1 = (l < 3) ? 160 : 128;
            const int s0 = (q == 2) ? vb : nsw1 + (vb - 128);
            const int s1 = (q == 2) ? ((vb < nsw1) ? vb + 1 : vb) : ((s0 + 1 < nsw) ? s0 + 1 : nsw);
            phase_swa_mfma(p, l, smem, s0, 1, s1, oz);
            __syncthreads();
        }
        if (q == 0) {
            if (cblk) {
                unsigned* bar = (unsigned*)(p.ws + OFF_BAR);
                asm volatile("s_waitcnt vmcnt(0)" ::: "memory");
                __syncthreads();
                if (threadIdx.x == 0) {
                    __builtin_amdgcn_fence(__ATOMIC_RELEASE, "agent");
                    asm volatile("s_waitcnt vmcnt(0)" ::: "memory");
                    xb_add(&bar[192], 1u);
                }
            }
            phase_E_rows(p, l, smem, vb, nvb, split, (l == 4) ? LAT : NROW, oz);
            if (l == 4) break;
        } else if (q == 1) {
            g8::gemm_phase<false>(p, l, smem, vb, nvb, 0, NROW);
        } else if (q == 2) {
            const int cls = (vb < 160) ? 0 : (vb < 224) ? 1 : 2;
            const int g0 = (cls == 0) ? 2 * vb : (cls == 1) ? 320 + 3 * (vb - 160) : 512 + 2 * (vb - 224);
            const int g1 = g0 + ((cls == 1) ? 3 : 2);
            phase_gdn_prep(p, l, smem, g0, 1, g1, oz);
            __syncthreads();
            const int n = vb & 3;
            int m0, mc;
            if (cls == 0) { const int j = vb >> 2; if (j < 26) { m0 = 3 * j; mc = 3; } else { m0 = 78 + 2 * (j - 26); mc = 2; } }
            else if (cls == 1) { const int j = (vb - 160) >> 2; if (j < 6) { m0 = 106 + 7 * j; mc = 7; } else { m0 = 148 + 6 * (j - 6); mc = 6; } }
            else { const int j = (vb - 224) >> 2; m0 = 208 + 10 * j; mc = 10; }
            lru_loop<0>(p, l, smem, n + 4 * m0, n + 4 * (m0 + mc), 4, false, oz);
#ifdef PROBE_CLS
            if (cls == PROBE_CLS) {
                __syncthreads();
                const unsigned long long t1 = __builtin_amdgcn_s_memrealtime(), d = (t1 - t_in) * PROBE_K;
                while (__builtin_amdgcn_s_memrealtime() - t1 < d) __builtin_amdgcn_s_sleep(8);
            }
#endif
        } else if (q == 3) {
            if (vb < 64) phase_gdn_chain(p, l, smem, vb, 64, oz);
            else if (vb < 128) phase_ret_chain(p, l, smem, vb - 64, 64, oz);
            else {
                lru_passC(p, l, smem, vb - 128, (l < 3) ? 1152 : 1024, nvb - 128, l == 3, oz);
                __syncthreads();
                if (l < 3) wconv_loop(p, l + 1, vb - 128, WCONV_TILES, nvb - 128, smem, oz);
            }
#ifdef PROBE_M2
            if ((vb < 64 ? 0 : vb < 128 ? 1 : 2) == PROBE_M2) {
                __syncthreads();
                const unsigned long long t1 = __builtin_amdgcn_s_memrealtime(), d = (t1 - t_in) * PROBE_K;
                while (__builtin_amdgcn_s_memrealtime() - t1 < d) __builtin_amdgcn_s_sleep(8);
            }
#endif
        } else if (q == 4) {
            phase_finish(p, l, smem, vb, nvb, oz);
        } else if (q == 6) {
            phase_prep(p, smem, vb, nvb, oz);
        }
        xcd_barrier(xb);
#ifdef PROBE_Q
        if (q == PROBE_Q) {
            const unsigned long long t1 = __builtin_amdgcn_s_memrealtime(), d = (t1 - t_in) * PROBE_K;
            while (__builtin_amdgcn_s_memrealtime() - t1 < d) __builtin_amdgcn_s_sleep(8);
        }
#endif
    }
}

extern "C" void kernel_launch(void* const* d_in, const int* in_sizes, int n_in, void* d_out, int out_size, void* d_ws,
                              size_t ws_size, hipStream_t stream) {
    static int grid_blocks = 0;
    if (grid_blocks == 0) {
        if (n_in != 23 || ws_size < WS_END) {
            fprintf(stderr, "kernel_launch: unexpected n_in %d or ws_size %zu (< %zu)\n", n_in, ws_size, (size_t)WS_END);
            grid_blocks = -1;
            return;
        }
        int dev = 0, cus = 0, per_cu = 0;
        (void)hipGetDevice(&dev);
        (void)hipDeviceGetAttribute(&cus, hipDeviceAttributeMultiprocessorCount, dev);
        (void)hipFuncSetAttribute((const void*)fwd_megakernel, hipFuncAttributeMaxDynamicSharedMemorySize, SMEM_BYTES);
        (void)hipOccupancyMaxActiveBlocksPerMultiprocessor(&per_cu, fwd_megakernel, NT, SMEM_BYTES);
        if (per_cu < 1) per_cu = 1;
        if (per_cu > 1) per_cu = 1;
        grid_blocks = cus * per_cu;
        fprintf(stderr, "kernel_launch: cus %d per_cu %d grid %d\n", cus, per_cu, grid_blocks);
    }
    if (grid_blocks < 0) return;
    Params p{};
    for (int i = 0; i < 23; ++i) p.in[i] = (const float*)d_in[i];
    p.out = (float*)d_out;
    p.ws = (unsigned char*)d_ws;
    (void)hipMemsetAsync((unsigned char*)d_ws + OFF_BAR, 0, XCD_BAR_WORDS * 4, stream);
    void* args[] = {&p};
    hipError_t e = hipLaunchCooperativeKernel((void*)fwd_megakernel, dim3(grid_blocks), dim3(NT), args, SMEM_BYTES, stream);
    if (e != hipSuccess) fprintf(stderr, "cooperative launch failed: %s (grid %d)\n", hipGetErrorString(e), grid_blocks);
}
```

```cpp
#include <hip/hip_runtime.h>
#include <hip/hip_bf16.h>
#include <cstdio>
#include <cstdint>

typedef unsigned short bf16_t;
typedef __attribute__((ext_vector_type(8))) short bf16x8;
typedef __attribute__((ext_vector_type(4))) float f32x4;
typedef __attribute__((ext_vector_type(4))) short bf16x4;
typedef __attribute__((ext_vector_type(4))) unsigned u32x4;
typedef __attribute__((ext_vector_type(2))) unsigned u32x2;
typedef __attribute__((ext_vector_type(2))) float f32x2;
typedef __attribute__((ext_vector_type(2))) __bf16 bf16v2;

#define NT 512
#define CTX_SPLIT 1
#define PROBE_K 4
constexpr int Bsz = 8, T = 2048, LC = 256, DM = 1024, INW = 3344, NPAD = 3584;
constexpr int LDU = 3392;
constexpr int LAT = Bsz * T, NROW = LAT + Bsz * LC;
constexpr int C_LRUX = 0, C_LRUZ = 256, C_GQ = 512, C_GZ = 1280, C_GA = 3328, C_GB = 3336;
constexpr int C_RQ = 1536, C_RK = 1792, C_RV = 2048, C_RZ = 2304, C_SQ = 2560, C_SK = 2816, C_SV = 2944, C_SZ = 3072;
__device__ __forceinline__ int win_src_col(int n) { return (n < 1536) ? n : (n < 3328) ? n + 16 : n - 3328 + 1536; }
constexpr float EPS = 1e-6f;

enum { I_X = 0, I_C, I_CTX, I_CCTX, I_WMOD, I_BMOD, I_PREG, I_POSTG, I_WIN, I_WOUT, I_LCW, I_LCB, I_LWR, I_LBR, I_LWI, I_LBI,
       I_LLAM, I_GCW, I_GALOG, I_GDT, I_GNG, I_RDEC, I_SINK };

constexpr int GI = 8 * 4 * 36;
constexpr size_t OFF_MOD = 0;
constexpr size_t OFF_WINT = 1u << 19;
constexpr size_t SZ_WINT = (size_t)NPAD * DM * 2;
constexpr size_t OFF_WOUTT = OFF_WINT + SZ_WINT;
constexpr size_t SZ_WOUTT = (size_t)DM * DM * 2;
constexpr size_t OFF_U = OFF_WOUTT + 2 * SZ_WOUTT;
constexpr size_t SZ_U = (size_t)NROW * LDU * 2;
constexpr size_t OFF_P = OFF_U + SZ_U;
constexpr size_t SZ_P = (size_t)NROW * DM * 2;
constexpr size_t OFF_XC = OFF_P + SZ_P;
constexpr size_t SZ_XC = (size_t)Bsz * LC * DM * 4;
constexpr size_t SZ_GT = (size_t)GI * 4096 * 2;
constexpr size_t OFF_GQ = OFF_XC + SZ_XC;
constexpr size_t OFF_GKT = OFF_GQ + SZ_GT;
constexpr size_t OFF_GWD = OFF_GKT + SZ_GT;
constexpr size_t OFF_GUV = OFF_GWD + 2 * SZ_GT;
constexpr size_t OFF_GATT = OFF_GUV + 2 * SZ_GT;
constexpr size_t OFF_GVEC = OFF_GATT + 2 * SZ_GT;
constexpr size_t OFF_AGG = OFF_GVEC + (size_t)2 * GI * 256 * 4;
constexpr size_t OFF_XS = OFF_AGG + (size_t)8 * 2 * 36 * 256 * 8;
constexpr size_t WS_END = OFF_XS + (size_t)64 * 256 * 4 * 4;
constexpr size_t SZ_T = (size_t)NROW * 256 * 2;
static_assert(4 * SZ_T <= SZ_P, "chain outputs must fit in P");

struct Params {
    const float* in[23];
    float* out;
    unsigned char* ws;
};

__device__ __forceinline__ float bf2f(bf16_t v) { return __uint_as_float(((unsigned)v) << 16); }
__device__ __forceinline__ bf16_t f2bf(float f) {
    unsigned u = __float_as_uint(f);
    u += 0x7fffu + ((u >> 16) & 1u);
    return (bf16_t)(u >> 16);
}
__device__ __forceinline__ float fexp(float x) { return __builtin_amdgcn_exp2f(x * 1.4426950408889634f); }
__device__ __forceinline__ float fexp2(float x) { return __builtin_amdgcn_exp2f(x); }
__device__ __forceinline__ float sigmoidf_(float x) { return __builtin_amdgcn_rcpf(1.f + fexp(-x)); }
__device__ __forceinline__ float siluf_(float x) { return x * __builtin_amdgcn_rcpf(1.f + fexp(-x)); }
__device__ __forceinline__ float softplusf_(float x) { return x > 20.f ? x : 0.6931471805599453f * __builtin_amdgcn_logf(1.f + fexp(x)); }
__device__ __forceinline__ float wave_sum(float v) {
#pragma unroll
    for (int o = 32; o >= 1; o >>= 1) v += __shfl_xor(v, o);
    return v;
}
#define LDS_BARRIER() asm volatile("s_waitcnt lgkmcnt(0)\n\ts_barrier" ::: "memory")
#define MFMA32(a, b, c) __builtin_amdgcn_mfma_f32_16x16x32_bf16((a), (b), (c), 0, 0, 0)
#define MFMA16(a, b, c) __builtin_amdgcn_mfma_f32_16x16x16bf16_1k((a), (b), (c), 0, 0, 0)
__device__ __forceinline__ unsigned cvt_pk(float lo, float hi) {
    const f32x2 v = {lo, hi};
    const bf16v2 b = __builtin_convertvector(v, bf16v2);
    return __builtin_bit_cast(unsigned, b);
}
__device__ __forceinline__ bf16x8 pack8(f32x4 a, f32x4 b) {
    u32x4 u = {cvt_pk(a[0], a[1]), cvt_pk(a[2], a[3]), cvt_pk(b[0], b[1]), cvt_pk(b[2], b[3])};
    return __builtin_bit_cast(bf16x8, u);
}
__device__ __forceinline__ bf16x4 pack4(f32x4 a) {
    u32x2 u = {cvt_pk(a[0], a[1]), cvt_pk(a[2], a[3])};
    return __builtin_bit_cast(bf16x4, u);
}
__device__ __forceinline__ bf16x8 cat8(bf16x4 a, bf16x4 b) { return __builtin_shufflevector(a, b, 0, 1, 2, 3, 4, 5, 6, 7); }
__device__ __forceinline__ bf16x4 lds_tr(const bf16_t* p) {
    return __builtin_amdgcn_ds_read_tr16_b64_v4i16((__attribute__((address_space(3))) bf16x4*)p);
}
__device__ __forceinline__ int permcol(int x) { return (x & ~31) | (((x >> 2) & 3) << 3) | (((x >> 4) & 1) << 2) | (x & 3); }
typedef __attribute__((ext_vector_type(2))) _Float16 f16v2;
__device__ __forceinline__ unsigned pk_h2(float a, float b) { const f16v2 v = {(_Float16)a, (_Float16)b}; return __builtin_bit_cast(unsigned, v); }
__device__ __forceinline__ float h_lo(unsigned u) { return (float)__builtin_bit_cast(f16v2, u)[0]; }
__device__ __forceinline__ float h_hi(unsigned u) { return (float)__builtin_bit_cast(f16v2, u)[1]; }
__device__ __forceinline__ void st_wt8(void* p, u32x2 v) {
    __hip_atomic_store((__attribute__((address_space(1))) unsigned long long*)p, (unsigned long long)v[0] | ((unsigned long long)v[1] << 32), __ATOMIC_RELAXED, __HIP_MEMORY_SCOPE_AGENT);
}
__device__ __forceinline__ float lo16(unsigned u) { return __uint_as_float(u << 16); }
__device__ __forceinline__ float hi16(unsigned u) { return __uint_as_float(u & 0xffff0000u); }

#define XB_TMO      128
#define XB_XCNT(j)  (256  + 64 * (j))
#define XB_XSUB(j)  (1280 + 64 * (j))
#define XB_XGEN(j)  (2304 + 64 * (j))
#define XB_TOP      3328
#define XB_TOPGEN   3392
#define XCD_BAR_WORDS 3456
#define XB_SPIN_CAP (1u << 18)
#define XB_LAS __attribute__((address_space(3)))
#define XB_PCNT(pm) (XCD_BAR_WORDS + 64 * (pm))
#define XB_YCNT(pm) (XCD_BAR_WORDS + 64 * 64 + 72 * 64 + 64 * (pm))
#define XB_FCNT(pm) (XCD_BAR_WORDS + 64 * 64 + 64 * (pm))
constexpr size_t OFF_BAR = 450560;
constexpr int BAR_WORDS_TOTAL = XCD_BAR_WORDS + 64 * 64 + 72 * 64 + 72 * 64;
static_assert(OFF_BAR + BAR_WORDS_TOTAL * 4 <= OFF_WINT && OFF_BAR >= 4 * 9 * 3072 * 4, "barrier words placement");
__device__ __forceinline__ unsigned xb_ld(unsigned* p)              { return __hip_atomic_load(p, __ATOMIC_RELAXED, __HIP_MEMORY_SCOPE_AGENT); }
__device__ __forceinline__ unsigned xb_add(unsigned* p, unsigned v) { return __hip_atomic_fetch_add(p, v, __ATOMIC_RELAXED, __HIP_MEMORY_SCOPE_AGENT); }
__device__ __forceinline__ unsigned xb_xcc_id() { return (unsigned)__builtin_amdgcn_s_getreg((3 << 11) | 20) & 0xFu; }
#define XB_SPIN(cond, bar) do { unsigned _sp = 0; while (cond) { __builtin_amdgcn_s_sleep(1); \
    if ((++_sp & 255u) == 0u) { if (xb_ld(&(bar)[XB_TMO])) break; if (_sp > XB_SPIN_CAP) { atomicAdd(&(bar)[XB_TMO], 1u); break; } } } } while (0)

__device__ void phase_prep_mod(const Params& p, char* smem, int it, int oz) {
    const int tid = (threadIdx.x + oz) & 511;
    float* mod = (float*)(p.ws + OFF_MOD);
    float* s = (float*)smem;
    float* red = s + 9 * 1024;
    const int l = it / 48, cgp = it % 48;
    {
        float cv[18];
#pragma unroll
        for (int j = 0; j < 18; ++j) {
            const int r = j >> 1, k = (j & 1) * 512 + tid;
            cv[j] = (r < 8) ? p.in[I_C][r * 1024 + k] : p.in[I_CCTX][k];
        }
#pragma unroll
        for (int j = 0; j < 18; ++j) s[(j >> 1) * 1024 + (j & 1) * 512 + tid] = siluf_(cv[j]);
    }
    __syncthreads();
    const int c4 = tid & 15, ks = tid >> 4;
    const float* w = p.in[I_WMOD] + (size_t)l * 1024 * 3072 + (size_t)(ks * 32) * 3072 + cgp * 64 + 4 * c4;
    f32x4 acc[9];
#pragma unroll
    for (int r = 0; r < 9; ++r) acc[r] = (f32x4){0.f, 0.f, 0.f, 0.f};
#pragma unroll
    for (int kb = 0; kb < 32; kb += 16) {
        f32x4 wv[16];
#pragma unroll
        for (int u = 0; u < 16; ++u) wv[u] = *(const f32x4*)(w + (size_t)(kb + u) * 3072);
#pragma unroll
        for (int u4 = 0; u4 < 4; ++u4)
#pragma unroll
            for (int r = 0; r < 9; ++r) {
                const f32x4 sv = *(const f32x4*)(s + r * 1024 + ks * 32 + kb + 4 * u4);
#pragma unroll
                for (int uu = 0; uu < 4; ++uu) acc[r] += wv[4 * u4 + uu] * sv[uu];
            }
    }
#pragma unroll
    for (int r = 0; r < 9; ++r) *(f32x4*)(red + (ks * 9 + r) * 64 + 4 * c4) = acc[r];
    __syncthreads();
    for (int i = tid; i < 9 * 64; i += NT) {
        const int r = i >> 6, cc = i & 63;
        float v = p.in[I_BMOD][l * 3072 + cgp * 64 + cc];
#pragma unroll
        for (int k = 0; k < 32; ++k) v += red[(k * 9 + r) * 64 + cc];
        __hip_atomic_store((unsigned*)&mod[(l * 9 + r) * 3072 + cgp * 64 + cc], __float_as_uint(v), __ATOMIC_RELAXED, __HIP_MEMORY_SCOPE_AGENT);
    }
}

constexpr int WCONV_TILES = 16 * 27 + 16 * 8;
__device__ void wconv_loop(const Params& p, int l, int first, int end, int stride, char* smem, int oz) {
    if (first >= end) return;
    const int tid = (threadIdx.x + oz) & 511;
    float* tile = (float*)smem;
    float4 vn[4];
#define WC_LOAD(id_)                                                                                   \
    {                                                                                                  \
        int id2 = (id_);                                                                               \
        const bool isin_ = id2 < 16 * 27;                                                              \
        if (!isin_) id2 -= 16 * 27;                                                                    \
        const int NN_ = isin_ ? INW : DM, ntn_ = isin_ ? 27 : 8;                                       \
        const int k0_ = (id2 / ntn_) * 64, n0_ = (id2 % ntn_) * 128;                                   \
        const float* W_ = (isin_ ? p.in[I_WIN] : p.in[I_WOUT]) + (size_t)l * 1024 * NN_;               \
        _Pragma("unroll") for (int i = 0; i < 4; ++i) {                                                \
            const int pc = tid + 512 * i, r = pc >> 5, c4 = (pc & 31) * 4;                             \
            const int n = n0_ + c4;                                                                    \
            const int ns = isin_ ? win_src_col(n) : n;     \
            vn[i] = (n < NN_) ? *(const float4*)(W_ + (size_t)(k0_ + r) * NN_ + ns) : make_float4(0.f, 0.f, 0.f, 0.f); \
        }                                                                                              \
    }
    WC_LOAD(first)
    for (int idt = first; idt < end; idt += stride) {
        int id = idt;
        const bool isin = id < 16 * 27;
        if (!isin) id -= 16 * 27;
        const int NN = isin ? INW : DM;
        const int ntn = isin ? 27 : 8;
        const int k0 = (id / ntn) * 64, n0 = (id % ntn) * 128;
        bf16_t* Wt = (bf16_t*)(p.ws + (isin ? OFF_WINT : OFF_WOUTT + (size_t)(l & 1) * SZ_WOUTT));
        float4 v[4];
#pragma unroll
        for (int i = 0; i < 4; ++i) v[i] = vn[i];
        if (idt + stride < end) WC_LOAD(idt + stride)
        __syncthreads();
#pragma unroll
        for (int i = 0; i < 4; ++i) {
            const int pc = tid + 512 * i, r = pc >> 5, c4 = (pc & 31) * 4;
            tile[r * 129 + c4] = v[i].x; tile[r * 129 + c4 + 1] = v[i].y; tile[r * 129 + c4 + 2] = v[i].z; tile[r * 129 + c4 + 3] = v[i].w;
        }
        __syncthreads();
        {
            const int nn = tid >> 2, q = tid & 3, n = n0 + nn;
            if (n < NN) {
                u32x4 o0, o1;
#pragma unroll
                for (int w = 0; w < 4; ++w) {
                    o0[w] = cvt_pk(tile[(q * 16 + 2 * w) * 129 + nn], tile[(q * 16 + 2 * w + 1) * 129 + nn]);
                    o1[w] = cvt_pk(tile[(q * 16 + 8 + 2 * w) * 129 + nn], tile[(q * 16 + 8 + 2 * w + 1) * 129 + nn]);
                }
                *(u32x4*)(Wt + (size_t)n * 1024 + k0 + q * 16) = o0;
                *(u32x4*)(Wt + (size_t)n * 1024 + k0 + q * 16 + 8) = o1;
            }
        }
    }
#undef WC_LOAD
}

__device__ void phase_prep(const Params& p, char* smem, int vb, int nvb, int oz) {
    if (vb < 192) phase_prep_mod(p, smem, vb, oz);
    asm volatile("s_waitcnt vmcnt(0)" ::: "memory");
    __syncthreads();
    if (vb < 48 && threadIdx.x == 0) (void)xb_add((unsigned*)(p.ws + OFF_BAR) + 193, 1u);
    const bool wb = vb >= 192;
    wconv_loop(p, 0, wb ? vb - 192 : 192 + vb, wb ? 192 : WCONV_TILES, wb ? nvb - 192 : 192, smem, oz);
}

__device__ void phase_E_rows(const Params& p, int l, char* smem, int vb, int nvb, bool split, int nrows, int oz) {
    const int tid = threadIdx.x + oz, lane = tid & 63, wave = __builtin_amdgcn_readfirstlane(tid >> 6);
    const float* mod = (const float*)(p.ws + OFF_MOD);
    bf16_t* P = (bf16_t*)(p.ws + OFF_P);
    float* XC = (float*)(p.ws + OFF_XC);
    const int gw = vb * 8 + wave;
#pragma clang loop unroll(disable)
  for (int seg = 0; seg < (split ? 2 : 1); ++seg) {
    int rbeg, rend;
    if (!split) {
        const int per = (nrows + nvb * 8 - 1) / (nvb * 8);
        rbeg = gw * per;
        rend = (rbeg + per < nrows) ? rbeg + per : nrows;
    } else if (seg == 0) {
        const int nw0 = (nvb - 32) * 8;
        rbeg = (gw < nw0) ? gw * 9 : nw0 * 9 + (gw - nw0);
        rend = (gw < nw0) ? rbeg + 9 : rbeg + 1;
        rend = rend < LAT ? rend : LAT;
    } else {
        unsigned* bar = (unsigned*)(p.ws + OFF_BAR);
        __syncthreads();
        if (threadIdx.x == 0) {
            XB_SPIN(xb_ld(&bar[XB_YCNT(64 + (vb >> 5))]) < 4u * (unsigned)l, bar);
            __builtin_amdgcn_fence(__ATOMIC_ACQUIRE, "agent");
            asm volatile("s_waitcnt vmcnt(0)" ::: "memory");
        }
        __syncthreads();
        rbeg = LAT + gw;
        rend = rbeg + 1;
    }
    if (rbeg < rend) {
    float4 gp[4], pa[4], sh[4];
    int cur_mr = -1;
    float4 nx0[4], nx1[4];
    u32x4 ny0[2], nxb0[2], ny1[2], nxb1[2];
#define E2_LOAD(nx, nxb, ny, row_)                                                                 \
    {                                                                                              \
        const int rr_ = (row_);                                                                    \
        const float* src_ = (l <= 1) ? ((rr_ >= LAT) ? p.in[I_CTX] + (size_t)(rr_ - LAT) * DM : p.in[I_X] + (size_t)rr_ * DM) \
                                     : ((rr_ >= LAT) ? XC + (size_t)(rr_ - LAT) * DM : p.out + (size_t)rr_ * DM); \
        _Pragma("unroll") for (int k = 0; k < 4; ++k)                                              \
            if (l <= 1) nx[k] = *(const float4*)(src_ + (k >> 1) * 512 + lane * 8 + (k & 1) * 4);  \
        _Pragma("unroll") for (int k2 = 0; k2 < 2; ++k2) {                                         \
            if (l >= 2) nxb[k2] = *(const u32x4*)((const bf16_t*)src_ + DM + k2 * 512 + lane * 8); \
            if (l > 0) ny[k2] = *(const u32x4*)(P + (size_t)rr_ * DM + k2 * 512 + lane * 8);       \
        }                                                                                          \
    }
    E2_LOAD(nx0, nxb0, ny0, rbeg)
    if (rbeg + 1 < rend) E2_LOAD(nx1, nxb1, ny1, rbeg + 1)
    for (int row = rbeg; row < rend; ++row) {
        const bool isctx = row >= LAT;
        const int mr = isctx ? 8 : row / T;
        if (mr != cur_mr) {
            cur_mr = mr;
#pragma unroll
            for (int k = 0; k < 4; ++k) {
                const int col = (k >> 1) * 512 + lane * 8 + (k & 1) * 4;
                if (l > 0) {
                    const float4 g = *(const float4*)(mod + ((l - 1) * 9 + mr) * 3072 + 2048 + col);
                    const float4 pg = *(const float4*)(p.in[I_POSTG] + (l - 1) * DM + col);
                    gp[k] = make_float4(g.x * pg.x, g.y * pg.y, g.z * pg.z, g.w * pg.w);
                }
                if (l < 4) {
                    const float4 pre = *(const float4*)(p.in[I_PREG] + l * DM + col);
                    const float4 sc = *(const float4*)(mod + (l * 9 + mr) * 3072 + 1024 + col);
                    sh[k] = *(const float4*)(mod + (l * 9 + mr) * 3072 + col);
                    pa[k] = make_float4(pre.x * (1.f + sc.x), pre.y * (1.f + sc.y), pre.z * (1.f + sc.z), pre.w * (1.f + sc.w));
                }
            }
        }
        float* xcur = isctx ? XC + (size_t)(row - LAT) * DM : p.out + (size_t)row * DM;
        float4 xv[4];
        u32x4 yq[2];
#pragma unroll
        for (int k = 0; k < 4; ++k) {
            const u32x4 w = nxb0[k >> 1];
            const int h2 = 2 * (k & 1);
            xv[k] = (l <= 1) ? nx0[k] : make_float4(h_lo(w[h2]), h_hi(w[h2]), h_lo(w[h2 + 1]), h_hi(w[h2 + 1]));
        }
#pragma unroll
        for (int k = 0; k < 4; ++k) nx0[k] = nx1[k];
#pragma unroll
        for (int k2 = 0; k2 < 2; ++k2) { yq[k2] = ny0[k2]; nxb0[k2] = nxb1[k2]; ny0[k2] = ny1[k2]; }
        if (row + 2 < rend) E2_LOAD(nx1, nxb1, ny1, row + 2)
        float y[4][4];
        float ss = 0.f;
#pragma unroll
        for (int k = 0; k < 4; ++k) {
            { const u32x4 w = yq[k >> 1]; const int h2 = 2 * (k & 1); y[k][0] = lo16(w[h2]); y[k][1] = hi16(w[h2]); y[k][2] = lo16(w[h2 + 1]); y[k][3] = hi16(w[h2 + 1]); }
            ss += y[k][0] * y[k][0] + y[k][1] * y[k][1] + y[k][2] * y[k][2] + y[k][3] * y[k][3];
        }
        float rs = 0.f;
        if (l > 0) {
            ss = wave_sum(ss);
            rs = rsqrtf(ss * (1.f / DM) + EPS);
        }
        float ss2 = 0.f;
#pragma unroll
        for (int k = 0; k < 4; ++k) {
            if (l > 0) {
                xv[k].x += gp[k].x * (y[k][0] * rs);
                xv[k].y += gp[k].y * (y[k][1] * rs);
                xv[k].z += gp[k].z * (y[k][2] * rs);
                xv[k].w += gp[k].w * (y[k][3] * rs);
            }
            ss2 += xv[k].x * xv[k].x + xv[k].y * xv[k].y + xv[k].z * xv[k].z + xv[k].w * xv[k].w;
        }
        if (l > 0) {
            const __amdgpu_buffer_rsrc_t xr = __builtin_amdgcn_make_buffer_rsrc((void*)xcur, (short)0, 4096, 0x00020000);
#pragma unroll
            for (int k2 = 0; k2 < 2; ++k2) {
                const u32x4 xb = {pk_h2(xv[2 * k2].x, xv[2 * k2].y), pk_h2(xv[2 * k2].z, xv[2 * k2].w), pk_h2(xv[2 * k2 + 1].x, xv[2 * k2 + 1].y), pk_h2(xv[2 * k2 + 1].z, xv[2 * k2 + 1].w)};
                __builtin_amdgcn_raw_buffer_store_b128(xb, xr, 2048 + (k2 * 512 + lane * 8) * 2, 0, 16);
            }
        }
        if (l < 4) {
            ss2 = wave_sum(ss2);
            const float rs2 = rsqrtf(ss2 * (1.f / DM) + EPS);
            const __amdgpu_buffer_rsrc_t hr = __builtin_amdgcn_make_buffer_rsrc((void*)(P + (size_t)row * DM), (short)0, 2048, 0x00020000);
#pragma unroll
            for (int k2 = 0; k2 < 2; ++k2) {
                u32x4 hv;
#pragma unroll
                for (int hh = 0; hh < 2; ++hh) {
                    const int k = 2 * k2 + hh;
                    hv[2 * hh] = cvt_pk(xv[k].x * rs2 * pa[k].x + sh[k].x, xv[k].y * rs2 * pa[k].y + sh[k].y);
                    hv[2 * hh + 1] = cvt_pk(xv[k].z * rs2 * pa[k].z + sh[k].z, xv[k].w * rs2 * pa[k].w + sh[k].w);
                }
                __builtin_amdgcn_raw_buffer_store_b128(hv, hr, (k2 * 512 + lane * 8) * 2, 0, 16);
            }
        }
    }
    }
  }
#undef E2_LOAD
}


namespace g8 {
#define G8_LAS __attribute__((address_space(3)))
constexpr int BM = 256, BK = 64, HALF = 128, HTB = HALF * BK * 2, STAGE_BYTES = 8 * HTB, NXCD = 8, WGM = 8;
__device__ __forceinline__ int lds_byte(int r, int c) { const int st = (r >> 4) * 2 + (c >> 5), rr = r & 15, cc = c & 31, ob = rr * 64 + cc * 2; return st * 1024 + (ob ^ (((ob >> 9) & 1) << 5)); }
__device__ __forceinline__ void stage_rc(int b, int& R, int& C) { const int st = b / 1024, sb = b % 1024, swz = sb ^ (((sb >> 9) & 1) << 5); R = (st >> 1) * 16 + swz / 64; C = (st & 1) * 32 + (swz % 64) / 2; }
__device__ __forceinline__ int perm32(int rho) { const int n = rho >> 4, i = rho & 15; return 8 * (i >> 2) + 4 * n + (i & 3); }
struct Unit { int pm, pn; };
struct Order {
    int nM, nN, nwg, G, c;
    __device__ __forceinline__ void init(int M, int N, int G_, int c_) { nM = M / BM; nN = N / BM; nwg = nM * nN; G = G_; c = c_; }
    __device__ __forceinline__ bool next(int i, Unit& u) const {
        const long L = (long)i * G + c; if (L >= nwg) return false;
        int wgid = (int)L; { const int q = nwg / NXCD, r = nwg % NXCD, xcd = wgid % NXCD, off = wgid / NXCD; wgid = (xcd < r ? xcd * (q + 1) : r * (q + 1) + (xcd - r) * q) + off; }
        const int nig = WGM * nN, gid = wgid / nig, fm = gid * WGM, gsz = (nM - fm) < WGM ? (nM - fm) : WGM;
        u.pm = fm + ((wgid % nig) % gsz); u.pn = (wgid % nig) / gsz; return true;
    }
};
template <bool OUTP>
__device__ __forceinline__ size_t colb(int t) {
    if (OUTP) {
        const int gsel = t >> 2;
        const int zoff = (gsel == 0) ? C_LRUZ : (gsel == 1) ? C_GZ : (gsel == 2) ? C_RZ : C_SZ;
        return (size_t)(zoff + (t & 3) * 64) * 2;
    }
    return (size_t)t * (BK * 2);
}
template <bool OUTP>
__device__ __forceinline__ void gemm_phase(const Params& p, int l, char* smem, int vb, int nvb, int pm0, int M, bool fuse, int oz) {
    G8_LAS unsigned char* lds = (G8_LAS unsigned char*)smem;
    const int tid = threadIdx.x + oz, wid = __builtin_amdgcn_readfirstlane(tid >> 6), lane = tid & 63, wr = wid >> 2, wc = wid & 3, fr = lane & 15, fq = lane >> 4;
    constexpr int K = DM, nt = K / BK;
    const int N = OUTP ? DM : INW;
    const int NP = OUTP ? DM : NPAD;
    const int lda = OUTP ? LDU : DM;
    const bf16_t* Aptr = OUTP ? (const bf16_t*)(p.ws + OFF_U) : (const bf16_t*)(p.ws + OFF_P);
    const bf16_t* Bptr = OUTP ? (const bf16_t*)(p.ws + OFF_WOUTT + (size_t)(l & 1) * SZ_WOUTT) : (const bf16_t*)(p.ws + OFF_WINT);
    bf16_t* Cptr = OUTP ? (bf16_t*)(p.ws + OFF_P) : (bf16_t*)(p.ws + OFF_U);
    const int ldc = OUTP ? DM : LDU;
    Order S; S.init(M, NP, nvb, vb);
    const __amdgpu_buffer_rsrc_t crsrc = __builtin_amdgcn_make_buffer_rsrc((void*)Cptr, (short)0, (int)((size_t)NROW * (OUTP ? DM : LDU) * 2), 0x00020000);
    unsigned voffA[2], voffB[2];
#pragma unroll
    for (int i = 0; i < 2; ++i) { int R, C; stage_rc(tid * 16 + i * 8192, R, C); const int Rb = (R & ~31) + perm32(R & 31);
        voffA[i] = (unsigned)(R * lda + C) * 2u; voffB[i] = (unsigned)(Rb * K + C) * 2u; }
    const size_t kstep = (size_t)(BK * 2);
    const size_t hstepA = (size_t)HALF * lda * 2, hstepB = (size_t)HALF * K * 2;
    const size_t tstepA = 2 * hstepA, tstepB = 2 * hstepB;
    const unsigned ldsw = (unsigned)wid * 1024u;
    const int aoff = lds_byte(wr * 64 + fr, fq * 8), boff = lds_byte(wc * 32 + fr, fq * 8);
#define G8_SA(b, h) (((b) * 2 + (h)) * HTB)
#define G8_SB(b, h) ((4 + (b) * 2 + (h)) * HTB)
#define G8_STAGE(bufoff, gbase, voff) do { _Pragma("unroll") for (int _i = 0; _i < 2; ++_i) \
        __builtin_amdgcn_global_load_lds((const unsigned*)((const char*)(gbase) + (voff)[_i]), (G8_LAS unsigned*)(lds + (bufoff) + ldsw + _i * 8192), 16, 0, 0); } while (0)
#define G8_LDA(dst, b, h) do { _Pragma("unroll") for (int m = 0; m < 4; ++m) _Pragma("unroll") for (int k = 0; k < 2; ++k) dst[m][k] = *(const G8_LAS bf16x8*)(lds + G8_SA(b, h) + aoff + m * 2048 + k * 1024); } while (0)
#define G8_LDB(dst, b, h) do { _Pragma("unroll") for (int n = 0; n < 2; ++n) _Pragma("unroll") for (int k = 0; k < 2; ++k) dst[n][k] = *(const G8_LAS bf16x8*)(lds + G8_SB(b, h) + boff + n * 2048 + k * 1024); } while (0)
#define G8_MMA(ai, bj, At, Bt) do { __builtin_amdgcn_s_setprio(1); _Pragma("unroll") for (int m = 0; m < 4; ++m) _Pragma("unroll") for (int n = 0; n < 2; ++n) _Pragma("unroll") for (int k = 0; k < 2; ++k) \
        acc[ai][bj][m][n] = __builtin_amdgcn_mfma_f32_16x16x32_bf16(Bt[n][k], At[m][k], acc[ai][bj][m][n], 0, 0, 0); __builtin_amdgcn_s_setprio(0); } while (0)
#define G8_WAIT_V(n) asm volatile("s_waitcnt vmcnt(" #n ")" ::: "memory")
#define G8_WAIT_L(n) asm volatile("s_waitcnt lgkmcnt(" #n ")" ::: "memory")
#define G8_BAR __builtin_amdgcn_s_barrier()
#define G8_SCHED __builtin_amdgcn_sched_barrier(0)
    Unit cur, nxt; int ui = 0;
    if (!S.next(0, cur)) return;
    cur.pm += pm0;
    if (OUTP) {
        unsigned* bar = (unsigned*)(p.ws + OFF_BAR);
        __syncthreads();
        if (threadIdx.x == 0) {
            XB_SPIN(xb_ld(&bar[XB_FCNT(cur.pm)]) < 256u * (unsigned)(l + 1), bar);
            __builtin_amdgcn_fence(__ATOMIC_ACQUIRE, "agent");
            asm volatile("s_waitcnt vmcnt(0)" ::: "memory");
        }
        __syncthreads();
    }
    f32x4 acc[2][2][4][2];
#pragma unroll
    for (int a = 0; a < 2; ++a)
#pragma unroll
        for (int b = 0; b < 2; ++b)
#pragma unroll
            for (int m = 0; m < 4; ++m)
#pragma unroll
                for (int n = 0; n < 2; ++n) acc[a][b][m][n] = (f32x4){0.f, 0.f, 0.f, 0.f};
    bf16x8 At[4][2], B0[2][2], B1[2][2];
    const char* cA = (const char*)Aptr + (size_t)cur.pm * tstepA; const char* cB = (const char*)Bptr + (size_t)cur.pn * tstepB;
    {
        const char* a0 = cA + colb<OUTP>(0);
        G8_STAGE(G8_SB(0, 0), cB, voffB); G8_STAGE(G8_SA(0, 0), a0, voffA); G8_STAGE(G8_SB(0, 1), cB + hstepB, voffB); G8_STAGE(G8_SA(0, 1), a0 + hstepA, voffA);
        if (wr == 1) G8_BAR;
        G8_WAIT_V(4); G8_BAR;
        G8_STAGE(G8_SB(1, 0), cB + kstep, voffB); G8_STAGE(G8_SA(1, 0), a0 + kstep, voffA); G8_STAGE(G8_SB(1, 1), cB + hstepB + kstep, voffB);
        G8_WAIT_V(6); G8_BAR;
    }
    for (;;) {
        const bool has_next = S.next(ui + 1, nxt);
        nxt.pm += pm0;
        const char* nA = has_next ? (const char*)Aptr + (size_t)nxt.pm * tstepA : cA; const char* nB = has_next ? (const char*)Bptr + (size_t)nxt.pn * tstepB : cB;
#pragma clang loop unroll(disable)
        for (int t = 0; t < nt; t += 2) {
            const bool last = (t == nt - 2);
            const char* a1 = cA + colb<OUTP>(t) + kstep;
            const char* a2 = last ? nA + colb<OUTP>(0) : cA + colb<OUTP>(t + 2); const char* b2 = last ? nB : cB + (size_t)(t + 2) * kstep;
            const char* a3 = a2 + kstep; const char* b3 = b2 + kstep;
            G8_LDB(B0, 0, 0); G8_SCHED; G8_LDA(At, 0, 0); G8_STAGE(G8_SA(1, 1), a1 + hstepA, voffA);
            G8_WAIT_L(8); G8_BAR; G8_WAIT_L(0); G8_MMA(0, 0, At, B0); G8_BAR; G8_SCHED;
            G8_LDB(B1, 0, 1); G8_STAGE(G8_SB(0, 0), b2, voffB);
            G8_BAR; G8_WAIT_L(0); G8_MMA(0, 1, At, B1); G8_BAR;
            G8_LDA(At, 0, 1); G8_STAGE(G8_SA(0, 0), a2, voffA);
            G8_BAR; G8_WAIT_L(0); G8_MMA(1, 0, At, B0); G8_BAR; G8_SCHED;
            G8_STAGE(G8_SB(0, 1), b2 + hstepB, voffB);
            G8_WAIT_V(6); G8_BAR; G8_MMA(1, 1, At, B1); G8_BAR;
            G8_LDB(B0, 1, 0); G8_SCHED; G8_LDA(At, 1, 0); G8_STAGE(G8_SA(0, 1), a2 + hstepA, voffA);
            G8_WAIT_L(8); G8_BAR; G8_WAIT_L(0); G8_MMA(0, 0, At, B0); G8_BAR; G8_SCHED;
            G8_LDB(B1, 1, 1); G8_STAGE(G8_SB(1, 0), b3, voffB);
            G8_BAR; G8_WAIT_L(0); G8_MMA(0, 1, At, B1); G8_BAR;
            G8_LDA(At, 1, 1); G8_STAGE(G8_SA(1, 0), a3, voffA);
            G8_BAR; G8_WAIT_L(0); G8_MMA(1, 0, At, B0); G8_BAR; G8_SCHED;
            G8_STAGE(G8_SB(1, 1), b3 + hstepB, voffB);
            G8_WAIT_V(6); G8_BAR; G8_MMA(1, 1, At, B1); G8_BAR;
        }
        if (!(OUTP && fuse)) {
            const int row0 = cur.pm * BM + wr * 64 + fr, col0 = cur.pn * BM + wc * 32 + 8 * fq;
#pragma unroll
            for (int ai = 0; ai < 2; ++ai)
#pragma unroll
                for (int m = 0; m < 4; ++m) {
                    bf16_t* rowp = Cptr + (size_t)(row0 + ai * HALF + m * 16) * ldc + col0;
#pragma unroll
                    for (int bj = 0; bj < 2; ++bj) {
                        if (col0 + bj * HALF < N) {
                            const f32x4 v0 = acc[ai][bj][m][0], v1 = acc[ai][bj][m][1];
                            u32x4 w = {cvt_pk(v0[0], v0[1]), cvt_pk(v0[2], v0[3]), cvt_pk(v1[0], v1[1]), cvt_pk(v1[2], v1[3])};
                            if (OUTP) {
                                __builtin_amdgcn_raw_buffer_store_b128(w, crsrc, (int)(((size_t)(row0 + ai * HALF + m * 16) * ldc + col0 + bj * HALF) * 2), 0, 16);
                            } else *(u32x4*)(rowp + bj * HALF) = w;
                        }
                    }
                }
        }
        if (!has_next) break;
#pragma unroll
        for (int a = 0; a < 2; ++a)
#pragma unroll
            for (int b = 0; b < 2; ++b)
#pragma unroll
                for (int m = 0; m < 4; ++m)
#pragma unroll
                    for (int n = 0; n < 2; ++n) acc[a][b][m][n] = (f32x4){0.f, 0.f, 0.f, 0.f};
        cur = nxt; cA = nA; cB = nB; ++ui;
    }
    G8_WAIT_V(0);
    if (wr == 0) G8_BAR;
    G8_BAR;
    if (OUTP && !fuse && threadIdx.x == 0) (void)xb_add((unsigned*)(p.ws + OFF_BAR) + XB_YCNT(cur.pm), 1u);
    if (OUTP && fuse) {
        float* Pp = (float*)smem;
        float* Sx = (float*)(smem + 8192);
        unsigned* bar = (unsigned*)(p.ws + OFF_BAR);
        unsigned* xs = (unsigned*)(p.ws + OFF_XS);
#pragma unroll
        for (int ai = 0; ai < 2; ++ai)
#pragma unroll
            for (int m = 0; m < 4; ++m) {
                float sq = 0.f;
#pragma unroll
                for (int bj = 0; bj < 2; ++bj)
#pragma unroll
                    for (int n = 0; n < 2; ++n) { const f32x4 x = acc[ai][bj][m][n]; sq += (x[0] * x[0] + x[1] * x[1]) + (x[2] * x[2] + x[3] * x[3]); }
                sq += __shfl_xor(sq, 16); sq += __shfl_xor(sq, 32);
                if (fq == 0) Pp[(ai * HALF + wr * 64 + m * 16 + fr) * 4 + wc] = sq;
            }
        const int col0 = cur.pn * BM + wc * 32 + 8 * fq;
        u32x4 xres[2][4][2];
#pragma unroll
        for (int ai = 0; ai < 2; ++ai)
#pragma unroll
            for (int m = 0; m < 4; ++m)
#pragma unroll
                for (int bj = 0; bj < 2; ++bj)
                    xres[ai][m][bj] = *(const u32x4*)((const bf16_t*)(p.out + (size_t)(cur.pm * BM + ai * HALF + wr * 64 + m * 16 + fr) * DM) + DM + col0 + bj * HALF);
        asm volatile("s_waitcnt lgkmcnt(0)" ::: "memory"); G8_BAR; asm volatile("" ::: "memory");
        const int prow = wid * 32 + (lane & 31);
        if (lane < 32) {
            const float t = (Pp[prow * 4 + 0] + Pp[prow * 4 + 1]) + (Pp[prow * 4 + 2] + Pp[prow * 4 + 3]);
            __hip_atomic_store(xs + ((size_t)(cur.pm * BM + prow) * 4 + cur.pn), __float_as_uint(t), __ATOMIC_RELAXED, __HIP_MEMORY_SCOPE_AGENT);
        }
        asm volatile("s_waitcnt vmcnt(0)" ::: "memory");
        if (lane == 0) (void)xb_add(&bar[XB_PCNT(cur.pm)], 1u);
        if (wid == 0) {
            if (lane == 0) XB_SPIN(xb_ld(&bar[XB_PCNT(cur.pm)]) < 32u, bar);
            __builtin_amdgcn_fence(__ATOMIC_ACQUIRE, "agent");
        }
        asm volatile("s_waitcnt vmcnt(0) lgkmcnt(0)" ::: "memory"); G8_BAR; asm volatile("" ::: "memory");
        if (lane < 32) {
            unsigned* sl = xs + (size_t)(cur.pm * BM + prow) * 4;
            float t = 0.f;
#pragma unroll
            for (int k = 0; k < 4; ++k) t += __uint_as_float(__hip_atomic_load(sl + k, __ATOMIC_RELAXED, __HIP_MEMORY_SCOPE_AGENT));
            Sx[prow] = rsqrtf(t * (1.f / DM) + EPS);
        }
        asm volatile("s_waitcnt vmcnt(0) lgkmcnt(0)" ::: "memory"); G8_BAR; asm volatile("" ::: "memory");
        const float* mod = (const float*)(p.ws + OFF_MOD);
        const int mr = cur.pm >> 3;
        f32x4 gp[2][2];
#pragma unroll
        for (int bj = 0; bj < 2; ++bj)
#pragma unroll
            for (int n = 0; n < 2; ++n) {
                const int c = col0 + bj * HALF + 4 * n;
                gp[bj][n] = *(const f32x4*)(mod + (3 * 9 + mr) * 3072 + 2048 + c) * *(const f32x4*)(p.in[I_POSTG] + 3 * DM + c);
            }
#pragma unroll
        for (int ai = 0; ai < 2; ++ai)
#pragma unroll
            for (int m = 0; m < 4; ++m) {
                const int r = ai * HALF + wr * 64 + m * 16 + fr;
                const float rs = Sx[r];
                float* xo = p.out + (size_t)(cur.pm * BM + r) * DM + col0;
#pragma unroll
                for (int bj = 0; bj < 2; ++bj)
#pragma unroll
                    for (int n = 0; n < 2; ++n) {
                        const u32x4 xb = xres[ai][m][bj];
                        const f32x4 xv = {h_lo(xb[2 * n]), h_hi(xb[2 * n]), h_lo(xb[2 * n + 1]), h_hi(xb[2 * n + 1])};
                        *(f32x4*)(xo + bj * HALF + 4 * n) = xv + gp[bj][n] * (acc[ai][bj][m][n] * rs);
                    }
                asm volatile("" ::: "memory");
            }
    }
#undef G8_SA
#undef G8_SB
#undef G8_STAGE
#undef G8_LDA
#undef G8_LDB
#undef G8_MMA
#undef G8_WAIT_V
#undef G8_WAIT_L
#undef G8_BAR
#undef G8_SCHED
}
}

struct ChunkInfo {
    bool isctx;
    int t0, Tseg;
    size_t rowbase;
};
template <int CH>
__device__ __forceinline__ ChunkInfo chunk_info(int ci, int dir, int b) {
    constexpr int NC = LC / CH, NL = T / CH;
    ChunkInfo c;
    c.isctx = ci < NC;
    const int cidx = c.isctx ? ci : ci - NC;
    const int nch = c.isctx ? NC : NL;
    const int chunk = dir ? (nch - 1 - cidx) : cidx;
    c.Tseg = c.isctx ? LC : T;
    c.rowbase = c.isctx ? (size_t)LAT + (size_t)b * LC : (size_t)b * T;
    c.t0 = chunk * CH;
    return c;
}

template <int DIR>
__device__ __forceinline__ void ret_step(const bf16_t* Q, const bf16_t* K, const bf16_t* V, f32x4 (&S)[4], f32x4 (&o)[4],
                                         int sl, int g, int li, float g64, bool need_o) {
    constexpr int LS = 72;
    const int q4 = li >> 2, p4 = li & 3;
    bf16x8 vf[2];
#pragma unroll
    for (int s = 0; s < 2; ++s)
        vf[s] = cat8(lds_tr(V + (32 * s + 4 * g + q4) * LS + 16 * sl + 4 * p4), lds_tr(V + (32 * s + 16 + 4 * g + q4) * LS + 16 * sl + 4 * p4));
    bf16x8 kr[4][2], qr[4][2];
    if (need_o) {
#pragma unroll
        for (int bi = 0; bi < 4; ++bi)
#pragma unroll
            for (int s2 = 0; s2 < 2; ++s2) {
                kr[bi][s2] = *(const bf16x8*)(K + (16 * bi + li) * LS + 32 * s2 + 8 * g);
                qr[bi][s2] = *(const bf16x8*)(Q + (16 * bi + li) * LS + 32 * s2 + 8 * g);
            }
    }
    __builtin_amdgcn_sched_barrier(0);
    bf16x8 af[4][2];
    if (need_o) {
#pragma unroll
        for (int ci = 0; ci < 4; ++ci) {
            u32x4 fr[2];
#pragma unroll
            for (int bi = 0; bi < 4; ++bi) {
                const bool needed = DIR ? (bi >= ci) : (bi <= ci);
                unsigned w0 = 0, w1 = 0;
                if (needed) {
                    f32x4 t = {0.f, 0.f, 0.f, 0.f};
#pragma unroll
                    for (int s2 = 0; s2 < 2; ++s2) t = MFMA32(kr[bi][s2], qr[ci][s2], t);
                    if (bi == ci) {
#pragma unroll
                        for (int r = 0; r < 4; ++r) {
                            const bool keep = DIR ? (4 * g + r >= li) : (4 * g + r <= li);
                            t[r] = keep ? t[r] : 0.f;
                        }
                    }
                    w0 = cvt_pk(t[0], t[1]);
                    w1 = cvt_pk(t[2], t[3]);
                }
                fr[bi >> 1][(bi & 1) * 2] = w0;
                fr[bi >> 1][(bi & 1) * 2 + 1] = w1;
            }
            af[ci][0] = __builtin_bit_cast(bf16x8, fr[0]);
            af[ci][1] = __builtin_bit_cast(bf16x8, fr[1]);
        }
    }
    bf16x8 ka[4][2], qa[4][2];
#pragma unroll
    for (int mt = 0; mt < 4; ++mt)
#pragma unroll
        for (int s = 0; s < 2; ++s) {
            ka[mt][s] = cat8(lds_tr(K + (32 * s + 4 * g + q4) * LS + 32 * (mt >> 1) + 8 * p4 + 4 * (mt & 1)),
                             lds_tr(K + (32 * s + 16 + 4 * g + q4) * LS + 32 * (mt >> 1) + 8 * p4 + 4 * (mt & 1)));
            if (need_o) qa[mt][s] = qr[mt][s];
        }
    __builtin_amdgcn_sched_barrier(0);
    if (need_o) {
        bf16x8 sf[2];
#pragma unroll
        for (int s = 0; s < 2; ++s) sf[s] = pack8(S[2 * s], S[2 * s + 1]);
#pragma unroll
        for (int ci = 0; ci < 4; ++ci) {
            f32x4 acc = {0.f, 0.f, 0.f, 0.f};
#pragma unroll
            for (int s = 0; s < 2; ++s) {
                acc = MFMA32(sf[s], qa[ci][s], acc);
                if (!(DIR ? (s == 0 && ci >= 2) : (s == 1 && ci < 2))) acc = MFMA32(vf[s], af[ci][s], acc);
            }
            o[ci] = acc;
        }
    }
#pragma unroll
    for (int mt = 0; mt < 4; ++mt) {
        f32x4 acc = S[mt];
#pragma unroll
        for (int s = 0; s < 2; ++s) acc = MFMA32(ka[mt][s], vf[s], acc);
        S[mt] = acc * g64;
    }
}

__device__ void phase_ret_chain(const Params& p, int l, char* smem, int vb, int nvb, int oz) {
    constexpr int LS = 72;
    constexpr int BUFE = 3 * 64 * LS;
    bf16_t* lds = (bf16_t*)smem;
    bf16_t* U = (bf16_t*)(p.ws + OFF_U);
    const int tid = threadIdx.x + oz, lane = tid & 63, wave = __builtin_amdgcn_readfirstlane(tid >> 6);
    const int sl = wave & 3, g = lane >> 4, li = lane & 15;
    const bool loader = wave >= 4;
    const int at = tid & 255, fr = at >> 2, fj = at & 3;
    const bool with_ctx = l < 3;
    for (int it = vb; it < 64; it += nvb) {
        const int b = it >> 3, h = (it >> 1) & 3, dir = it & 1;
        const float lg2 = log2f(sigmoidf_(p.in[I_RDEC][(l * 2 + dir) * 4 + h]));
        if (loader) {
            float invr[8];
#pragma unroll
            for (int ii = 0; ii < 8; ++ii) invr[ii] = fexp(-(float)(8 * fj + ii) * (9.210340371976184f / 32.f)) * 0.15915494309189535f;
            const float pp1 = (float)((dir ? 63 - fr : fr) + 1);
            const float fq = exp2f(lg2 * pp1), fk = 0.125f * exp2f(-lg2 * pp1);
            u32x4 ra[6], rb[6], rc[6];
#define RET_LOAD(R, ci_)                                                                              \
    {                                                                                                 \
        const ChunkInfo cc = chunk_info<64>((ci_), dir, b);                                           \
        const bf16_t* base = U + (cc.rowbase + cc.t0 + fr) * LDU + h * 64 + 8 * fj;                   \
        R[0] = *(const u32x4*)(base + C_RQ); R[1] = *(const u32x4*)(base + C_RQ + 32);                \
        R[2] = *(const u32x4*)(base + C_RK); R[3] = *(const u32x4*)(base + C_RK + 32);                \
        R[4] = *(const u32x4*)(base + C_RV); R[5] = *(const u32x4*)(base + C_RV + 32);                \
    }
#define RET_FILL(R, ci_, buf_)                                                                        \
    {                                                                                                 \
        const ChunkInfo cc = chunk_info<64>((ci_), dir, b);                                           \
        bf16_t* Q = lds + (buf_) * BUFE;                                                              \
        bf16_t* K = Q + 64 * LS;                                                                      \
        bf16_t* V = K + 64 * LS;                                                                      \
        float q1[8], q2[8], k1[8], k2[8];                                                             \
        _Pragma("unroll") for (int w = 0; w < 4; ++w) {                                               \
            q1[2 * w] = lo16(R[0][w]); q1[2 * w + 1] = hi16(R[0][w]);                                 \
            q2[2 * w] = lo16(R[1][w]); q2[2 * w + 1] = hi16(R[1][w]);                                 \
            k1[2 * w] = lo16(R[2][w]); k1[2 * w + 1] = hi16(R[2][w]);                                 \
            k2[2 * w] = lo16(R[3][w]); k2[2 * w + 1] = hi16(R[3][w]);                                 \
        }                                                                                             \
        if (!cc.isctx) {                                                                              \
            const float pos = (float)(cc.t0 + fr);                                                    \
            _Pragma("unroll") for (int ii = 0; ii < 8; ++ii) {                                        \
                float rev = pos * invr[ii];                                                           \
                rev -= floorf(rev);                                                                   \
                const float cs = __builtin_amdgcn_cosf(rev), sn = __builtin_amdgcn_sinf(rev);         \
                const float a1 = q1[ii], a2 = q2[ii];                                                 \
                q1[ii] = a1 * cs - a2 * sn;                                                           \
                q2[ii] = a1 * sn + a2 * cs;                                                           \
                const float b1 = k1[ii], b2 = k2[ii];                                                 \
                k1[ii] = b1 * cs - b2 * sn;                                                           \
                k2[ii] = b1 * sn + b2 * cs;                                                           \
            }                                                                                         \
        }                                                                                             \
        u32x4 o1, o2;                                                                                 \
        _Pragma("unroll") for (int w = 0; w < 4; ++w) { o1[w] = cvt_pk(q1[2 * w] * fq, q1[2 * w + 1] * fq); o2[w] = cvt_pk(q2[2 * w] * fq, q2[2 * w + 1] * fq); } \
        *(u32x2*)(Q + fr * LS + permcol(8 * fj)) = (u32x2){o1[0], o1[1]};                             \
        *(u32x2*)(Q + fr * LS + permcol(8 * fj + 4)) = (u32x2){o1[2], o1[3]};                         \
        *(u32x2*)(Q + fr * LS + permcol(32 + 8 * fj)) = (u32x2){o2[0], o2[1]};                        \
        *(u32x2*)(Q + fr * LS + permcol(36 + 8 * fj)) = (u32x2){o2[2], o2[3]};                        \
        _Pragma("unroll") for (int w = 0; w < 4; ++w) { o1[w] = cvt_pk(k1[2 * w] * fk, k1[2 * w + 1] * fk); o2[w] = cvt_pk(k2[2 * w] * fk, k2[2 * w + 1] * fk); } \
        *(u32x2*)(K + fr * LS + permcol(8 * fj)) = (u32x2){o1[0], o1[1]};                             \
        *(u32x2*)(K + fr * LS + permcol(8 * fj + 4)) = (u32x2){o1[2], o1[3]};                         \
        *(u32x2*)(K + fr * LS + permcol(32 + 8 * fj)) = (u32x2){o2[0], o2[1]};                        \
        *(u32x2*)(K + fr * LS + permcol(36 + 8 * fj)) = (u32x2){o2[2], o2[3]};                        \
        *(u32x4*)(V + fr * LS + 8 * fj) = R[4];                                                       \
        *(u32x4*)(V + fr * LS + 32 + 8 * fj) = R[5];                                                  \
    }
            RET_LOAD(ra, 0)
            RET_LOAD(rb, 1)
            RET_LOAD(rc, 2)
            RET_FILL(ra, 0, 0)
            RET_LOAD(ra, 3)
            LDS_BARRIER();
            for (int ci = 0; ci < 36; ci += 6) {
                RET_FILL(rb, ci + 1, 1)  if (ci + 4 < 36) RET_LOAD(rb, ci + 4)  LDS_BARRIER();
                RET_FILL(rc, ci + 2, 0)  if (ci + 5 < 36) RET_LOAD(rc, ci + 5)  LDS_BARRIER();
                RET_FILL(ra, ci + 3, 1)  if (ci + 6 < 36) RET_LOAD(ra, ci + 6)  LDS_BARRIER();
                RET_FILL(rb, ci + 4, 0)  if (ci + 7 < 36) RET_LOAD(rb, ci + 7)  LDS_BARRIER();
                RET_FILL(rc, ci + 5, 1)  if (ci + 8 < 36) RET_LOAD(rc, ci + 8)  LDS_BARRIER();
                if (ci + 6 < 36) RET_FILL(ra, ci + 6, 0)  if (ci + 9 < 36) RET_LOAD(ra, ci + 9)  LDS_BARRIER();
            }
#undef RET_LOAD
#undef RET_FILL
        } else {
            const float g64 = exp2f(lg2 * 64.f);
            bf16_t* OUTB = U + (dir ? C_GQ + 512 : C_LRUX);
            f32x4 S[4];
#pragma unroll
            for (int mt = 0; mt < 4; ++mt) S[mt] = (f32x4){0.f, 0.f, 0.f, 0.f};
            bf16x4 ost[4];
            size_t orow = 0;
            bool ohave = false;
            if (__builtin_amdgcn_readfirstlane(wave) < 4) __builtin_amdgcn_s_setprio(3);
            LDS_BARRIER();
            for (int ci = 0; ci < 36; ++ci) {
                if (ohave) {
#pragma unroll
                    for (int mt = 0; mt < 4; ++mt) *(bf16x4*)(OUTB + (orow + 16 * mt + li) * LDU + h * 64 + 16 * sl + 4 * g) = ost[mt];
                }
                const ChunkInfo c = chunk_info<64>(ci, dir, b);
                const bool need_o = !c.isctx || with_ctx;
                const bf16_t* Q = lds + (ci & 1) * BUFE;
                const bf16_t* K = Q + 64 * LS;
                const bf16_t* V = K + 64 * LS;
                f32x4 o[4];
                if (dir == 0) ret_step<0>(Q, K, V, S, o, sl, g, li, g64, need_o);
                else          ret_step<1>(Q, K, V, S, o, sl, g, li, g64, need_o);
                ohave = need_o;
                if (need_o) {
                    orow = c.rowbase + c.t0;
#pragma unroll
                    for (int mt = 0; mt < 4; ++mt) ost[mt] = pack4(o[mt]);
                }
                LDS_BARRIER();
            }
            if (ohave) {
#pragma unroll
                for (int mt = 0; mt < 4; ++mt) *(bf16x4*)(OUTB + (orow + 16 * mt + li) * LDU + h * 64 + 16 * sl + 4 * g) = ost[mt];
            }
        }
        __builtin_amdgcn_s_setprio(0);
        LDS_BARRIER();
    }
}

template <int DIR>
__device__ __forceinline__ void lru_scan(const float (&av)[4][4], const float (&bv)[4][4], float (&hv)[4][4], float (&pv)[4][4], float& hc, float& pc, int g, int li) {
#pragma unroll
    for (int mi = 0; mi < 4; ++mi) {
        const int mt = DIR ? 3 - mi : mi;
        const float a0 = av[mt][DIR ? 3 : 0], a1 = av[mt][DIR ? 2 : 1], a2 = av[mt][DIR ? 1 : 2], a3 = av[mt][DIR ? 0 : 3];
        const float b0 = bv[mt][DIR ? 3 : 0], b1 = bv[mt][DIR ? 2 : 1], b2 = bv[mt][DIR ? 1 : 2], b3 = bv[mt][DIR ? 0 : 3];
        const float A4 = a0 * a1 * a2 * a3;
        const float B4 = ((b0 * a1 + b1) * a2 + b2) * a3 + b3;
        float hs = hc, hend = hc, pend = pc, ps = pc;
#pragma unroll
        for (int gi = 0; gi < 4; ++gi) {
            const int gg = DIR ? 3 - gi : gi;
            const float Ag = __shfl(A4, gg * 16 + li), Bg = __shfl(B4, gg * 16 + li);
            hs = (gg == g) ? hend : hs;
            ps = (gg == g) ? pend : ps;
            hend = Ag * hend + Bg;
            pend = Ag * pend;
        }
        hc = hend;
        pc = pend;
        const float h0 = a0 * hs + b0, h1 = a1 * h0 + b1, h2 = a2 * h1 + b2, h3 = a3 * h2 + b3;
        hv[mt][DIR ? 3 : 0] = h0;
        hv[mt][DIR ? 2 : 1] = h1;
        hv[mt][DIR ? 1 : 2] = h2;
        hv[mt][DIR ? 0 : 3] = h3;
        const float p0 = a0 * ps, p1 = a1 * p0, p2 = a2 * p1, p3 = a3 * p2;
        pv[mt][DIR ? 3 : 0] = p0;
        pv[mt][DIR ? 2 : 1] = p1;
        pv[mt][DIR ? 1 : 2] = p2;
        pv[mt][DIR ? 0 : 3] = p3;
    }
}

template <int PASS>
__device__ void lru_loop(const Params& p, int l, char* smem, int first, int end, int stride, bool skip_ctx, int oz) {
    constexpr int LS = 72;
    if (first >= end) return;
    bf16_t* ul = (bf16_t*)smem;
    float* pre = (float*)(smem + 64 * LS * 2);
    float* car = pre + 2 * 35 * 64 * 2;
    float* exc = car + 128;
    bf16_t* U = (bf16_t*)(p.ws + OFF_U);
    float* AGG = (float*)(p.ws + OFF_AGG);
    int oz2 = oz;
    asm volatile("" : "+v"(oz2));
    const int tid = threadIdx.x + oz2, lane = tid & 63, wave = __builtin_amdgcn_readfirstlane(tid >> 6);
    const int dir = wave >> 2, nt = wave & 3, g = lane >> 4, li = lane & 15;
    const int c8 = tid & 7, ft = tid >> 3;
    const int n = first & 3;
    const int d = 16 * nt + li, ch = n * 64 + d;
    bf16x8 wf[2][2];
#pragma unroll
    for (int m = 0; m < 2; ++m)
#pragma unroll
        for (int s = 0; s < 2; ++s) {
            const float* W = (m ? p.in[I_LWI] : p.in[I_LWR]) + (size_t)((l * 2 + dir) * 4 + n) * 4096 + d;
            float w[8];
#pragma unroll
            for (int jj = 0; jj < 8; ++jj) w[jj] = W[(32 * s + 8 * g + jj) * 64];
            u32x4 u = {cvt_pk(w[0], w[1]), cvt_pk(w[2], w[3]), cvt_pk(w[4], w[5]), cvt_pk(w[6], w[7])};
            wf[m][s] = __builtin_bit_cast(bf16x8, u);
        }
    const float br = p.in[I_LBR][(l * 2 + dir) * 256 + ch];
    const float bi = p.in[I_LBI][(l * 2 + dir) * 256 + ch];
    const float sp8 = -8.f * 1.4426950408889634f * softplusf_(-p.in[I_LLAM][(l * 2 + dir) * 256 + ch]);
    float cbv[8], cwv[4][8];
#pragma unroll
    for (int e = 0; e < 8; ++e) {
        cbv[e] = p.in[I_LCB][l * 256 + n * 64 + 8 * c8 + e];
#pragma unroll
        for (int j = 0; j < 4; ++j) cwv[j][e] = p.in[I_LCW][(l * 4 + j) * 256 + n * 64 + 8 * c8 + e];
    }
    u32x4 nrx[4], nzv = {0u, 0u, 0u, 0u};
#define LRU_ITEM_OF(idx_) (skip_ctx ? ((idx_) >> 7) * 144 + 16 + ((idx_) & 127) : (idx_))
#define LRU_LOAD(idx_)                                                                                      \
    {                                                                                                       \
        const int it_ = LRU_ITEM_OF(idx_);                                                                  \
        const int b_ = it_ / 144, cid_ = (it_ >> 2) % 36;                                                   \
        const bool ic_ = cid_ < 4;                                                                          \
        const int t0_ = (ic_ ? cid_ : cid_ - 4) * 64, Ts_ = ic_ ? LC : T;                                   \
        const size_t rb_ = ic_ ? (size_t)LAT + (size_t)b_ * LC : (size_t)b_ * T;                            \
        _Pragma("unroll") for (int j = 0; j < 4; ++j) {                                                     \
            int tt = t0_ + ft + j - 2;                                                                      \
            tt = tt < 0 ? 0 : (tt > Ts_ - 1 ? Ts_ - 1 : tt);                                                \
            nrx[j] = *(const u32x4*)(U + (rb_ + tt) * LDU + C_LRUX + n * 64 + 8 * c8);                      \
        }                                                                                                   \
        if (PASS == 1) nzv = *(const u32x4*)(U + (rb_ + t0_ + ft) * LDU + C_LRUZ + n * 64 + 8 * c8);        \
    }
    LRU_LOAD(first)
  for (int idx = first; idx < end; idx += stride) {
    const int item = LRU_ITEM_OF(idx);
    const int b = item / 144, cid = (item >> 2) % 36;
    const bool isctx = cid < 4;
    const int t0 = (isctx ? cid : cid - 4) * 64, Tseg = isctx ? LC : T;
    const size_t rowbase = isctx ? (size_t)LAT + (size_t)b * LC : (size_t)b * T;
    u32x4 rx[4];
#pragma unroll
    for (int j = 0; j < 4; ++j) rx[j] = nrx[j];
    const u32x4 zv = nzv;
    const int posf = cid, posb = isctx ? 3 - cid : 39 - cid;
    f32x4 pr[5];
    if (PASS == 1) {
#pragma unroll
        for (int k = 0; k < 5; ++k) {
            const int pidx = tid + 512 * k;
            const int dd = pidx / (35 * 32), rem = pidx % (35 * 32), q = rem >> 5, pc16 = rem & 31;
            const bool need = (dd < 2) && (q < (dd ? posb : posf));
            const int j = dd ? (q < 4 ? 3 - q : 39 - q) : q;
            pr[k] = (f32x4){1.f, 0.f, 1.f, 0.f};
            if (need) pr[k] = *(const f32x4*)(AGG + ((size_t)((b * 2 + dd) * 36 + j) * 256 + n * 64) * 2 + pc16 * 4);
        }
    }
    if (idx + stride < end) LRU_LOAD(idx + stride)
    __syncthreads();
    {
        float acc[8];
#pragma unroll
        for (int e = 0; e < 8; ++e) acc[e] = cbv[e];
#pragma unroll
        for (int j = 0; j < 4; ++j) {
            const int tt = t0 + ft + j - 2;
            const bool ok = (tt >= 0) && (tt < Tseg);
#pragma unroll
            for (int w = 0; w < 4; ++w) {
                const unsigned xw = ok ? rx[j][w] : 0u;
                acc[2 * w] += cwv[j][2 * w] * lo16(xw);
                acc[2 * w + 1] += cwv[j][2 * w + 1] * hi16(xw);
            }
        }
        u32x4 o = {cvt_pk(acc[0], acc[1]), cvt_pk(acc[2], acc[3]), cvt_pk(acc[4], acc[5]), cvt_pk(acc[6], acc[7])};
        *(u32x4*)(ul + ft * LS + 8 * c8) = o;
    }
    if (PASS == 1) {
#pragma unroll
        for (int k = 0; k < 5; ++k) {
            const int pidx = tid + 512 * k;
            if (pidx < 2 * 35 * 32) *(f32x4*)(pre + pidx * 4) = pr[k];
        }
    }
    __syncthreads();
    if (PASS == 1 && tid < 128) {
        const int dd = tid >> 6, cc = tid & 63, np = dd ? posb : posf;
        float h = 0.f;
        for (int q = 0; q < np; ++q) {
            const f32x2 ah = *(const f32x2*)(pre + ((dd * 35 + q) * 64 + cc) * 2);
            h = ah[0] * h + ah[1];
        }
        car[tid] = h;
    }
    float av[4][4], bv[4][4], hv[4][4];
#pragma unroll
    for (int mt = 0; mt < 4; ++mt) {
        f32x4 racc = {0.f, 0.f, 0.f, 0.f}, iacc = {0.f, 0.f, 0.f, 0.f};
#pragma unroll
        for (int s = 0; s < 2; ++s) {
            const bf16x8 a = *(const bf16x8*)(ul + (16 * mt + li) * LS + 32 * s + 8 * g);
            racc = MFMA32(a, wf[0][s], racc);
            iacc = MFMA32(a, wf[1][s], iacc);
        }
#pragma unroll
        for (int r = 0; r < 4; ++r) {
            const float uval = bf2f(ul[(16 * mt + 4 * g + r) * LS + d]);
            const float rg = sigmoidf_(racc[r] + br), ig = sigmoidf_(iacc[r] + bi);
            const float a = fexp2(sp8 * rg);
            av[mt][r] = a;
            bv[mt][r] = __builtin_amdgcn_sqrtf(fmaxf(0.f, 1.f - a * a)) * ig * uval;
        }
    }
    if (PASS == 0) {
        float hc = 0.f, pc = 1.f;
        float pv[4][4];
        if (dir == 0) lru_scan<0>(av, bv, hv, pv, hc, pc, g, li);
        else          lru_scan<1>(av, bv, hv, pv, hc, pc, g, li);
        if (g == 0) *(f32x2*)(AGG + ((size_t)((b * 2 + dir) * 36 + cid) * 256 + ch) * 2) = (f32x2){pc, hc};
        bf16_t* stp = (bf16_t*)(p.ws + OFF_P) + (size_t)item * 16384 + (size_t)(wave * 4) * 512 + lane * 8;
#pragma unroll
        for (int mt = 0; mt < 4; ++mt) {
            *(u32x4*)(stp + mt * 512) = (u32x4){cvt_pk(hv[mt][0], hv[mt][1]), cvt_pk(hv[mt][2], hv[mt][3]), cvt_pk(pv[mt][0], pv[mt][1]), cvt_pk(pv[mt][2], pv[mt][3])};
        }
    } else {
        __syncthreads();
        float hc = car[dir * 64 + d], pc = 1.f;
        float pv[4][4];
        if (dir == 0) lru_scan<0>(av, bv, hv, pv, hc, pc, g, li);
        else          lru_scan<1>(av, bv, hv, pv, hc, pc, g, li);
#pragma unroll
        for (int mt = 0; mt < 4; ++mt)
#pragma unroll
            for (int r = 0; r < 4; ++r) exc[dir * 4096 + (16 * mt + 4 * g + r) * 64 + d] = hv[mt][r];
        __syncthreads();
        const float* ef = exc + ft * 64 + 8 * c8;
        const f32x4 f0 = *(const f32x4*)ef, f1 = *(const f32x4*)(ef + 4), b0 = *(const f32x4*)(ef + 4096), b1 = *(const f32x4*)(ef + 4100);
        u32x4 y;
        y[0] = cvt_pk((f0[0] + b0[0]) * siluf_(lo16(zv[0])), (f0[1] + b0[1]) * siluf_(hi16(zv[0])));
        y[1] = cvt_pk((f0[2] + b0[2]) * siluf_(lo16(zv[1])), (f0[3] + b0[3]) * siluf_(hi16(zv[1])));
        y[2] = cvt_pk((f1[0] + b1[0]) * siluf_(lo16(zv[2])), (f1[1] + b1[1]) * siluf_(hi16(zv[2])));
        y[3] = cvt_pk((f1[2] + b1[2]) * siluf_(lo16(zv[3])), (f1[3] + b1[3]) * siluf_(hi16(zv[3])));
        *(u32x4*)(U + (rowbase + t0 + ft) * LDU + C_LRUZ + n * 64 + 8 * c8) = y;
    }
  }
#undef LRU_LOAD
#undef LRU_ITEM_OF
}

__device__ void lru_passC(const Params& p, int l, char* smem, int first, int end, int stride, bool skip_ctx, int oz) {
    if (first >= end) return;
    float* pre = (float*)smem;
    float* parts = pre + 2 * 35 * 64 * 2;
    float* exc = parts + 2 * 4 * 64 * 2;
    bf16_t* U = (bf16_t*)(p.ws + OFF_U);
    const bf16_t* ST = (const bf16_t*)(p.ws + OFF_P);
    const float* AGG = (const float*)(p.ws + OFF_AGG);
    int oz2 = oz;
    asm volatile("" : "+v"(oz2));
    const int tid = threadIdx.x + oz2, lane = tid & 63, wave = __builtin_amdgcn_readfirstlane(tid >> 6);
    const int dir = wave >> 2, nt = wave & 3, g = lane >> 4, li = lane & 15;
    const int c8 = tid & 7, ft = tid >> 3;
    const int n = first & 3;
    const int d = 16 * nt + li;
    u32x4 nst[4];
    u32x4 nzv;
    f32x4 npr[5];
#define LC_ITEM_OF(idx_) (skip_ctx ? ((idx_) >> 7) * 144 + 16 + ((idx_) & 127) : (idx_))
#define LC_LOAD(idx_)                                                                                       \
    {                                                                                                       \
        const int it_ = LC_ITEM_OF(idx_);                                                                   \
        const int b_ = it_ / 144, cid_ = (it_ >> 2) % 36;                                                   \
        const bool ic_ = cid_ < 4;                                                                          \
        const int t0_ = (ic_ ? cid_ : cid_ - 4) * 64;                                                       \
        const size_t rb_ = ic_ ? (size_t)LAT + (size_t)b_ * LC : (size_t)b_ * T;                            \
        const int pf_ = cid_, pb_ = ic_ ? 3 - cid_ : 39 - cid_;                                             \
        const bf16_t* sp_ = ST + (size_t)it_ * 16384 + (size_t)(wave * 4) * 512 + lane * 8;                 \
        _Pragma("unroll") for (int k = 0; k < 4; ++k) nst[k] = *(const u32x4*)(sp_ + k * 512);              \
        nzv = *(const u32x4*)(U + (rb_ + t0_ + ft) * LDU + C_LRUZ + n * 64 + 8 * c8);                       \
        _Pragma("unroll") for (int k = 0; k < 5; ++k) {                                                     \
            const int pidx = tid + 512 * k;                       \
            const int dd = pidx / (35 * 32), rem = pidx % (35 * 32), q = rem >> 5, pc16 = rem & 31;        \
            const bool need = (dd < 2) && (q < (dd ? pb_ : pf_));                                           \
            const int j = dd ? (q < 4 ? 3 - q : 39 - q) : q;                                                \
            npr[k] = (f32x4){1.f, 0.f, 1.f, 0.f};                                                           \
            if (need) npr[k] = *(const f32x4*)(AGG + ((size_t)((b_ * 2 + dd) * 36 + j) * 256 + n * 64) * 2 + pc16 * 4); \
        }                                                                                                   \
    }
    LC_LOAD(first)
    for (int idx = first; idx < end; idx += stride) {
        const int item = LC_ITEM_OF(idx);
        const int b = item / 144, cid = (item >> 2) % 36;
        const bool isctx = cid < 4;
        const int t0 = (isctx ? cid : cid - 4) * 64;
        const size_t rowbase = isctx ? (size_t)LAT + (size_t)b * LC : (size_t)b * T;
        const int posf = cid, posb = isctx ? 3 - cid : 39 - cid;
        u32x4 st[4];
        f32x4 pr[5];
#pragma unroll
        for (int k = 0; k < 4; ++k) st[k] = nst[k];
#pragma unroll
        for (int k = 0; k < 5; ++k) pr[k] = npr[k];
        const u32x4 zv = nzv;
        if (idx + stride < end) LC_LOAD(idx + stride)
        __syncthreads();
#pragma unroll
        for (int k = 0; k < 5; ++k) {
            const int pidx = tid + 512 * k;
            if (pidx < 2 * 35 * 32) *(f32x4*)(pre + pidx * 4) = pr[k];
        }
        __syncthreads();
        {
            const int dd = wave >> 2, part = wave & 3, np = dd ? posb : posf;
            const int q1 = (np < 9 * part + 9) ? np : 9 * part + 9;
            float A = 1.f, B = 0.f;
            for (int q = 9 * part; q < q1; ++q) {
                const f32x2 ah = *(const f32x2*)(pre + ((dd * 35 + q) * 64 + lane) * 2);
                A = ah[0] * A;
                B = ah[0] * B + ah[1];
            }
            *(f32x2*)(parts + ((dd * 4 + part) * 64 + lane) * 2) = (f32x2){A, B};
        }
        __syncthreads();
        float hc = 0.f;
#pragma unroll
        for (int pt = 0; pt < 4; ++pt) {
            const f32x2 ab = *(const f32x2*)(parts + ((dir * 4 + pt) * 64 + d) * 2);
            hc = ab[0] * hc + ab[1];
        }
#pragma unroll
        for (int mt = 0; mt < 4; ++mt) {
            const u32x2 h0 = {st[mt][0], st[mt][1]}, pp = {st[mt][2], st[mt][3]};
            float* e = exc + dir * 4096 + (16 * mt + 4 * g) * 64 + d;
            e[0] = lo16(h0[0]) + lo16(pp[0]) * hc;
            e[64] = hi16(h0[0]) + hi16(pp[0]) * hc;
            e[128] = lo16(h0[1]) + lo16(pp[1]) * hc;
            e[192] = hi16(h0[1]) + hi16(pp[1]) * hc;
        }
        __syncthreads();
        const float* ef = exc + ft * 64 + 8 * c8;
        const f32x4 f0 = *(const f32x4*)ef, f1 = *(const f32x4*)(ef + 4), b0 = *(const f32x4*)(ef + 4096), b1 = *(const f32x4*)(ef + 4100);
        u32x4 y;
        y[0] = cvt_pk((f0[0] + b0[0]) * siluf_(lo16(zv[0])), (f0[1] + b0[1]) * siluf_(hi16(zv[0])));
        y[1] = cvt_pk((f0[2] + b0[2]) * siluf_(lo16(zv[1])), (f0[3] + b0[3]) * siluf_(hi16(zv[1])));
        y[2] = cvt_pk((f1[0] + b1[0]) * siluf_(lo16(zv[2])), (f1[1] + b1[1]) * siluf_(hi16(zv[2])));
        y[3] = cvt_pk((f1[2] + b1[2]) * siluf_(lo16(zv[3])), (f1[3] + b1[3]) * siluf_(hi16(zv[3])));
        *(u32x4*)(U + (rowbase + t0 + ft) * LDU + C_LRUZ + n * 64 + 8 * c8) = y;
    }
#undef LC_LOAD
#undef LC_ITEM_OF
}

template <int DIR>
__device__ __forceinline__ void gdn_prep_wave(const bf16_t* qs, const bf16_t* ks, const bf16_t* vs, const float* beta, const float* G,
                                              int half, int g, int li, int lane, bf16_t* gwd, bf16_t* guv, bf16_t* gatt) {
    constexpr int LS = 72;
    float bcol[4], Gcol[4];
    f32x4 Grow[4], brow[4];
#pragma unroll
    for (int i = 0; i < 4; ++i) {
        bcol[i] = beta[16 * i + li];
        Gcol[i] = G[16 * i + li];
        Grow[i] = *(const f32x4*)(G + 16 * i + 4 * g);
        brow[i] = *(const f32x4*)(beta + 16 * i + 4 * g);
    }
    bf16x4 LtF[4][4];
    f32x4 Ntile[4], NtT[4];
#pragma unroll
    for (int ib = 0; ib < 4; ++ib)
#pragma unroll
        for (int kb = 0; kb < 4; ++kb) {
            const bool needed = DIR ? (kb >= ib) : (kb <= ib);
            if (needed) {
                f32x4 t = {0.f, 0.f, 0.f, 0.f};
#pragma unroll
                for (int s2 = 0; s2 < 2; ++s2) {
                    const bf16x8 a = *(const bf16x8*)(ks + (16 * kb + li) * LS + 32 * s2 + 8 * g);
                    const bf16x8 bb = *(const bf16x8*)(ks + (16 * ib + li) * LS + 32 * s2 + 8 * g);
                    t = MFMA32(a, bb, t);
                }
                f32x4 lt;
#pragma unroll
                for (int r = 0; r < 4; ++r) lt[r] = -(bcol[ib] * t[r] * fexp2(Gcol[ib] - Grow[kb][r]));
                if (kb == ib) {
                    f32x4 nn;
#pragma unroll
                    for (int r = 0; r < 4; ++r) {
                        const bool keepT = DIR ? (4 * g + r > li) : (4 * g + r < li);
                        lt[r] = keepT ? lt[r] : 0.f;
                        const bool keepN = DIR ? (li > 4 * g + r) : (li < 4 * g + r);
                        const float nv = -(brow[ib][r] * t[r] * fexp2(Grow[ib][r] - Gcol[ib]));
                        nn[r] = keepN ? nv : 0.f;
                    }
                    NtT[ib] = lt;
                    Ntile[ib] = nn;
                } else {
                    LtF[ib][kb] = pack4(lt);
                }
            }
        }
    bf16x4 DtF[4];
#pragma unroll
    for (int i = 0; i < 4; ++i) {
        f32x4 M = Ntile[i], Mt = NtT[i], P = Ntile[i], Pt = NtT[i];
#pragma unroll
        for (int r = 0; r < 4; ++r) {
            const float one = (4 * g + r == li) ? 1.f : 0.f;
            P[r] += one;
            Pt[r] += one;
        }
#pragma unroll
        for (int k = 0; k < 3; ++k) {
            const bf16x4 fM = pack4(M), fMt = pack4(Mt);
            const f32x4 z = {0.f, 0.f, 0.f, 0.f};
            const f32x4 M2 = MFMA16(fMt, fM, z);
            const f32x4 Mt2 = MFMA16(fM, fMt, z);
            const bf16x4 fPt = pack4(Pt), fM2 = pack4(M2);
            P = MFMA16(fPt, fM2, P);
            Pt = MFMA16(fM2, fPt, Pt);
            M = M2;
            Mt = Mt2;
        }
        DtF[i] = pack4(Pt);
    }
    bf16x4 Xf[4][4];
#pragma unroll
    for (int si = 0; si < 4; ++si) {
        const int i = DIR ? 3 - si : si;
        f32x4 eg;
#pragma unroll
        for (int r = 0; r < 4; ++r) eg[r] = half ? brow[i][r] * fexp2(Grow[i][r]) : brow[i][r];
        const bf16_t* src = half ? ks : vs;
#pragma unroll
        for (int ntl = 0; ntl < 4; ++ntl) {
            f32x4 Y;
            {
                const u32x2 sv = __builtin_bit_cast(u32x2, lds_tr(src + (16 * i + 4 * g + (li >> 2)) * LS + 16 * ntl + 4 * (li & 3)));
                Y[0] = eg[0] * lo16(sv[0]); Y[1] = eg[1] * hi16(sv[0]); Y[2] = eg[2] * lo16(sv[1]); Y[3] = eg[3] * hi16(sv[1]);
            }
#pragma unroll
            for (int sk = 0; sk < si; ++sk) {
                const int k = DIR ? 3 - sk : sk;
                Y = MFMA16(LtF[i][k], Xf[k][ntl], Y);
            }
            const f32x4 z = {0.f, 0.f, 0.f, 0.f};
            const bf16x4 Yf = pack4(Y);
            const f32x4 X = MFMA16(DtF[i], Yf, z);
            Xf[i][ntl] = pack4(X);
            if (half == 0) {
                *(bf16x4*)(guv + ((i * 4 + ntl) * 64 + lane) * 4) = Xf[i][ntl];
            } else {
                const f32x4 XT = MFMA16(Yf, DtF[i], z);
                *(bf16x4*)(gwd + (16 * i + li) * 64 + permcol(16 * ntl + 4 * g)) = pack4(-XT);
            }
        }
    }
    for (int cix = 0; cix < 2; ++cix) {
        const int ci = 2 * half + cix;
        const float Gc = G[16 * ci + li];
#pragma unroll
        for (int bi = 0; bi < 4; ++bi) {
            const bool needed = DIR ? (bi >= ci) : (bi <= ci);
            const float zf = Gc * 0.f;
            f32x4 v = {zf, zf, zf, zf};
            if (needed) {
                f32x4 t = {0.f, 0.f, 0.f, 0.f};
#pragma unroll
                for (int s2 = 0; s2 < 2; ++s2) {
                    const bf16x8 a = *(const bf16x8*)(ks + (16 * bi + li) * LS + 32 * s2 + 8 * g);
                    const bf16x8 bb = *(const bf16x8*)(qs + (16 * ci + li) * LS + 32 * s2 + 8 * g);
                    t = MFMA32(a, bb, t);
                }
#pragma unroll
                for (int r = 0; r < 4; ++r) {
                    const float x = t[r] * fexp2(Gc - Grow[bi][r]);
                    const bool keep = (bi != ci) || (DIR ? (4 * g + r >= li) : (4 * g + r <= li));
                    v[r] = keep ? x : 0.f;
                }
            }
            *(bf16x4*)(gatt + (16 * ci + li) * 64 + permcol(16 * bi + 4 * g)) = pack4(v);
        }
    }
}

__device__ void phase_gdn_prep(const Params& p, int l, char* smem, int vb, int nvb, int pend, int oz) {
    constexpr int LS = 72;
    constexpr int HBYTES = 57984;
    const int hb = __builtin_amdgcn_readfirstlane((int)((threadIdx.x + oz) >> 8));
    smem += hb * HBYTES;
    bf16_t* raw = (bf16_t*)smem;
    bf16_t* qs = (bf16_t*)(smem + 25728);
    bf16_t* ks = qs + 64 * LS;
    bf16_t* vs = ks + 64 * LS;
    float* cwl = (float*)(smem + 53376);
    float* gl = cwl + 768;
    float* bl = gl + 128;
    float* Gl = bl + 128;
    bf16_t* U = (bf16_t*)(p.ws + OFF_U);
#define GP_DMA(pair_)                                                                                    \
    {                                                                                                    \
        const int tid_ = (threadIdx.x + oz) & 255, wv_ = __builtin_amdgcn_readfirstlane(tid_ >> 6);      \
        const int it_ = __builtin_amdgcn_readfirstlane(2 * (pair_) + hb);                                \
        const int b_ = it_ / 144, h_ = (it_ / 36) & 3, cid_ = it_ % 36;                                  \
        const bool ic_ = cid_ < 4;                                                                       \
        const int t0_ = (ic_ ? cid_ : cid_ - 4) * 64, Ts_ = ic_ ? LC : T;                                \
        const size_t rb_ = ic_ ? (size_t)LAT + (size_t)b_ * LC : (size_t)b_ * T;                         \
        _Pragma("unroll") for (int k = 0; k < 7; ++k) {                                                  \
            const int idx = tid_ + 256 * k;                                                              \
            const int r = idx / 24, c8 = idx % 24;                                                       \
            int t = t0_ - 2 + r;                                                                         \
            t = (t >= 0 && t < Ts_) ? t : t0_;     \
            if (idx < 67 * 24)                                                                           \
                __builtin_amdgcn_global_load_lds((const unsigned*)(U + (rb_ + t) * LDU + C_GQ + (c8 >> 3) * 256 + h_ * 64 + (c8 & 7) * 8), \
                    (__attribute__((address_space(3))) unsigned*)(raw + (size_t)(wv_ * 64 + 256 * k) * 8), 16, 0, 0); \
        }                                                                                                \
    }
    for (int pair = vb - nvb; pair < pend; pair += nvb) {
      const bool live = pair >= vb;
      if (live) {
        int oz2 = oz;
        asm volatile("" : "+v"(oz2));
        const int tid = (threadIdx.x + oz2) & 255, lane = tid & 63, wave = __builtin_amdgcn_readfirstlane(tid >> 6), g = lane >> 4, li = lane & 15;
        const int it = __builtin_amdgcn_readfirstlane(2 * pair + hb);
        const int b = it / 144, h = (it / 36) & 3, cid = it % 36;
        const bool isctx = cid < 4;
        const int t0 = (isctx ? cid : cid - 4) * 64;
        const int Tseg = isctx ? LC : T;
        const size_t rowbase = isctx ? (size_t)LAT + (size_t)b * LC : (size_t)b * T;
        {
            float cv[3];
#pragma unroll
            for (int k = 0; k < 3; ++k) {
                const int idx = tid + 256 * k, j = idx / 192, cc = idx % 192;
                cv[k] = p.in[I_GCW][(l * 4 + j) * 768 + (cc >> 6) * 256 + h * 64 + (cc & 63)];
            }
            asm volatile("s_waitcnt vmcnt(0)" ::: "memory");
            __syncthreads();
#pragma unroll
            for (int k = 0; k < 3; ++k) cwl[tid + 256 * k] = cv[k];
            if (tid < 24) {
                const unsigned z0 = (unsigned)oz2;
                const u32x4 zz = {z0, z0, z0, z0};
                if (t0 == 0) { *(u32x4*)(raw + tid * 8) = zz; *(u32x4*)(raw + 192 + tid * 8) = zz; }
                if (t0 + 64 >= Tseg) *(u32x4*)(raw + 66 * 192 + tid * 8) = zz;
            }
        }
        if (tid < 128) {
            const int dd = tid >> 6, t = tid & 63;
            const size_t row = rowbase + t0 + t;
            const float alpha = bf2f(U[row * LDU + C_GA + dd * 4 + h]);
            const float beta = bf2f(U[row * LDU + C_GB + dd * 4 + h]);
            gl[tid] = -1.4426950408889634f * fexp(p.in[I_GALOG][(l * 2 + dd) * 4 + h]) * softplusf_(alpha + p.in[I_GDT][(l * 2 + dd) * 4 + h]);
            bl[tid] = sigmoidf_(beta);
        }
        __syncthreads();
        {
            const int t = tid >> 2, qt = tid & 3;
#pragma unroll
            for (int which = 0; which < 3; ++which) {
                float a[16];
#pragma unroll
                for (int i = 0; i < 16; ++i) a[i] = 0.f;
#pragma unroll
                for (int j = 0; j < 4; ++j) {
                    const u32x4 x0 = *(const u32x4*)(raw + (t + j) * 192 + which * 64 + qt * 16);
                    const u32x4 x1 = *(const u32x4*)(raw + (t + j) * 192 + which * 64 + qt * 16 + 8);
                    const float* cwp = cwl + j * 192 + which * 64 + qt * 16;
#pragma unroll
                    for (int w = 0; w < 4; ++w) {
                        a[2 * w] += cwp[2 * w] * lo16(x0[w]);
                        a[2 * w + 1] += cwp[2 * w + 1] * hi16(x0[w]);
                        a[8 + 2 * w] += cwp[8 + 2 * w] * lo16(x1[w]);
                        a[8 + 2 * w + 1] += cwp[8 + 2 * w + 1] * hi16(x1[w]);
                    }
                }
                float ss = 0.f;
#pragma unroll
                for (int i = 0; i < 16; ++i) {
                    a[i] = siluf_(a[i]);
                    ss += a[i] * a[i];
                }
                float sc = 1.f;
                if (which < 2) {
                    ss += __shfl_xor(ss, 1);
                    ss += __shfl_xor(ss, 2);
                    sc = rsqrtf(ss + EPS) * (which == 0 ? 0.125f : 1.f);
                }
                bf16_t* dst = (which == 0 ? qs : which == 1 ? ks : vs) + t * LS + qt * 16;
                u32x4 o0 = {cvt_pk(a[0] * sc, a[1] * sc), cvt_pk(a[2] * sc, a[3] * sc), cvt_pk(a[4] * sc, a[5] * sc), cvt_pk(a[6] * sc, a[7] * sc)};
                u32x4 o1 = {cvt_pk(a[8] * sc, a[9] * sc), cvt_pk(a[10] * sc, a[11] * sc), cvt_pk(a[12] * sc, a[13] * sc), cvt_pk(a[14] * sc, a[15] * sc)};
                *(u32x4*)dst = o0;
                *(u32x4*)(dst + 8) = o1;
            }
        }
        if (wave < 2) {
            float v = gl[wave * 64 + lane];
#pragma unroll
            for (int off = 1; off < 64; off <<= 1) {
                const float nb = wave == 0 ? __shfl_up(v, off) : __shfl_down(v, off);
                const bool ok = wave == 0 ? (lane >= off) : (lane + off < 64);
                v += ok ? nb : 0.f;
            }
            Gl[wave * 64 + lane] = v;
        }
        __syncthreads();
      }
      if (pair + nvb < pend) GP_DMA(pair + nvb)
      if (live) {
        int oz2 = oz;
        asm volatile("" : "+v"(oz2));
        const int tid = (threadIdx.x + oz2) & 255, lane = tid & 63, wave = __builtin_amdgcn_readfirstlane(tid >> 6), g = lane >> 4, li = lane & 15;
        const int it = __builtin_amdgcn_readfirstlane(2 * pair + hb);
        bf16_t* gq = (bf16_t*)(p.ws + OFF_GQ) + (size_t)it * 4096;
        bf16_t* gkt = (bf16_t*)(p.ws + OFF_GKT) + (size_t)it * 4096;
#pragma unroll
        for (int k = 0; k < 2; ++k) {
            const int pc = tid + 256 * k, row = pc >> 3, c8 = pc & 7;
            {
                const u32x4 qv = *(const u32x4*)(qs + row * LS + 8 * c8);
                *(u32x2*)(gq + row * 64 + permcol(8 * c8)) = (u32x2){qv[0], qv[1]};
                *(u32x2*)(gq + row * 64 + permcol(8 * c8 + 4)) = (u32x2){qv[2], qv[3]};
            }
            const int d = pc >> 3, c0 = (pc & 7) * 8;
            float kv[8];
#pragma unroll
            for (int i = 0; i < 8; ++i) kv[i] = bf2f(ks[(c0 + i) * LS + d]);
            u32x4 o = {cvt_pk(kv[0], kv[1]), cvt_pk(kv[2], kv[3]), cvt_pk(kv[4], kv[5]), cvt_pk(kv[6], kv[7])};
            *(u32x2*)(gkt + d * 64 + permcol(c0)) = (u32x2){o[0], o[1]};
            *(u32x2*)(gkt + d * 64 + permcol(c0 + 4)) = (u32x2){o[2], o[3]};
        }
        if (tid < 128) {
            const int dd = tid >> 6, t = tid & 63;
            float* vec = (float*)(p.ws + OFF_GVEC) + ((size_t)dd * GI + it) * 256;
            const float Glast = dd ? Gl[64] : Gl[63];
            const float Gt = Gl[dd * 64 + t];
            vec[t] = fexp2(Gt);
            vec[64 + t] = fexp2(Glast - Gt);
            if (t == 0) vec[128] = fexp2(Glast);
        }
        {
            const int dir = __builtin_amdgcn_readfirstlane(wave >> 1), half = __builtin_amdgcn_readfirstlane(wave & 1);
            bf16_t* gwd = (bf16_t*)(p.ws + OFF_GWD) + ((size_t)dir * GI + it) * 4096;
            bf16_t* guv = (bf16_t*)(p.ws + OFF_GUV) + ((size_t)dir * GI + it) * 4096;
            bf16_t* gatt = (bf16_t*)(p.ws + OFF_GATT) + ((size_t)dir * GI + it) * 4096;
            if (dir == 0) gdn_prep_wave<0>(qs, ks, vs, bl, Gl, half, g, li, lane, gwd, guv, gatt);
            else          gdn_prep_wave<1>(qs, ks, vs, bl + 64, Gl + 64, half, g, li, lane, gwd, guv, gatt);
        }
      }
    }
}

#undef GP_DMA
__device__ void phase_gdn_chain(const Params& p, int l, char* smem, int vb, int nvb, int oz) {
    constexpr int LS = 72;
    constexpr int TILEB = 64 * LS * 2;
    constexpr int BUFB = 4 * TILEB + 8192 + 528;
    bf16_t* U = (bf16_t*)(p.ws + OFF_U);
    const int tid = threadIdx.x + oz, lane = tid & 63, wave = tid >> 6;
    const int sl = wave & 3, g = lane >> 4, li = lane & 15;
    const bool loader = wave >= 4;
    const int at = tid & 255;
    const bool with_ctx = l < 3;
    for (int it = vb; it < 64; it += nvb) {
        const int b = it >> 3, h = (it >> 1) & 3, dir = it & 1;
#define GDN_GI(ci_) ((b * 4 + h) * 36 + (dir ? ((ci_) < 4 ? 3 - (ci_) : 39 - (ci_)) : (ci_)))
        if (loader) {
            u32x4 ra[5][2], rb[5][2], rc[5][2];
            float va = 0.f, vb_ = 0.f, vc_ = 0.f, ga = 0.f, gb = 0.f, gc = 0.f;
#define GDN_LOAD(R, V, G, ci_)                                                                                   \
    {                                                                                                            \
        const size_t gi = GDN_GI(ci_);                                                                           \
        const bf16_t* tp[5] = {(const bf16_t*)(p.ws + OFF_GWD) + ((size_t)dir * GI + gi) * 4096,                 \
                               (const bf16_t*)(p.ws + OFF_GATT) + ((size_t)dir * GI + gi) * 4096,                \
                               (const bf16_t*)(p.ws + OFF_GKT) + gi * 4096,                                      \
                               (const bf16_t*)(p.ws + OFF_GQ) + gi * 4096,                                       \
                               (const bf16_t*)(p.ws + OFF_GUV) + ((size_t)dir * GI + gi) * 4096};                \
        _Pragma("unroll") for (int tl = 0; tl < 5; ++tl)                                                         \
            _Pragma("unroll") for (int k = 0; k < 2; ++k) R[tl][k] = *(const u32x4*)(tp[tl] + (at + 256 * k) * 8); \
        const float* vp = (const float*)(p.ws + OFF_GVEC) + ((size_t)dir * GI + gi) * 256;                       \
        if (at < 128) V = vp[at];                                                                                \
        if (at == 0) G = vp[128];                                                                                \
    }
#define GDN_FILL(R, V, G, buf_)                                                                                  \
    {                                                                                                            \
        char* bp = smem + (buf_) * BUFB;                                                                         \
        _Pragma("unroll") for (int tl = 0; tl < 4; ++tl)                                                         \
            _Pragma("unroll") for (int k = 0; k < 2; ++k) {                                                      \
                const int pc = at + 256 * k;                                                                     \
                *(u32x4*)(bp + tl * TILEB + ((pc >> 3) * LS + (pc & 7) * 8) * 2) = R[tl][k];                     \
            }                                                                                                    \
        _Pragma("unroll") for (int k = 0; k < 2; ++k) *(u32x4*)(bp + 4 * TILEB + (at + 256 * k) * 16) = R[4][k]; \
        float* vl = (float*)(bp + 4 * TILEB + 8192);                                                             \
        if (at < 128) vl[at] = V;                                                                                \
        if (at == 0) vl[128] = G;                                                                                \
    }
            GDN_LOAD(ra, va, ga, 0)
            GDN_LOAD(rb, vb_, gb, 1)
            GDN_LOAD(rc, vc_, gc, 2)
            GDN_FILL(ra, va, ga, 0)
            GDN_LOAD(ra, va, ga, 3)
            LDS_BARRIER();
            for (int ci = 0; ci < 36; ci += 6) {
                GDN_FILL(rb, vb_, gb, 1)  if (ci + 4 < 36) GDN_LOAD(rb, vb_, gb, ci + 4)  LDS_BARRIER();
                GDN_FILL(rc, vc_, gc, 0)  if (ci + 5 < 36) GDN_LOAD(rc, vc_, gc, ci + 5)  LDS_BARRIER();
                GDN_FILL(ra, va, ga, 1)  if (ci + 6 < 36) GDN_LOAD(ra, va, ga, ci + 6)  LDS_BARRIER();
                GDN_FILL(rb, vb_, gb, 0)  if (ci + 7 < 36) GDN_LOAD(rb, vb_, gb, ci + 7)  LDS_BARRIER();
                GDN_FILL(rc, vc_, gc, 1)  if (ci + 8 < 36) GDN_LOAD(rc, vc_, gc, ci + 8)  LDS_BARRIER();
                if (ci + 6 < 36) GDN_FILL(ra, va, ga, 0)  if (ci + 9 < 36) GDN_LOAD(ra, va, ga, ci + 9)  LDS_BARRIER();
            }
#undef GDN_LOAD
#undef GDN_FILL
        } else {
            f32x4 S[4];
#pragma unroll
            for (int mt = 0; mt < 4; ++mt) S[mt] = (f32x4){0.f, 0.f, 0.f, 0.f};
            bf16x4 ost[4], onew[4];
#pragma unroll
            for (int mt = 0; mt < 4; ++mt) { ost[mt] = (bf16x4){0, 0, 0, 0}; onew[mt] = (bf16x4){0, 0, 0, 0}; }
            size_t orow = 0;
            bool ohave = false;
            if (__builtin_amdgcn_readfirstlane(wave) < 4) __builtin_amdgcn_s_setprio(3);
            LDS_BARRIER();
            for (int ci = 0; ci < 36; ++ci) {
                if (ohave) {
#pragma unroll
                    for (int mt = 0; mt < 4; ++mt)
                        *(bf16x4*)(U + (orow + 16 * mt + li) * LDU + C_GQ + dir * 256 + h * 64 + 16 * sl + 4 * g) = ost[mt];
                }
                const ChunkInfo c = chunk_info<64>(ci, dir, b);
                const bool need_o = !c.isctx || with_ctx;
                const char* bp = smem + (ci & 1) * BUFB;
                const bf16_t* WD = (const bf16_t*)bp;
                const bf16_t* AT = WD + 64 * LS;
                const bf16_t* KT = AT + 64 * LS;
                const bf16_t* QQ = KT + 64 * LS;
                const bf16_t* UVl = QQ + 64 * LS;
                const float* eG = (const float*)(bp + 4 * TILEB + 8192);
                const float* eT = eG + 64;
                const float gt = eG[128];
                u32x2 uvw[4];
                bf16x8 wa[4][2], ka[4][2];
                f32x4 e0[2], e1[2];
#pragma unroll
                for (int mt = 0; mt < 4; ++mt) {
                    uvw[mt] = *(const u32x2*)(UVl + ((mt * 4 + sl) * 64 + lane) * 4);
#pragma unroll
                    for (int s = 0; s < 2; ++s) {
                        wa[mt][s] = *(const bf16x8*)(WD + (16 * mt + li) * LS + 32 * s + 8 * g);
                    }
                }
#pragma unroll
                for (int s = 0; s < 2; ++s) { e0[s] = *(const f32x4*)(eT + 32 * s + 4 * g); e1[s] = *(const f32x4*)(eT + 32 * s + 16 + 4 * g); }
                bf16x8 sf[2];
#pragma unroll
                for (int s = 0; s < 2; ++s) sf[s] = pack8(S[2 * s], S[2 * s + 1]);
                __builtin_amdgcn_sched_barrier(0);
                f32x4 vn[4];
#pragma unroll
                for (int mt = 0; mt < 4; ++mt) {
                    vn[mt] = (f32x4){lo16(uvw[mt][0]), hi16(uvw[mt][0]), lo16(uvw[mt][1]), hi16(uvw[mt][1])};
#pragma unroll
                    for (int s = 0; s < 2; ++s) vn[mt] = MFMA32(wa[mt][s], sf[s], vn[mt]);
                }
#pragma unroll
                for (int mt = 0; mt < 4; ++mt)
#pragma unroll
                    for (int s = 0; s < 2; ++s)
                        ka[mt][s] = *(const bf16x8*)(KT + (16 * mt + li) * LS + 32 * s + 8 * g);
                bf16x8 qa[4][2], aa[4][2];
                float eGc[4];
                if (need_o) {
#pragma unroll
                    for (int mt = 0; mt < 4; ++mt) {
                        eGc[mt] = eG[16 * mt + li];
#pragma unroll
                        for (int s = 0; s < 2; ++s) {
                            qa[mt][s] = *(const bf16x8*)(QQ + (16 * mt + li) * LS + 32 * s + 8 * g);
                            if (!(dir ? (s == 0 && mt >= 2) : (s == 1 && mt < 2)))
                                aa[mt][s] = *(const bf16x8*)(AT + (16 * mt + li) * LS + 32 * s + 8 * g);
                        }
                    }
                }
                __builtin_amdgcn_sched_barrier(0);
                bf16x8 vf[2], vsf[2];
#pragma unroll
                for (int s = 0; s < 2; ++s) {
                    vf[s] = pack8(vn[2 * s], vn[2 * s + 1]);
                    vsf[s] = pack8(vn[2 * s] * e0[s], vn[2 * s + 1] * e1[s]);
                }
#pragma unroll
                for (int mt = 0; mt < 4; ++mt) {
                    f32x4 acc = S[mt] * gt;
#pragma unroll
                    for (int s = 0; s < 2; ++s) acc = MFMA32(ka[mt][s], vsf[s], acc);
                    S[mt] = acc;
                }
                ohave = need_o;
                if (need_o) {
                    orow = c.rowbase + c.t0;
#pragma unroll
                    for (int mt = 0; mt < 4; ++mt) {
                        f32x4 acc = {0.f, 0.f, 0.f, 0.f};
#pragma unroll
                        for (int s = 0; s < 2; ++s) acc = MFMA32(sf[s], qa[mt][s], acc);
                        acc = acc * eGc[mt];
#pragma unroll
                        for (int s = 0; s < 2; ++s)
                            if (!(dir ? (s == 0 && mt >= 2) : (s == 1 && mt < 2))) acc = MFMA32(vf[s], aa[mt][s], acc);
                        onew[mt] = pack4(acc);
                    }
                }
                asm volatile("" :: "v"(ost[0]), "v"(ost[1]), "v"(ost[2]), "v"(ost[3]));
#pragma unroll
                for (int mt = 0; mt < 4; ++mt) ost[mt] = onew[mt];
                LDS_BARRIER();
            }
            if (ohave) {
#pragma unroll
                for (int mt = 0; mt < 4; ++mt)
                    *(bf16x4*)(U + (orow + 16 * mt + li) * LDU + C_GQ + dir * 256 + h * 64 + 16 * sl + 4 * g) = ost[mt];
            }
        }
#undef GDN_GI
        __builtin_amdgcn_s_setprio(0);
        LDS_BARRIER();
    }
}

__device__ void phase_swa_mfma(const Params& p, int l, char* smem, int vb, int nvb, int pend, int oz) {
    constexpr int LS = 72;
    constexpr float QSC = 0.125f * 1.4426950408889634f;
    const int hb = __builtin_amdgcn_readfirstlane((int)((threadIdx.x + oz) >> 8));
    smem += hb * (2 * 64 * LS * 2);
    bf16_t* Kl = (bf16_t*)smem;
    bf16_t* Vl = Kl + 64 * LS;
    bf16_t* U = (bf16_t*)(p.ws + OFF_U);
    const int tid = (threadIdx.x + oz) & 255, lane = tid & 63, wave = __builtin_amdgcn_readfirstlane(tid >> 6), g = lane >> 4, li = lane & 15;
    const int q4 = li >> 2, p4 = li & 3;
    const int fr = tid >> 2, fj = tid & 3;
    const bool with_ctx = l < 3;
    const int nlat = 8 * 2 * 32, nctx = with_ctx ? 8 * 2 * 4 : 0;
    float invq[8], invk[8];
#pragma unroll
    for (int j = 0; j < 8; ++j) {
        invq[j] = fexp(-(float)((8 * g + j) & 15) * (9.210340371976184f / 16.f)) * 0.15915494309189535f;
        invk[j] = fexp(-(float)((8 * fj + j) & 15) * (9.210340371976184f / 16.f)) * 0.15915494309189535f;
    }
    for (int pair = vb; pair < pend; pair += nvb) {
        const int it = 2 * pair + hb;
        const bool cq = it >= nlat;
        const int id = cq ? it - nlat : it;
        int qt, kvh, b;
        if (!cq) { qt = id & 31; kvh = (id >> 5) & 1; b = id >> 6; }
        else     { qt = id & 3;  kvh = (id >> 2) & 1; b = id >> 3; }
        const int hq = kvh * 2 + (wave >> 1), qsub = wave & 1;
        const size_t qbase = cq ? (size_t)LAT + (size_t)b * LC : (size_t)b * T;
        bf16x8 qf[2][2];
#pragma unroll
        for (int qt2 = 0; qt2 < 2; ++qt2) {
            const int tq = qt * 64 + 32 * qsub + 16 * qt2 + li;
            const bf16_t* qp = U + (qbase + tq) * LDU + C_SQ + hq * 64 + 8 * g;
            const u32x4 r0 = *(const u32x4*)qp, r1 = *(const u32x4*)(qp + 32);
            float x1[8], x2[8];
#pragma unroll
            for (int w = 0; w < 4; ++w) {
                x1[2 * w] = lo16(r0[w]); x1[2 * w + 1] = hi16(r0[w]);
                x2[2 * w] = lo16(r1[w]); x2[2 * w + 1] = hi16(r1[w]);
            }
            if (!cq) {
                const float pos = (g < 2) ? (float)(tq >> 6) : (float)(tq & 63);
#pragma unroll
                for (int j = 0; j < 8; ++j) {
                    float rev = pos * invq[j];
                    rev -= floorf(rev);
                    const float cs = __builtin_amdgcn_cosf(rev), sn = __builtin_amdgcn_sinf(rev);
                    const float a1 = x1[j], a2 = x2[j];
                    x1[j] = a1 * cs - a2 * sn;
                    x2[j] = a1 * sn + a2 * cs;
                }
            }
            u32x4 o1, o2;
#pragma unroll
            for (int w = 0; w < 4; ++w) {
                o1[w] = cvt_pk(x1[2 * w] * QSC, x1[2 * w + 1] * QSC);
                o2[w] = cvt_pk(x2[2 * w] * QSC, x2[2 * w + 1] * QSC);
            }
            qf[qt2][0] = __builtin_bit_cast(bf16x8, o1);
            qf[qt2][1] = __builtin_bit_cast(bf16x8, o2);
        }
        u32x2 zpre[2][4];
#pragma unroll
        for (int qt2 = 0; qt2 < 2; ++qt2)
#pragma unroll
            for (int dt = 0; dt < 4; ++dt)
                zpre[qt2][dt] = *(const u32x2*)(U + (qbase + qt * 64 + 32 * qsub + 16 * qt2 + li) * LDU + C_SZ + hq * 64 + 4 * g + 16 * dt);
        float m[2] = {-1e30f, -1e30f}, lsum[2] = {0.f, 0.f};
        f32x4 O[4][2];
#pragma unroll
        for (int dt = 0; dt < 4; ++dt)
#pragma unroll
            for (int qt2 = 0; qt2 < 2; ++qt2) O[dt][qt2] = (f32x4){0.f, 0.f, 0.f, 0.f};
        const int nloc = cq ? 0 : 5;
        u32x4 pk0, pk1, pv0, pv1;
#define SWA_TILE(ti_, kctx_, ktile_, oob_)                                                      \
        const bool kctx_ = (ti_) >= nloc;                                                       \
        int ktile_ = kctx_ ? (ti_) - nloc : qt + (((ti_) == 0) ? 0 : ((ti_) == 1) ? -1 : ((ti_) == 2) ? 1 : ((ti_) == 3) ? -2 : 2); \
        const bool oob_ = !kctx_ && (ktile_ < 0 || ktile_ >= 32);                               \
        ktile_ = oob_ ? qt : ktile_;
#define SWA_PREFETCH(ti_)                                                                       \
        {                                                                                       \
            SWA_TILE((ti_), kc_, kt_, ob_)                                                      \
            const int tk_ = kt_ * 64 + fr;                                                      \
            const size_t krow_ = kc_ ? (size_t)LAT + (size_t)b * LC + tk_ : (size_t)b * T + tk_; \
            const bf16_t* kp_ = U + krow_ * LDU + C_SK + kvh * 64 + 8 * fj;                     \
            const bf16_t* vp_ = U + krow_ * LDU + C_SV + kvh * 64 + 8 * fj;                     \
            pk0 = *(const u32x4*)kp_; pk1 = *(const u32x4*)(kp_ + 32);                          \
            pv0 = *(const u32x4*)vp_; pv1 = *(const u32x4*)(vp_ + 32);                          \
        }
        SWA_PREFETCH(0)
        for (int ti = 0; ti < nloc + 4; ++ti) {
            SWA_TILE(ti, kctx, ktile, oob)
            const bool edge = !kctx && (ti >= 3 || oob);
            __syncthreads();
            {
                const int tk = ktile * 64 + fr;
                const u32x4 k0 = pk0, k1 = pk1, v0 = pv0, v1 = pv1;
                u32x4 o1 = k0, o2 = k1;
                if (!kctx) {
                    const float pos = (fj < 2) ? (float)(tk >> 6) : (float)(tk & 63);
                    float x1[8], x2[8];
#pragma unroll
                    for (int w = 0; w < 4; ++w) {
                        x1[2 * w] = lo16(k0[w]); x1[2 * w + 1] = hi16(k0[w]);
                        x2[2 * w] = lo16(k1[w]); x2[2 * w + 1] = hi16(k1[w]);
                    }
#pragma unroll
                    for (int j = 0; j < 8; ++j) {
                        float rev = pos * invk[j];
                        rev -= floorf(rev);
                        const float cs = __builtin_amdgcn_cosf(rev), sn = __builtin_amdgcn_sinf(rev);
                        const float a1 = x1[j], a2 = x2[j];
                        x1[j] = a1 * cs - a2 * sn;
                        x2[j] = a1 * sn + a2 * cs;
                    }
#pragma unroll
                    for (int w = 0; w < 4; ++w) {
                        o1[w] = cvt_pk(x1[2 * w], x1[2 * w + 1]);
                        o2[w] = cvt_pk(x2[2 * w], x2[2 * w + 1]);
                    }
                }
                *(u32x4*)(Kl + fr * LS + 8 * fj) = o1;
                *(u32x4*)(Kl + fr * LS + 32 + 8 * fj) = o2;
                *(u32x4*)(Vl + fr * LS + 8 * fj) = v0;
                *(u32x4*)(Vl + fr * LS + 32 + 8 * fj) = v1;
            }
            __syncthreads();
            if (ti + 1 < nloc + 4) SWA_PREFETCH(ti + 1)
            f32x4 st[4][2];
#pragma unroll
            for (int km = 0; km < 4; ++km) {
                bf16x8 ka[2];
#pragma unroll
                for (int ks = 0; ks < 2; ++ks) ka[ks] = *(const bf16x8*)(Kl + (16 * km + li) * LS + 32 * ks + 8 * g);
#pragma unroll
                for (int qt2 = 0; qt2 < 2; ++qt2) {
                    f32x4 acc = {0.f, 0.f, 0.f, 0.f};
#pragma unroll
                    for (int ks = 0; ks < 2; ++ks) acc = MFMA32(ka[ks], qf[qt2][ks], acc);
                    st[km][qt2] = acc;
                }
            }
            if (edge) {
#pragma unroll
                for (int qt2 = 0; qt2 < 2; ++qt2) {
                    const int tq = qt * 64 + 32 * qsub + 16 * qt2 + li;
#pragma unroll
                    for (int km = 0; km < 4; ++km)
#pragma unroll
                        for (int r = 0; r < 4; ++r) {
                            int dlt = ktile * 64 + 16 * km + 4 * g + r - tq;
                            dlt = dlt < 0 ? -dlt : dlt;
                            st[km][qt2][r] = (dlt <= 128 && !oob) ? st[km][qt2][r] : -1e30f;
                        }
                }
            }
            bf16x8 pf[2][2];
#pragma unroll
            for (int qt2 = 0; qt2 < 2; ++qt2) {
                float mx = st[0][qt2][0];
#pragma unroll
                for (int km = 0; km < 4; ++km)
#pragma unroll
                    for (int r = 0; r < 4; ++r) mx = fmaxf(mx, st[km][qt2][r]);
                mx = fmaxf(mx, __shfl_xor(mx, 16));
                mx = fmaxf(mx, __shfl_xor(mx, 32));
                const float mn = fmaxf(m[qt2], mx);
                const float sc = fexp2(m[qt2] - mn);
                m[qt2] = mn;
                float ps = 0.f;
#pragma unroll
                for (int km = 0; km < 4; ++km)
#pragma unroll
                    for (int r = 0; r < 4; ++r) {
                        const float pv = fexp2(st[km][qt2][r] - mn);
                        st[km][qt2][r] = pv;
                        ps += pv;
                    }
                lsum[qt2] = lsum[qt2] * sc + ps;
#pragma unroll
                for (int dt = 0; dt < 4; ++dt) O[dt][qt2] = O[dt][qt2] * sc;
                pf[qt2][0] = pack8(st[0][qt2], st[1][qt2]);
                pf[qt2][1] = pack8(st[2][qt2], st[3][qt2]);
            }
#pragma unroll
            for (int dt = 0; dt < 4; ++dt)
#pragma unroll
                for (int ks = 0; ks < 2; ++ks) {
                    const bf16x8 va = cat8(lds_tr(Vl + (32 * ks + 4 * g + q4) * LS + 16 * dt + 4 * p4),
                                           lds_tr(Vl + (32 * ks + 16 + 4 * g + q4) * LS + 16 * dt + 4 * p4));
#pragma unroll
                    for (int qt2 = 0; qt2 < 2; ++qt2) O[dt][qt2] = MFMA32(va, pf[qt2][ks], O[dt][qt2]);
                }
        }
#undef SWA_TILE
#undef SWA_PREFETCH
        const float snk = p.in[I_SINK][l * 4 + hq] * 1.4426950408889634f;
#pragma unroll
        for (int qt2 = 0; qt2 < 2; ++qt2) {
            float ls = lsum[qt2];
            ls += __shfl_xor(ls, 16);
            ls += __shfl_xor(ls, 32);
            const float mn = fmaxf(m[qt2], snk);
            const float s1 = fexp2(m[qt2] - mn);
            const float inv = s1 / (ls * s1 + fexp2(snk - mn));
            const int tq = qt * 64 + 32 * qsub + 16 * qt2 + li;
            bf16_t* zp = U + (qbase + tq) * LDU + C_SZ + hq * 64 + 4 * g;
#pragma unroll
            for (int dt = 0; dt < 4; ++dt) {
                const u32x2 zv = zpre[qt2][dt];
                u32x2 yv;
                yv[0] = cvt_pk(O[dt][qt2][0] * inv * siluf_(lo16(zv[0])), O[dt][qt2][1] * inv * siluf_(hi16(zv[0])));
                yv[1] = cvt_pk(O[dt][qt2][2] * inv * siluf_(lo16(zv[1])), O[dt][qt2][3] * inv * siluf_(hi16(zv[1])));
                *(u32x2*)(zp + 16 * dt) = yv;
            }
        }
    }
}


__device__ void phase_finish(const Params& p, int l, char* smem, int vb, int nvb, int oz) {
    bf16_t* U = (bf16_t*)(p.ws + OFF_U);
    const bf16_t* PF = (const bf16_t*)(p.ws + OFF_P);
    const int tid = threadIdx.x + oz, lane = tid & 63, wave = __builtin_amdgcn_readfirstlane(tid >> 6);
    const int nrows = (l < 3) ? NROW : LAT;
    const int per = (nrows + nvb * 8 - 1) / (nvb * 8);
    const int rbeg = (vb * 8 + wave) * per, rend = (rbeg + per < nrows) ? rbeg + per : nrows;
    if (rbeg < nrows) {
    const float4 ng = *(const float4*)(p.in[I_GNG] + l * 64 + (lane & 15) * 4);
    u32x2 nl[6], nm[6];
#define F_LOAD(nl, row_)                                                           \
    {                                                                              \
        const size_t r_ = (size_t)(row_);                                          \
        const bf16_t* ur_ = U + r_ * LDU;                                          \
        nl[0] = *(const u32x2*)(ur_ + C_LRUX + lane * 4);                          \
        nl[1] = *(const u32x2*)(ur_ + C_GQ + 512 + lane * 4);                      \
        nl[2] = *(const u32x2*)(ur_ + C_GQ + lane * 4);                            \
        nl[3] = *(const u32x2*)(ur_ + C_GQ + 256 + lane * 4);                      \
        nl[4] = *(const u32x2*)(ur_ + C_GZ + lane * 4);                            \
        nl[5] = *(const u32x2*)(ur_ + C_RZ + lane * 4);                            \
    }
    F_LOAD(nl, rbeg)
    if (rbeg + 1 < rend) F_LOAD(nm, rbeg + 1)
    for (int row = rbeg; row < rend; ++row) {
        bf16_t* ur = U + (size_t)row * LDU;
        const u32x2 rf = nl[0], rb = nl[1], gf = nl[2], gb = nl[3], zg = nl[4], zr = nl[5];
#pragma unroll
        for (int i = 0; i < 6; ++i) nl[i] = nm[i];
        if (row + 2 < rend) F_LOAD(nm, row + 2)
        {
            const float o0 = lo16(gf[0]) + lo16(gb[0]), o1 = hi16(gf[0]) + hi16(gb[0]);
            const float o2 = lo16(gf[1]) + lo16(gb[1]), o3 = hi16(gf[1]) + hi16(gb[1]);
            float ss = o0 * o0 + o1 * o1 + o2 * o2 + o3 * o3;
            ss += __shfl_xor(ss, 1); ss += __shfl_xor(ss, 2); ss += __shfl_xor(ss, 4); ss += __shfl_xor(ss, 8);
            const float rs = rsqrtf(ss * (1.f / 64.f) + EPS);
            u32x2 y;
            y[0] = cvt_pk(o0 * rs * ng.x * siluf_(lo16(zg[0])), o1 * rs * ng.y * siluf_(hi16(zg[0])));
            y[1] = cvt_pk(o2 * rs * ng.z * siluf_(lo16(zg[1])), o3 * rs * ng.w * siluf_(hi16(zg[1])));
            st_wt8(ur + C_GZ + lane * 4, y);
        }
        {
            const float o0 = lo16(rf[0]) + lo16(rb[0]), o1 = hi16(rf[0]) + hi16(rb[0]);
            const float o2 = lo16(rf[1]) + lo16(rb[1]), o3 = hi16(rf[1]) + hi16(rb[1]);
            float s1 = o0 + o1 + o2 + o3;
            s1 += __shfl_xor(s1, 1); s1 += __shfl_xor(s1, 2); s1 += __shfl_xor(s1, 4); s1 += __shfl_xor(s1, 8);
            const float mu = s1 * (1.f / 64.f);
            const float d0 = o0 - mu, d1 = o1 - mu, d2 = o2 - mu, d3 = o3 - mu;
            float s2 = d0 * d0 + d1 * d1 + d2 * d2 + d3 * d3;
            s2 += __shfl_xor(s2, 1); s2 += __shfl_xor(s2, 2); s2 += __shfl_xor(s2, 4); s2 += __shfl_xor(s2, 8);
            const float rs = rsqrtf(s2 * (1.f / 64.f) + EPS);
            u32x2 y;
            y[0] = cvt_pk(d0 * rs * siluf_(lo16(zr[0])), d1 * rs * siluf_(hi16(zr[0])));
            y[1] = cvt_pk(d2 * rs * siluf_(lo16(zr[1])), d3 * rs * siluf_(hi16(zr[1])));
            st_wt8(ur + C_RZ + lane * 4, y);
        }
    }
    asm volatile("s_waitcnt vmcnt(0)" ::: "memory");
    if (lane == 0) {
        unsigned* bar = (unsigned*)(p.ws + OFF_BAR);
        const int pa_ = rbeg >> 8, pb_ = (rend - 1) >> 8;
        const int na_ = (pa_ == pb_) ? rend - rbeg : ((pa_ + 1) << 8) - rbeg;
        (void)xb_add(&bar[XB_FCNT(pa_)], (unsigned)na_);
        if (pb_ != pa_) (void)xb_add(&bar[XB_FCNT(pb_)], (unsigned)(rend - rbeg - na_));
    }
    }
#undef F_LOAD
}

#include <hip/hip_cooperative_groups.h>
namespace cg = cooperative_groups;


struct XcdBarrier { unsigned* bar; unsigned x; volatile XB_LAS unsigned* st; };
__device__ __forceinline__ XcdBarrier xcd_barrier_post(unsigned* bar, volatile XB_LAS unsigned* st) {
    XcdBarrier b; b.bar = bar; b.x = xb_xcc_id(); b.st = st;
    if (threadIdx.x == 0) (void)xb_add(&bar[XB_XCNT(b.x)], 1u);
    return b;
}
__device__ __forceinline__ void xcd_barrier_complete(unsigned* bar, unsigned x, unsigned& nloc, unsigned& nx) {
    const unsigned G = gridDim.x * gridDim.y * gridDim.z;
    unsigned sum, cnt, mine, sp = 0u;
    for (;;) {
        sum = 0u; cnt = 0u; mine = 0u;
#pragma unroll
        for (unsigned j = 0; j < 16; ++j) { const unsigned c = xb_ld(&bar[XB_XCNT(j)]); sum += c; cnt += (c > 0u) ? 1u : 0u; mine = (j == x) ? c : mine; }
        if (sum == G) break;
        __builtin_amdgcn_s_sleep(1);
        if ((++sp & 255u) == 0u) { if (xb_ld(&bar[XB_TMO])) break; if (sp > XB_SPIN_CAP) { atomicAdd(&bar[XB_TMO], 1u); break; } }
    }
    nloc = mine > 0u ? mine : 1u; nx = cnt > 0u ? cnt : 1u;
}
__device__ __forceinline__ void xcd_barrier(const XcdBarrier& b) {
    asm volatile("s_waitcnt vmcnt(0)" ::: "memory");
    __syncthreads();
    if (threadIdx.x == 0) {
        unsigned* bar = b.bar;
        __builtin_amdgcn_s_waitcnt(0);
        unsigned nloc = b.st[0], nx = b.st[1];
        if (nloc == 0u) { xcd_barrier_complete(bar, b.x, nloc, nx); b.st[0] = nloc; b.st[1] = nx; }
        const unsigned old = xb_add(&bar[XB_XSUB(b.x)], 1u);
        const unsigned gen = old / nloc;
        if (old + 1u == (gen + 1u) * nloc) {
            __builtin_amdgcn_fence(__ATOMIC_RELEASE, "agent");
            asm volatile("s_waitcnt vmcnt(0)" ::: "memory");
            const unsigned og = xb_add(&bar[XB_TOP], 1u);
            const unsigned tg = og / nx;
            if (og + 1u == (tg + 1u) * nx) xb_add(&bar[XB_TOPGEN], 1u);
            else XB_SPIN(xb_ld(&bar[XB_TOPGEN]) == tg, bar);
            __builtin_amdgcn_fence(__ATOMIC_ACQUIRE, "agent");
            xb_add(&bar[XB_XGEN(b.x)], 1u);
            asm volatile("s_waitcnt vmcnt(0)" ::: "memory");
        } else {
            XB_SPIN(xb_ld(&bar[XB_XGEN(b.x)]) == gen, bar);
            __builtin_amdgcn_fence(__ATOMIC_ACQUIRE, "agent");
            asm volatile("s_waitcnt vmcnt(0)" ::: "memory");
        }
    }
    __syncthreads();
}

constexpr int SMEM_BYTES = 128 * 1024 + 16;

__global__ void __launch_bounds__(NT) fwd_megakernel(Params p) {
    extern __shared__ __attribute__((aligned(16))) char smem[];
    cg::grid_group grid = cg::this_grid();
    const int nvb = gridDim.x;
    volatile XB_LAS unsigned* xst = (volatile XB_LAS unsigned*)(smem + 128 * 1024);
    if (threadIdx.x == 0) { xst[0] = 0u; xst[1] = 0u; }
    __syncthreads();
    const XcdBarrier xb = xcd_barrier_post((unsigned*)(p.ws + OFF_BAR), xst);
    if (p.ws == nullptr) grid.sync();
    const int cgrp = nvb - 32;
#pragma clang loop unroll(disable)
    for (int ph = -1; ph <= 24; ++ph) {
        int oz = 0, vb = blockIdx.x, l = (ph < 0) ? 0 : ph / 6, q = (ph < 0) ? 6 : ph % 6;
        asm volatile("" : "+v"(oz));
        asm volatile("" : "+s"(vb));
        asm volatile("" : "+s"(l));
        asm volatile("" : "+s"(q));
        const bool split = CTX_SPLIT && (l >= 1) && (l <= 3);
        const bool cblk = split && (vb >= cgrp);
#if defined(PROBE_Q) || defined(PROBE_CLS) || defined(PROBE_M2)
        const unsigned long long t_in = __builtin_amdgcn_s_memrealtime();
#endif
        if ((q == 0 && cblk) || q == 5) {
            const bool cg_ = (q == 0);
            g8::gemm_phase<true>(p, cg_ ? l - 1 : l, smem, cg_ ? vb - cgrp : vb, cg_ ? 32 : nvb, cg_ ? LAT / 256 : 0, cg_ ? Bsz * LC : (CTX_SPLIT || l == 3) ? LAT : NROW, !cg_ && l == 3, oz);
            if (q == 5 && l == 3) break;
        }
        if (q == 2 || (q == 3 && vb >= 128)) {
            const int nsw = (l < 3) ? 288 : 256, nsw1 = (l < 3) ? 160 : 128;
            const int s0 = (q == 2) ? vb : nsw1 + (vb - 128);
            const int s1 = (q == 2) ? ((vb < nsw1) ? vb + 1 : vb) : ((s0 + 1 < nsw) ? s0 + 1 : nsw);
            phase_swa_mfma(p, l, smem, s0, 1, s1, oz);
            __syncthreads();
        }
        if (q == 0) {
            if (cblk) {
                unsigned* bar = (unsigned*)(p.ws + OFF_BAR);
                asm volatile("s_waitcnt vmcnt(0)" ::: "memory");
                __syncthreads();
                if (threadIdx.x == 0) xb_add(&bar[192], 1u);
            }
            if (l >= 1) {
                unsigned* bar = (unsigned*)(p.ws + OFF_BAR);
                const int r0 = cblk ? (nvb - 32) * 72 + (vb - cgrp) * 8 : vb * 72, r1 = cblk ? r0 + 7 : r0 + 71;
                const int pa_ = r0 >> 8, pb_ = ((r1 < LAT) ? r1 : LAT - 1) >> 8;
                __syncthreads();
                if (threadIdx.x == 0) {
                    XB_SPIN(xb_ld(&bar[XB_YCNT(pa_)]) < 4u * (unsigned)l, bar);
                    XB_SPIN(xb_ld(&bar[XB_YCNT(pb_)]) < 4u * (unsigned)l, bar);
                    __builtin_amdgcn_fence(__ATOMIC_ACQUIRE, "agent");
                    asm volatile("s_waitcnt vmcnt(0)" ::: "memory");
                }
                __syncthreads();
            }
            if (l == 0) {
                unsigned* bar = (unsigned*)(p.ws + OFF_BAR);
                __syncthreads();
                if (threadIdx.x == 0) {
                    XB_SPIN(xb_ld(&bar[193]) < 48u, bar);
                    __builtin_amdgcn_fence(__ATOMIC_ACQUIRE, "agent");
                    asm volatile("s_waitcnt vmcnt(0)" ::: "memory");
                }
                __syncthreads();
            }
            phase_E_rows(p, l, smem, vb, nvb, split, (l == 4) ? LAT : NROW, oz);
            if (l == 4) break;
        } else if (q == 1) {
            g8::gemm_phase<false>(p, l, smem, vb, nvb, 0, NROW, false, oz);
        } else if (q == 2) {
            const int cls = (vb < 160) ? 0 : (vb < 224) ? 1 : 2;
            const int g0 = (cls == 0) ? 2 * vb : (cls == 1) ? 320 + 3 * (vb - 160) : 512 + 2 * (vb - 224);
            const int g1 = g0 + ((cls == 1) ? 3 : 2);
            phase_gdn_prep(p, l, smem, g0, 1, g1, oz);
            __syncthreads();
            const int n = vb & 3;
            int m0, mc;
            if (cls == 0) { const int j = vb >> 2; if (j < 26) { m0 = 3 * j; mc = 3; } else { m0 = 78 + 2 * (j - 26); mc = 2; } }
            else if (cls == 1) { const int j = (vb - 160) >> 2; if (j < 6) { m0 = 106 + 7 * j; mc = 7; } else { m0 = 148 + 6 * (j - 6); mc = 6; } }
            else { const int j = (vb - 224) >> 2; m0 = 208 + 10 * j; mc = 10; }
            lru_loop<0>(p, l, smem, n + 4 * m0, n + 4 * (m0 + mc), 4, false, oz);
#ifdef PROBE_CLS
            if (cls == PROBE_CLS) {
                __syncthreads();
                const unsigned long long t1 = __builtin_amdgcn_s_memrealtime(), d = (t1 - t_in) * PROBE_K;
                while (__builtin_amdgcn_s_memrealtime() - t1 < d) __builtin_amdgcn_s_sleep(8);
            }
#endif
        } else if (q == 3) {
            if (vb < 64) phase_gdn_chain(p, l, smem, vb, 64, oz);
            else if (vb < 128) phase_ret_chain(p, l, smem, vb - 64, 64, oz);
            else {
                lru_passC(p, l, smem, vb - 128, (l < 3) ? 1152 : 1024, nvb - 128, l == 3, oz);
                __syncthreads();
                if (l < 3) wconv_loop(p, l + 1, vb - 128, WCONV_TILES, nvb - 128, smem, oz);
            }
#ifdef PROBE_M2
            if ((vb < 64 ? 0 : vb < 128 ? 1 : 2) == PROBE_M2) {
                __syncthreads();
                const unsigned long long t1 = __builtin_amdgcn_s_memrealtime(), d = (t1 - t_in) * PROBE_K;
                while (__builtin_amdgcn_s_memrealtime() - t1 < d) __builtin_amdgcn_s_sleep(8);
            }
#endif
        } else if (q == 4) {
            phase_finish(p, l, smem, vb, nvb, oz);
        } else if (q == 6) {
            phase_prep(p, smem, vb, nvb, oz);
        }
        if (q != 6 && q != 4 && q != 5) xcd_barrier(xb);
#ifdef PROBE_Q
        if (q == PROBE_Q) {
            const unsigned long long t1 = __builtin_amdgcn_s_memrealtime(), d = (t1 - t_in) * PROBE_K;
            while (__builtin_amdgcn_s_memrealtime() - t1 < d) __builtin_amdgcn_s_sleep(8);
        }
#endif
    }
}

extern "C" void kernel_launch(void* const* d_in, const int* in_sizes, int n_in, void* d_out, int out_size, void* d_ws,
                              size_t ws_size, hipStream_t stream) {
    static int grid_blocks = 0;
    if (grid_blocks == 0) {
        if (n_in != 23 || ws_size < WS_END) {
            fprintf(stderr, "kernel_launch: unexpected n_in %d or ws_size %zu (< %zu)\n", n_in, ws_size, (size_t)WS_END);
            grid_blocks = -1;
            return;
        }
        int dev = 0, cus = 0, per_cu = 0;
        (void)hipGetDevice(&dev);
        (void)hipDeviceGetAttribute(&cus, hipDeviceAttributeMultiprocessorCount, dev);
        (void)hipFuncSetAttribute((const void*)fwd_megakernel, hipFuncAttributeMaxDynamicSharedMemorySize, SMEM_BYTES);
        (void)hipOccupancyMaxActiveBlocksPerMultiprocessor(&per_cu, fwd_megakernel, NT, SMEM_BYTES);
        if (per_cu < 1) per_cu = 1;
        if (per_cu > 1) per_cu = 1;
        grid_blocks = cus * per_cu;
        fprintf(stderr, "kernel_launch: cus %d per_cu %d grid %d\n", cus, per_cu, grid_blocks);
    }
    if (grid_blocks < 0) return;
    Params p{};
    for (int i = 0; i < 23; ++i) p.in[i] = (const float*)d_in[i];
    p.out = (float*)d_out;
    p.ws = (unsigned char*)d_ws;
    (void)hipMemsetAsync((unsigned char*)d_ws + OFF_BAR, 0, BAR_WORDS_TOTAL * 4, stream);
    void* args[] = {&p};
    hipError_t e = hipLaunchCooperativeKernel((void*)fwd_megakernel, dim3(grid_blocks), dim3(NT), args, SMEM_BYTES, stream);
    if (e != hipSuccess) fprintf(stderr, "cooperative launch failed: %s (grid %d)\n", hipGetErrorString(e), grid_blocks);
}
```
